# Optimizing an MI355X kernel written in HIP

```python
import jax, jax.numpy as jnp
from jax import lax
import numpy as np

D_MODEL = 1024
BATCH = 2
SEQ = 8192
DEPTH = 2

HEAD_DIM = 64
A_Q_HEADS = 6
A_KV_HEADS = 2
WINDOW = 128
B_HEADS = 6
MOBA_BLOCK = 256
MOBA_TOPK = 3
MOBA_Q_CHUNK = 64
C_HEADS = 12
FOX_Q_BLOCK = 128
MEM_HEADS = 4
MEM_LEN = 256
EVEN_MIX = (A_Q_HEADS + B_HEADS + MEM_HEADS) * HEAD_DIM
ODD_MIX = (C_HEADS + MEM_HEADS) * HEAD_DIM
EVEN_SPLIT = [A_Q_HEADS * HEAD_DIM, A_KV_HEADS * HEAD_DIM, A_KV_HEADS * HEAD_DIM,
              B_HEADS * HEAD_DIM, B_HEADS * HEAD_DIM, B_HEADS * HEAD_DIM,
              MEM_HEADS * HEAD_DIM, EVEN_MIX]
ODD_SPLIT = [C_HEADS * HEAD_DIM, C_HEADS * HEAD_DIM, C_HEADS * HEAD_DIM, C_HEADS,
             MEM_HEADS * HEAD_DIM, ODD_MIX]
EVEN_IN = sum(EVEN_SPLIT)
ODD_IN = sum(ODD_SPLIT)
N_ALIBI = A_Q_HEADS + B_HEADS
EPS = 1e-6
NEG = -1e30
SCALE = HEAD_DIM ** -0.5

kernel_name = 'hybrid_swa_moba_fox_memory_trunk'


def rms_norm(x, g):
    xf = x.astype(jnp.float32)
    y = xf * lax.rsqrt(jnp.mean(xf * xf, axis=-1, keepdims=True) + EPS)
    return (y * g.astype(jnp.float32)).astype(x.dtype)


def split_cols(h, sizes):
    return jnp.split(h, np.cumsum(sizes)[:-1].tolist(), axis=-1)


def split_heads(t, n):
    return t.reshape(t.shape[0], t.shape[1], n, HEAD_DIM)


def alibi_slopes():
    h = jnp.arange(1, N_ALIBI + 1, dtype=jnp.float32)
    return 2.0 ** (-8.0 * h / N_ALIBI)


def sliding_window_sink_attn(q, k, v, sinks, slopes):
    B, S, HQ, _ = q.shape
    HKV = k.shape[2]
    G = HQ // HKV
    W = WINDOW
    nb = S // W
    qb = q.reshape(B, nb, W, HKV, G, HEAD_DIM)

    def band(t):
        tb = t.reshape(B, nb, W, HKV, HEAD_DIM)
        prev = jnp.pad(tb, ((0, 0), (1, 0), (0, 0), (0, 0), (0, 0)))[:, :-1]
        return jnp.concatenate([prev, tb], axis=2)

    kb, vb = band(k), band(v)
    logits = jnp.einsum('bnqkgd,bnskd->bnkgqs', qb, kb,
                        preferred_element_type=jnp.float32) * SCALE
    qpos = jnp.arange(nb)[:, None] * W + jnp.arange(W)[None, :]
    kpos = jnp.arange(nb)[:, None] * W - W + jnp.arange(2 * W)[None, :]
    dist = qpos[:, :, None] - kpos[:, None, :]
    allowed = (dist >= 0) & (dist < W) & (kpos[:, None, :] >= 0)
    sl = slopes.reshape(HKV, G)[None, None, :, :, None, None]
    logits = logits - sl * dist[None, :, None, None].astype(jnp.float32)
    logits = jnp.where(allowed[None, :, None, None], logits, NEG)
    sink = jnp.broadcast_to(
        sinks.astype(jnp.float32).reshape(HKV, G)[None, None, :, :, None, None],
        logits.shape[:-1] + (1,))
    p = jax.nn.softmax(jnp.concatenate([logits, sink], axis=-1), axis=-1)[..., :-1]
    o = jnp.einsum('bnkgqs,bnskd->bnqkgd', p.astype(v.dtype), vb)
    return o.reshape(B, S, HQ * HEAD_DIM)


def moba_attn(q, k, v, slopes):
    B, S, H, _ = q.shape
    L = MOBA_BLOCK
    nblk = -(-S // L)
    Sp = nblk * L
    pad = ((0, 0), (0, Sp - S), (0, 0), (0, 0))
    q, k, v = [jnp.pad(t, pad).transpose(0, 2, 1, 3) for t in (q, k, v)]
    kblk = k.reshape(B, H, nblk, L, HEAD_DIM)
    vblk = v.reshape(B, H, nblk, L, HEAD_DIM)
    kmean = jnp.mean(kblk.astype(jnp.float32), axis=3)
    gate = jnp.einsum('bhtd,bhnd->bhtn', q.astype(jnp.float32), kmean)
    qblk_id = jnp.arange(Sp) // L
    past = jnp.arange(nblk)[None, :] < qblk_id[:, None]
    gate = jnp.where(past, gate, NEG)
    K = min(MOBA_TOPK, nblk)
    _, sel = lax.top_k(gate, K)
    sel_valid = jnp.arange(K)[None, :] < qblk_id[:, None]

    C = MOBA_Q_CHUNK
    nch = Sp // C
    q_c = q.reshape(B, H, nch, C, HEAD_DIM).transpose(2, 0, 1, 3, 4)
    sel_c = sel.reshape(B, H, nch, C, K).transpose(2, 0, 1, 3, 4)
    valid_c = sel_valid.reshape(nch, C, K)
    qpos_c = jnp.arange(Sp).reshape(nch, C)
    bi = jnp.arange(B)[:, None, None, None]
    hi = jnp.arange(H)[None, :, None, None]
    sl = slopes.astype(jnp.float32)
    offs = jnp.arange(L)

    def chunk_fn(args):
        qc, selc, validc, qposc = args
        own = qposc[0] // L
        ksel = kblk[bi, hi, selc]
        vsel = vblk[bi, hi, selc]
        kown = lax.dynamic_index_in_dim(kblk, own, axis=2, keepdims=False)
        vown = lax.dynamic_index_in_dim(vblk, own, axis=2, keepdims=False)
        s_sel = jnp.einsum('bhcd,bhckld->bhckl', qc, ksel,
                           preferred_element_type=jnp.float32) * SCALE
        dist_sel = (qposc[None, None, :, None, None]
                    - (selc[..., None] * L + offs)).astype(jnp.float32)
        s_sel = s_sel - sl[None, :, None, None, None] * dist_sel
        s_sel = jnp.where(validc[None, None, :, :, None], s_sel, NEG)
        s_own = jnp.einsum('bhcd,bhld->bhcl', qc, kown,
                           preferred_element_type=jnp.float32) * SCALE
        dist_own = qposc[:, None] - (own * L + offs)[None, :]
        s_own = s_own - sl[None, :, None, None] * dist_own.astype(jnp.float32)[None, None]
        s_own = jnp.where((dist_own >= 0)[None, None], s_own, NEG)
        logits = jnp.concatenate([s_sel.reshape(B, H, C, K * L), s_own], axis=-1)
        p = jax.nn.softmax(logits, axis=-1).astype(v.dtype)
        p_sel = p[..., :K * L].reshape(B, H, C, K, L)
        p_own = p[..., K * L:]
        return (jnp.einsum('bhckl,bhckld->bhcd', p_sel, vsel)
                + jnp.einsum('bhcl,bhld->bhcd', p_own, vown))

    o = lax.map(chunk_fn, (q_c, sel_c, valid_c, qpos_c))
    o = o.transpose(1, 0, 3, 2, 4).reshape(B, Sp, H * HEAD_DIM)
    return o[:, :S]


def forgetting_attn(q, k, v, f_logit):
    B, S, H, _ = q.shape
    logf = jax.nn.log_sigmoid(f_logit.astype(jnp.float32))
    c = jnp.cumsum(logf, axis=1)
    cT = c.transpose(0, 2, 1)
    Q = FOX_Q_BLOCK
    nb = S // Q
    qb = q.reshape(B, nb, Q, H, HEAD_DIM).transpose(1, 0, 2, 3, 4)
    cb = c.reshape(B, nb, Q, H).transpose(1, 0, 3, 2)
    kpos = jnp.arange(S)

    def block_fn(args):
        qblk, cblk, n = args
        s = jnp.einsum('bqhd,bshd->bhqs', qblk, k,
                       preferred_element_type=jnp.float32) * SCALE
        s = s + cblk[..., None] - cT[:, :, None, :]
        qpos = n * Q + jnp.arange(Q)
        s = jnp.where((kpos[None, :] <= qpos[:, None])[None, None], s, NEG)
        p = jax.nn.softmax(s, axis=-1).astype(v.dtype)
        return jnp.einsum('bhqs,bshd->bqhd', p, v)

    o = lax.map(block_fn, (qb, cb, jnp.arange(nb)))
    return o.transpose(1, 0, 2, 3, 4).reshape(B, S, H * HEAD_DIM)


def head_rms(t, g):
    tf = t.astype(jnp.float32)
    y = tf * lax.rsqrt(jnp.mean(tf * tf, axis=-1, keepdims=True) + EPS)
    return (y * g.astype(jnp.float32)).astype(t.dtype)


def memory_kv(mem, mem_norm_g, w_mem_kv, k_gain):
    hm = rms_norm(mem, mem_norm_g)
    mk, mv = jnp.split(hm @ w_mem_kv, 2, axis=-1)
    return head_rms(split_heads(mk, MEM_HEADS), k_gain), split_heads(mv, MEM_HEADS)


def memory_cross_attn(q, mk, mv):
    B, S = q.shape[0], q.shape[1]
    s = jnp.einsum('bshd,bmhd->bhsm', q, mk, preferred_element_type=jnp.float32) * SCALE
    p = jax.nn.softmax(s, axis=-1).astype(mv.dtype)
    return jnp.einsum('bhsm,bmhd->bshd', p, mv).reshape(B, S, MEM_HEADS * HEAD_DIM)


def even_layer(x, mem, norm_g, w_in, qk_g, sinks, mem_norm_g, w_mem_kv, w_out):
    h = rms_norm(x, norm_g)
    aq, ak, av, bq, bk, bv, mq, z = split_cols(h @ w_in, EVEN_SPLIT)
    aq = head_rms(split_heads(aq, A_Q_HEADS), qk_g[0])
    ak = head_rms(split_heads(ak, A_KV_HEADS), qk_g[1])
    av = split_heads(av, A_KV_HEADS)
    bq = head_rms(split_heads(bq, B_HEADS), qk_g[2])
    bk = head_rms(split_heads(bk, B_HEADS), qk_g[3])
    bv = split_heads(bv, B_HEADS)
    mq = head_rms(split_heads(mq, MEM_HEADS), qk_g[4])
    mk, mv = memory_kv(mem, mem_norm_g, w_mem_kv, qk_g[5])
    slopes = alibi_slopes()
    ya = sliding_window_sink_attn(aq, ak, av, sinks, slopes[:A_Q_HEADS])
    yb = moba_attn(bq, bk, bv, slopes[A_Q_HEADS:])
    ym = memory_cross_attn(mq, mk, mv)
    y = jnp.concatenate([ya, yb, ym], axis=-1) * jax.nn.silu(z)
    return x + y @ w_out


def odd_layer(x, mem, norm_g, w_in, qk_g, b_f, mem_norm_g, w_mem_kv, w_out):
    h = rms_norm(x, norm_g)
    cq, ck, cv, cf, mq, z = split_cols(h @ w_in, ODD_SPLIT)
    cq = head_rms(split_heads(cq, C_HEADS), qk_g[0])
    ck = head_rms(split_heads(ck, C_HEADS), qk_g[1])
    cv = split_heads(cv, C_HEADS)
    mq = head_rms(split_heads(mq, MEM_HEADS), qk_g[2])
    mk, mv = memory_kv(mem, mem_norm_g, w_mem_kv, qk_g[3])
    yc = forgetting_attn(cq, ck, cv, cf + b_f)
    ym = memory_cross_attn(mq, mk, mv)
    y = jnp.concatenate([yc, ym], axis=-1) * jax.nn.silu(z)
    return x + y @ w_out


def setup_inputs(seed: int = 0) -> dict:
    key = jax.random.key(seed)
    ks = jax.random.split(key, 18)
    NE = (DEPTH + 1) // 2
    NO = DEPTH // 2
    D = D_MODEL
    f32 = jnp.float32

    def w(k, shape, fan_in):
        return jax.random.normal(k, shape, f32) * fan_in ** -0.5

    def gain(k, shape):
        return 1.0 + 0.02 * jax.random.normal(k, shape, f32)

    return {
        'x': jax.random.normal(ks[0], (BATCH, SEQ, D), f32),
        'mem': jax.random.normal(ks[1], (BATCH, MEM_LEN, D), f32),
        'e_norm': gain(ks[2], (NE, D)),
        'e_w_in': w(ks[3], (NE, D, EVEN_IN), D),
        'e_qk_norm': gain(ks[4], (NE, 6, HEAD_DIM)),
        'e_sinks': 0.5 * jax.random.normal(ks[5], (NE, A_Q_HEADS), f32),
        'e_mem_norm': gain(ks[6], (NE, D)),
        'e_w_mem_kv': w(ks[7], (NE, D, 2 * MEM_HEADS * HEAD_DIM), D),
        'e_w_out': w(ks[8], (NE, EVEN_MIX, D), EVEN_MIX),
        'o_norm': gain(ks[9], (NO, D)),
        'o_w_in': w(ks[10], (NO, D, ODD_IN), D),
        'o_qk_norm': gain(ks[11], (NO, 4, HEAD_DIM)),
        'o_b_f': jax.random.uniform(ks[12], (NO, C_HEADS), f32, 1.0, 3.0),
        'o_mem_norm': gain(ks[13], (NO, D)),
        'o_w_mem_kv': w(ks[14], (NO, D, 2 * MEM_HEADS * HEAD_DIM), D),
        'o_w_out': w(ks[15], (NO, ODD_MIX, D), ODD_MIX),
    }


def reference(x, mem, e_norm, e_w_in, e_qk_norm, e_sinks, e_mem_norm, e_w_mem_kv, e_w_out,
              o_norm, o_w_in, o_qk_norm, o_b_f, o_mem_norm, o_w_mem_kv, o_w_out):
    for layer in range(DEPTH):
        i = layer // 2
        if layer % 2 == 0:
            x = even_layer(x, mem, e_norm[i], e_w_in[i], e_qk_norm[i], e_sinks[i],
                           e_mem_norm[i], e_w_mem_kv[i], e_w_out[i])
        else:
            x = odd_layer(x, mem, o_norm[i], o_w_in[i], o_qk_norm[i], o_b_f[i],
                          o_mem_norm[i], o_w_mem_kv[i], o_w_out[i])
    return x
```

```cpp
#include <hip/hip_runtime.h>
#include <cstdint>
#include <cstdio>

#define GAS __attribute__((address_space(1)))
#define LAS __attribute__((address_space(3)))
typedef unsigned short bf16;
typedef unsigned v4u __attribute__((ext_vector_type(4)));
typedef unsigned v2u __attribute__((ext_vector_type(2)));
typedef float f32x4 __attribute__((ext_vector_type(4)));
typedef float f32x16 __attribute__((ext_vector_type(16)));
typedef short bf16x8 __attribute__((ext_vector_type(8)));

constexpr int BATCH = 2, SEQ = 8192, T = BATCH * SEQ, DM = 1024, HD = 64, MEML = 256;
constexpr int N0 = 3072;
constexpr int N1REF = 3596;
constexpr int N1 = 3840;
constexpr int LDP = 3584;
constexpr float EPS = 1e-6f;
constexpr float LOG2E = 1.4426950408889634f;
constexpr float C2 = 0.125f * LOG2E;
constexpr int L0_AQ = 0, L0_AK = 384, L0_AV = 512, L0_BQ = 640, L0_BK = 1024, L0_BV = 1408, L0_MQ = 1792, L0_Z = 2048;
constexpr int L1_CQ = 0, L1_CK = 768, L1_CV = 1536, L1_MQ = 2304, L1_Z = 2560, L1_CF = 3584;

constexpr size_t MiB = 1u << 20;
constexpr size_t WS_CTL = 0, CTL_ZERO_BYTES = 1 * MiB;
constexpr size_t WS_KMEAN = 512 * 1024;
constexpr size_t WS_WIN0 = 2 * MiB, WS_WOUT0 = 8 * MiB, WS_WIN1 = 10 * MiB, WS_WOUT1 = 18 * MiB;
constexpr size_t WS_SS0 = 20 * MiB, WS_SS1 = 21 * MiB;
constexpr size_t WS_LOGF = 22 * MiB;
constexpr size_t WS_MKV = 23 * MiB;
constexpr size_t MKV_ONE = (size_t)BATCH * MEML * 256 * 2;
constexpr size_t WS_XB = 24 * MiB;
constexpr size_t WS_P = 56 * MiB;
constexpr size_t WS_Y = 168 * MiB;
constexpr size_t WS_END = 200 * MiB;

__device__ __forceinline__ float bf2f(bf16 v) { return __uint_as_float((unsigned)v << 16); }
__device__ __forceinline__ unsigned f2bf(float f) { unsigned u = __float_as_uint(f); return (u + 0x7fffu + ((u >> 16) & 1u)) >> 16; }
__device__ __forceinline__ unsigned pk2(float lo, float hi) { return f2bf(lo) | (f2bf(hi) << 16); }
__device__ __forceinline__ float wave_sum(float v) {
#pragma unroll
    for (int o = 1; o < 64; o <<= 1) v += __shfl_xor(v, o);
    return v;
}
__device__ __forceinline__ float fexp2(float x) { return __builtin_amdgcn_exp2f(x); }
__device__ __forceinline__ float silu_f(float z) { return z / (1.f + __expf(-z)); }
__device__ __forceinline__ float logsig2(float f) { return LOG2E * (fminf(f, 0.f) - log1pf(__expf(-fabsf(f)))); }
__device__ __forceinline__ float alibi_slope2(int h) { return LOG2E * exp2f(-8.0f * (float)(h + 1) / 12.0f); }

struct Args {
    const float* in[16]; float* out; unsigned char* ws; int ph_lo, ph_hi;
};
constexpr int PRO_NW = 8;

__device__ __forceinline__ int l1_refcol(int n) {
    if (n < 2304) return n;
    if (n < 3584) return n + 12;
    if (n < 3596) return n - 3584 + 2304;
    return -1;
}
__device__ __forceinline__ void pro_transpose_item(const float* W, const float* g, int K, int Nref, int nblk, bf16* WT, bool remap, LAS float* scr, int item, int lane) {
    const int kb = item / nblk, nb = item % nblk, k0 = 64 * kb, n0 = 32 * nb;
    const int np = n0 + (lane & 31); const int rc = remap ? l1_refcol(np) : np;
#pragma unroll 8
    for (int i = 0; i < 32; ++i) { const int kk = 2 * i + (lane >> 5);
        float v = 0.f; if (rc >= 0) v = W[(size_t)(k0 + kk) * Nref + rc] * (g ? g[k0 + kk] : 1.f);
        scr[kk * 33 + (lane & 31)] = v; }
    asm volatile("s_waitcnt lgkmcnt(0)" ::: "memory");
    const int c = lane & 7;
#pragma unroll
    for (int j = 0; j < 4; ++j) { const int n = (lane >> 3) + 8 * j; const LAS float* s = scr + (8 * c) * 33 + n;
        v4u o; o.x = pk2(s[0 * 33], s[1 * 33]); o.y = pk2(s[2 * 33], s[3 * 33]); o.z = pk2(s[4 * 33], s[5 * 33]); o.w = pk2(s[6 * 33], s[7 * 33]);
        *(v4u*)(WT + (size_t)(n0 + n) * K + k0 + 8 * c) = o; }
    asm volatile("s_waitcnt lgkmcnt(0)" ::: "memory");
}
__device__ __forceinline__ void pro_row(const float* xrow, bf16* orow, float* ssrow, int lane) {
    const f32x4* xr = (const f32x4*)xrow + lane; f32x4 v[4]; float s = 0.f;
#pragma unroll
    for (int j = 0; j < 4; ++j) { v[j] = xr[64 * j]; s += (v[j].x * v[j].x + v[j].y * v[j].y) + (v[j].z * v[j].z + v[j].w * v[j].w); }
    s = wave_sum(s);
    v2u* o8 = (v2u*)orow + lane;
#pragma unroll
    for (int j = 0; j < 4; ++j) { v2u w; w.x = pk2(v[j].x, v[j].y); w.y = pk2(v[j].z, v[j].w); o8[64 * j] = w; }
    if (lane < 16) ssrow[lane] = lane == 0 ? s : 0.f;
}
__device__ __forceinline__ void pro_memkv_task(const float* mem, const float* gm, const float* W, const float* kg, bf16* MK, bf16* MV, int rt, int ct, LAS unsigned char* lds) {
    const int tid = threadIdx.x, lane = tid & 63, w = tid >> 6, r32 = lane & 31, hi = lane >> 5;
    LAS float* part = (LAS float*)lds; LAS float* rs = (LAS float*)(lds + 131072);
    for (int i = 0; i < 8; ++i) { const int row = rt * 64 + 8 * w + i; const f32x4* xr = (const f32x4*)(mem + (size_t)row * DM) + lane; float s = 0.f;
#pragma unroll
        for (int j = 0; j < 4; ++j) { const f32x4 v = xr[64 * j]; s += (v.x * v.x + v.y * v.y) + (v.z * v.z + v.w * v.w); }
        s = wave_sum(s); if (lane == 0) rs[8 * w + i] = rsqrtf(s * (1.f / DM) + EPS); }
    f32x16 acc[2][2];
#pragma unroll
    for (int a = 0; a < 2; ++a)
#pragma unroll
        for (int b = 0; b < 2; ++b) acc[a][b] = f32x16{};
    for (int ks = 0; ks < 8; ++ks) { const int k0 = 128 * w + 16 * ks + 8 * hi;
        bf16x8 wf[2], hf[2];
#pragma unroll
        for (int cb = 0; cb < 2; ++cb) { const float* wp = W + (size_t)k0 * 512 + ct * 64 + 32 * cb + r32;
#pragma unroll
            for (int j = 0; j < 8; ++j) wf[cb][j] = (short)f2bf(wp[(size_t)j * 512]); }
        const f32x4 g0 = *(const f32x4*)(gm + k0), g1 = *(const f32x4*)(gm + k0 + 4);
#pragma unroll
        for (int ra = 0; ra < 2; ++ra) { const float* mp = mem + (size_t)(rt * 64 + 32 * ra + r32) * DM + k0; const f32x4 a0 = *(const f32x4*)mp, a1 = *(const f32x4*)(mp + 4);
            hf[ra][0] = (short)f2bf(a0.x * g0.x); hf[ra][1] = (short)f2bf(a0.y * g0.y); hf[ra][2] = (short)f2bf(a0.z * g0.z); hf[ra][3] = (short)f2bf(a0.w * g0.w);
            hf[ra][4] = (short)f2bf(a1.x * g1.x); hf[ra][5] = (short)f2bf(a1.y * g1.y); hf[ra][6] = (short)f2bf(a1.z * g1.z); hf[ra][7] = (short)f2bf(a1.w * g1.w); }
#pragma unroll
        for (int cb = 0; cb < 2; ++cb)
#pragma unroll
            for (int ra = 0; ra < 2; ++ra) acc[cb][ra] = __builtin_amdgcn_mfma_f32_32x32x16_bf16(wf[cb], hf[ra], acc[cb][ra], 0, 0, 0);
    }
#pragma unroll
    for (int cb = 0; cb < 2; ++cb)
#pragma unroll
        for (int ra = 0; ra < 2; ++ra)
#pragma unroll
            for (int r = 0; r < 16; ++r) { const int n = 32 * cb + (r & 3) + 8 * (r >> 2) + 4 * hi; part[(w * 64 + 32 * ra + r32) * 64 + n] = acc[cb][ra][r]; }
    __syncthreads();
    { const int tok = tid >> 3, c0 = (tid & 7) * 8; float v[8];
#pragma unroll
      for (int i = 0; i < 8; ++i) v[i] = 0.f;
      for (int ww = 0; ww < 8; ++ww) {
#pragma unroll
          for (int i = 0; i < 8; ++i) v[i] += part[(ww * 64 + tok) * 64 + c0 + i]; }
      const float r = rs[tok]; float ss = 0.f;
#pragma unroll
      for (int i = 0; i < 8; ++i) { v[i] *= r; ss += v[i] * v[i]; }
      ss += __shfl_xor(ss, 1); ss += __shfl_xor(ss, 2); ss += __shfl_xor(ss, 4);
      const int row = rt * 64 + tok;
      bf16* dst;
      if (ct < 4) { const float inv = rsqrtf(ss * (1.f / 64.f) + EPS);
#pragma unroll
          for (int i = 0; i < 8; ++i) v[i] *= inv * kg[c0 + i];
          dst = MK + (size_t)row * 256 + ct * 64 + c0; }
      else dst = MV + (size_t)row * 256 + (ct - 4) * 64 + c0;
      v4u o; o.x = pk2(v[0], v[1]); o.y = pk2(v[2], v[3]); o.z = pk2(v[4], v[5]); o.w = pk2(v[6], v[7]); *(v4u*)dst = o; }
    __syncthreads();
}

__device__ __forceinline__ void phase_prologue(const Args& a, LAS unsigned char* lds, int vcu, int G) {
    const int tid = threadIdx.x, lane = tid & 63, wave = __builtin_amdgcn_readfirstlane(tid >> 6);
    unsigned char* ws = a.ws;
    for (int wt = (G - 1 - vcu); wt < 128; wt += G) { const int layer = wt >> 6, rt = (wt >> 3) & 7, ct = wt & 7;
        const float* gm = layer ? a.in[13] : a.in[6]; const float* W = layer ? a.in[14] : a.in[7];
        const float* kg = layer ? a.in[11] + 3 * 64 : a.in[4] + 5 * 64;
        bf16* MK = (bf16*)(ws + WS_MKV + (size_t)(2 * layer) * MKV_ONE); bf16* MV = (bf16*)(ws + WS_MKV + (size_t)(2 * layer + 1) * MKV_ONE);
        pro_memkv_task(a.in[1], gm, W, kg, MK, MV, rt, ct, lds); }
    LAS float* scr = (LAS float*)(lds + wave * 16384);
    const int gw = vcu * PRO_NW + wave, NGW = G * PRO_NW;
    constexpr int I_IN0 = 16 * (N0 / 32), I_OUT = 16 * (DM / 32), I_IN1 = 16 * (N1 / 32);
    constexpr int NITEMS = I_IN0 + I_OUT + I_IN1 + I_OUT;
    for (int it = gw; it < NITEMS; it += NGW) { int r = it;
        if (r < I_IN0) { pro_transpose_item(a.in[3], a.in[2], DM, N0, N0 / 32, (bf16*)(ws + WS_WIN0), false, scr, r, lane); continue; } r -= I_IN0;
        if (r < I_OUT) { pro_transpose_item(a.in[8], nullptr, DM, DM, DM / 32, (bf16*)(ws + WS_WOUT0), false, scr, r, lane); continue; } r -= I_OUT;
        if (r < I_IN1) { pro_transpose_item(a.in[10], a.in[9], DM, N1REF, N1 / 32, (bf16*)(ws + WS_WIN1), true, scr, r, lane); continue; } r -= I_IN1;
        pro_transpose_item(a.in[15], nullptr, DM, DM, DM / 32, (bf16*)(ws + WS_WOUT1), false, scr, r, lane); }
    const float* x = a.in[0]; bf16* XB = (bf16*)(ws + WS_XB); float* SS0 = (float*)(ws + WS_SS0);
    for (int m = gw; m < T; m += NGW) pro_row(x + (size_t)m * DM, XB + (size_t)m * DM, SS0 + (size_t)m * 16, lane);
}
enum { HK_QNORM = 0, HK_KNORM = 1, HK_PLAIN = 2, HK_SILU = 3, HK_BK = 4, HK_CF = 5, HK_NONE = 6 };
struct HeadInfo { int kind; int gidx; int dstcol; };
__device__ __forceinline__ HeadInfo head_info(int layer, int hh) {
    HeadInfo h; h.dstcol = hh * 64; h.gidx = 0;
    if (layer == 0) {
        if (hh < 6) { h.kind = HK_QNORM; h.gidx = 0; } else if (hh < 8) { h.kind = HK_KNORM; h.gidx = 1; } else if (hh < 10) h.kind = HK_PLAIN;
        else if (hh < 16) { h.kind = HK_QNORM; h.gidx = 2; } else if (hh < 22) { h.kind = HK_BK; h.gidx = 3; } else if (hh < 28) h.kind = HK_PLAIN;
        else if (hh < 32) { h.kind = HK_QNORM; h.gidx = 4; } else h.kind = HK_SILU;
    } else {
        if (hh < 12) { h.kind = HK_QNORM; h.gidx = 0; } else if (hh < 24) { h.kind = HK_KNORM; h.gidx = 1; } else if (hh < 36) h.kind = HK_PLAIN;
        else if (hh < 40) { h.kind = HK_QNORM; h.gidx = 2; } else if (hh < 56) h.kind = HK_SILU; else if (hh == 56) h.kind = HK_CF; else h.kind = HK_NONE;
    }
    return h;
}

__global__ void __launch_bounds__(64) naive_inproj(int layer, const bf16* XB, const bf16* Wt, const float* SS, const float* qkg, const float* bfp, bf16* P, float* kmean, float* logf2) {
    const int row = blockIdx.x * 64 + threadIdx.x, hh = blockIdx.y; const HeadInfo hi = head_info(layer, hh);
    if (hi.kind == HK_NONE) return;
    float acc[64];
#pragma unroll
    for (int c = 0; c < 64; ++c) acc[c] = 0.f;
    const bf16* xr = XB + (size_t)row * DM; const bf16* wr = Wt + (size_t)hh * 64 * DM;
    for (int k = 0; k < DM; k += 2) { const unsigned xv = *(const unsigned*)(xr + k); const float x0 = __uint_as_float(xv << 16), x1 = __uint_as_float(xv & 0xffff0000u);
#pragma unroll
        for (int c = 0; c < 64; ++c) { const unsigned wv = *(const unsigned*)(wr + (size_t)c * DM + k); acc[c] += x0 * __uint_as_float(wv << 16) + x1 * __uint_as_float(wv & 0xffff0000u); } }
    float ss = 0.f;
#pragma unroll
    for (int j = 0; j < 16; ++j) ss += SS[(size_t)row * 16 + j];
    const float rstd = rsqrtf(ss * (1.f / DM) + EPS);
#pragma unroll
    for (int c = 0; c < 64; ++c) acc[c] *= rstd;
    if (hi.kind == HK_CF) { const int b = row / SEQ, t = row % SEQ;
#pragma unroll
        for (int c = 0; c < 12; ++c) logf2[((size_t)b * 12 + c) * SEQ + t] = logsig2(acc[c] + bfp[c]);
        return; }
    if (hi.kind == HK_QNORM || hi.kind == HK_KNORM || hi.kind == HK_BK) { float q = 0.f;
#pragma unroll
        for (int c = 0; c < 64; ++c) q += acc[c] * acc[c];
        const float inv = rsqrtf(q * (1.f / 64.f) + EPS) * (hi.kind == HK_QNORM ? C2 : 1.f);
#pragma unroll
        for (int c = 0; c < 64; ++c) acc[c] *= inv * qkg[hi.gidx * 64 + c]; }
    if (hi.kind == HK_SILU) {
#pragma unroll
        for (int c = 0; c < 64; ++c) acc[c] = silu_f(acc[c]); }
    if (hi.kind == HK_BK) { const int b = row / SEQ, blk = (row % SEQ) / 256, h = hh - 16;
#pragma unroll
        for (int c = 0; c < 64; ++c) atomicAdd(&kmean[(((size_t)b * 6 + h) * 32 + blk) * 64 + c], acc[c]); }
    bf16* pr = P + (size_t)row * LDP + hi.dstcol;
#pragma unroll
    for (int c = 0; c < 64; c += 2) *(unsigned*)(pr + c) = pk2(acc[c], acc[c + 1]);
}

__device__ __forceinline__ void nv_loadq(float (&q)[64], const bf16* p) {
#pragma unroll
    for (int d = 0; d < 64; d += 2) { const unsigned v = *(const unsigned*)(p + d); q[d] = __uint_as_float(v << 16); q[d + 1] = __uint_as_float(v & 0xffff0000u); }
}
__device__ __forceinline__ float nv_dot(const float (&q)[64], const bf16* p) { float s = 0.f;
#pragma unroll
    for (int d = 0; d < 64; d += 2) { const unsigned v = *(const unsigned*)(p + d); s += q[d] * __uint_as_float(v << 16) + q[d + 1] * __uint_as_float(v & 0xffff0000u); }
    return s; }
__device__ __forceinline__ void nv_axpy(float (&o)[64], float p, const bf16* vp) {
#pragma unroll
    for (int d = 0; d < 64; d += 2) { const unsigned v = *(const unsigned*)(vp + d); o[d] += p * __uint_as_float(v << 16); o[d + 1] += p * __uint_as_float(v & 0xffff0000u); }
}
__device__ __forceinline__ void nv_store_y(const float (&o)[64], float l, const bf16* zp, bf16* yp) { const float il = 1.f / l;
#pragma unroll
    for (int d = 0; d < 64; d += 2) { const unsigned z = *(const unsigned*)(zp + d); *(unsigned*)(yp + d) = pk2(o[d] * il * __uint_as_float(z << 16), o[d + 1] * il * __uint_as_float(z & 0xffff0000u)); }
}
__global__ void __launch_bounds__(64) naive_attn(int layer, const bf16* P, const bf16* MK, const bf16* MV, const float* kmean, const float* sinks, const float* logf2, bf16* Y) {
    const int row = blockIdx.x * 64 + threadIdx.x, h = blockIdx.y, b = row / SEQ, t = row % SEQ;
    const bf16* prow = P + (size_t)row * LDP; const bf16* Pb = P + (size_t)b * SEQ * LDP;
    float q[64], o[64]; float l = 0.f;
#pragma unroll
    for (int d = 0; d < 64; ++d) o[d] = 0.f;
    const int zcol = (layer == 0 ? L0_Z : L1_Z) + h * 64;
    if (h >= 12) {
        const int hm = h - 12; nv_loadq(q, prow + (layer == 0 ? L0_MQ : L1_MQ) + hm * 64);
        for (int m = 0; m < MEML; ++m) { const size_t off = ((size_t)b * MEML + m) * 256 + hm * 64; const float p = fexp2(nv_dot(q, MK + off)); l += p; nv_axpy(o, p, MV + off); }
    } else if (layer == 1) {
        nv_loadq(q, prow + L1_CQ + h * 64); const float* lf = logf2 + ((size_t)b * 12 + h) * SEQ; float dacc = 0.f;
        for (int s = t; s >= 0; --s) { if (s < t) dacc += lf[s + 1]; if (dacc < -300.f) break;
            const bf16* kr = Pb + (size_t)s * LDP; const float p = fexp2(nv_dot(q, kr + L1_CK + h * 64) + dacc); l += p; nv_axpy(o, p, kr + L1_CV + h * 64); }
    } else if (h < 6) {
        nv_loadq(q, prow + L0_AQ + h * 64); const int kvh = h / 3; const float sl = alibi_slope2(h);
        const int s0 = t - 127 < 0 ? 0 : t - 127;
        for (int s = s0; s <= t; ++s) { const bf16* kr = Pb + (size_t)s * LDP; const float p = fexp2(nv_dot(q, kr + L0_AK + kvh * 64) - sl * (float)(t - s)); l += p; nv_axpy(o, p, kr + L0_AV + kvh * 64); }
        l += fexp2(LOG2E * sinks[h]);
    } else {
        const int hb = h - 6; nv_loadq(q, prow + L0_BQ + hb * 64); const float sl = alibi_slope2(h); const int blk = t / 256;
        unsigned chosen = 0u; const int nsel = blk < 3 ? blk : 3;
        for (int i = 0; i < nsel; ++i) { int best = -1; float bestv = -3.0e38f;
            for (int j = 0; j < blk; ++j) { if ((chosen >> j) & 1u) continue; const float* km = kmean + (((size_t)b * 6 + hb) * 32 + j) * 64; float g = 0.f;
#pragma unroll
                for (int d = 0; d < 64; ++d) g += q[d] * km[d];
                if (g > bestv) { bestv = g; best = j; } }
            chosen |= 1u << best; }
        chosen |= 1u << blk;
        for (int j = 0; j <= blk; ++j) { if (!((chosen >> j) & 1u)) continue; const int e = (j == blk) ? t : 256 * j + 255;
            for (int s = 256 * j; s <= e; ++s) { const bf16* kr = Pb + (size_t)s * LDP; const float p = fexp2(nv_dot(q, kr + L0_BK + hb * 64) - sl * (float)(t - s)); l += p; nv_axpy(o, p, kr + L0_BV + hb * 64); } }
    }
    nv_store_y(o, l, prow + zcol, Y + (size_t)row * DM + h * 64);
}

__global__ void __launch_bounds__(64) naive_outproj(const bf16* Y, const bf16* Wt, const float* xin, float* xout, bf16* XB, float* SS) {
    const int row = blockIdx.x * 64 + threadIdx.x, g = blockIdx.y;
    float acc[64];
#pragma unroll
    for (int c = 0; c < 64; ++c) acc[c] = 0.f;
    const bf16* yr = Y + (size_t)row * DM; const bf16* wr = Wt + (size_t)g * 64 * DM;
    for (int k = 0; k < DM; k += 2) { const unsigned xv = *(const unsigned*)(yr + k); const float x0 = __uint_as_float(xv << 16), x1 = __uint_as_float(xv & 0xffff0000u);
#pragma unroll
        for (int c = 0; c < 64; ++c) { const unsigned wv = *(const unsigned*)(wr + (size_t)c * DM + k); acc[c] += x0 * __uint_as_float(wv << 16) + x1 * __uint_as_float(wv & 0xffff0000u); } }
    float ss = 0.f; const size_t off = (size_t)row * DM + g * 64;
#pragma unroll
    for (int c = 0; c < 64; ++c) { acc[c] += xin[off + c]; ss += acc[c] * acc[c]; xout[off + c] = acc[c]; }
    if (XB) {
#pragma unroll
        for (int c = 0; c < 64; c += 2) *(unsigned*)(XB + off + c) = pk2(acc[c], acc[c + 1]);
        SS[(size_t)row * 16 + g] = ss; }
}
constexpr int LDS_BYTES = 147456;
__global__ void __launch_bounds__(512, 2) mk_fwd(Args a) {
    extern __shared__ __attribute__((aligned(16))) unsigned char lds_raw[];
    LAS unsigned char* lds = (LAS unsigned char*)lds_raw;
    const int G = gridDim.x, bx = blockIdx.x; const int vcu = (G % 8 == 0) ? (bx % 8) * (G / 8) + bx / 8 : bx;
    if (a.ph_lo <= 0 && 0 < a.ph_hi) phase_prologue(a, lds, vcu, G);
}

extern "C" void kernel_launch(void* const* d_in, const int* in_sizes, int n_in, void* d_out, int out_size, void* d_ws, size_t ws_size, hipStream_t stream) {
    static int grid = 0;
    if (grid == 0) {
        if (n_in != 16 || out_size != T * DM || ws_size < WS_END) { fprintf(stderr, "kernel_launch: unexpected shapes (n_in %d out %d ws %zu)\n", n_in, out_size, ws_size); grid = -1; return; }
        int dev = 0, cus = 0, per_cu = 0;
        hipGetDevice(&dev); hipDeviceGetAttribute(&cus, hipDeviceAttributeMultiprocessorCount, dev);
        hipFuncSetAttribute((const void*)mk_fwd, hipFuncAttributeMaxDynamicSharedMemorySize, LDS_BYTES);
        hipOccupancyMaxActiveBlocksPerMultiprocessor(&per_cu, (const void*)mk_fwd, 512, LDS_BYTES);
        (void)hipGetLastError();
        grid = cus * (per_cu >= 1 ? 1 : 0); if (grid <= 0) { fprintf(stderr, "kernel_launch: occupancy query says 0\n"); grid = -1; return; }
    }
    if (grid < 0) return;
    unsigned char* ws = (unsigned char*)d_ws;
    hipMemsetAsync(ws + WS_CTL, 0, CTL_ZERO_BYTES, stream);
    Args a{}; for (int i = 0; i < 16; ++i) a.in[i] = (const float*)d_in[i];
    a.out = (float*)d_out; a.ws = ws; a.ph_lo = 0; a.ph_hi = 1;
    hipLaunchKernelGGL(mk_fwd, dim3(grid), dim3(512), LDS_BYTES, stream, a);
    const bf16* XB = (const bf16*)(ws + WS_XB); bf16* P = (bf16*)(ws + WS_P); bf16* Y = (bf16*)(ws + WS_Y);
    float* kmean = (float*)(ws + WS_KMEAN); float* logf2 = (float*)(ws + WS_LOGF);
    const bf16* MK0 = (const bf16*)(ws + WS_MKV); const bf16* MV0 = (const bf16*)(ws + WS_MKV + MKV_ONE); const bf16* MK1 = (const bf16*)(ws + WS_MKV + 2 * MKV_ONE); const bf16* MV1 = (const bf16*)(ws + WS_MKV + 3 * MKV_ONE);
    hipLaunchKernelGGL(naive_inproj, dim3(T / 64, 48), dim3(64), 0, stream, 0, XB, (const bf16*)(ws + WS_WIN0), (const float*)(ws + WS_SS0), a.in[4], (const float*)nullptr, P, kmean, logf2);
    hipLaunchKernelGGL(naive_attn, dim3(T / 64, 16), dim3(64), 0, stream, 0, (const bf16*)P, MK0, MV0, (const float*)kmean, a.in[5], (const float*)logf2, Y);
    hipLaunchKernelGGL(naive_outproj, dim3(T / 64, 16), dim3(64), 0, stream, (const bf16*)Y, (const bf16*)(ws + WS_WOUT0), a.in[0], a.out, (bf16*)(ws + WS_XB), (float*)(ws + WS_SS1));
    hipLaunchKernelGGL(naive_inproj, dim3(T / 64, 60), dim3(64), 0, stream, 1, XB, (const bf16*)(ws + WS_WIN1), (const float*)(ws + WS_SS1), a.in[11], a.in[12], P, kmean, logf2);
    hipLaunchKernelGGL(naive_attn, dim3(T / 64, 16), dim3(64), 0, stream, 1, (const bf16*)P, MK1, MV1, (const float*)kmean, a.in[5], (const float*)logf2, Y);
    hipLaunchKernelGGL(naive_outproj, dim3(T / 64, 16), dim3(64), 0, stream, (const bf16*)Y, (const bf16*)(ws + WS_WOUT1), (const float*)a.out, a.out, (bf16*)nullptr, (float*)nullptr);
}
```

```cpp
#include <hip/hip_runtime.h>
#include <cstdint>
#include <cstdio>

#define GAS __attribute__((address_space(1)))
#define LAS __attribute__((address_space(3)))
typedef unsigned short bf16;
typedef unsigned v4u __attribute__((ext_vector_type(4)));
typedef unsigned u32x4 __attribute__((ext_vector_type(4)));
typedef unsigned v2u __attribute__((ext_vector_type(2)));
typedef float f32x4 __attribute__((ext_vector_type(4)));
typedef float f32x16 __attribute__((ext_vector_type(16)));
typedef short bf16x8 __attribute__((ext_vector_type(8)));

constexpr int BATCH = 2, SEQ = 8192, T = BATCH * SEQ, DM = 1024, HD = 64, MEML = 256;
constexpr int N0 = 3072;
constexpr int N1REF = 3596;
constexpr int N1 = 3840;
constexpr int LDP = 3584;
constexpr float EPS = 1e-6f;
constexpr float LOG2E = 1.4426950408889634f;
constexpr float C2 = 0.125f * LOG2E;
constexpr int L0_AQ = 0, L0_AK = 384, L0_AV = 512, L0_BQ = 640, L0_BK = 1024, L0_BV = 1408, L0_MQ = 1792, L0_Z = 2048;
constexpr int L1_CQ = 0, L1_CK = 768, L1_CV = 1536, L1_MQ = 2304, L1_Z = 2560, L1_CF = 3584;

constexpr size_t MiB = 1u << 20;
constexpr size_t WS_CTL = 0, CTL_ZERO_BYTES = 1 * MiB;
constexpr size_t WS_KMEAN = 512 * 1024;
constexpr size_t WS_WIN0 = 2 * MiB, WS_WOUT0 = 8 * MiB, WS_WIN1 = 10 * MiB, WS_WOUT1 = 18 * MiB;
constexpr size_t WS_SS0 = 20 * MiB, WS_SS1 = 21 * MiB;
constexpr size_t WS_LOGF = 22 * MiB;
constexpr size_t WS_MKV = 23 * MiB;
constexpr size_t MKV_ONE = (size_t)BATCH * MEML * 256 * 2;
constexpr size_t WS_XB = 24 * MiB;
constexpr size_t WS_P = 56 * MiB;
constexpr size_t WS_Y = 168 * MiB;
constexpr size_t WS_END = 200 * MiB;

__device__ __forceinline__ float bf2f(bf16 v) { return __uint_as_float((unsigned)v << 16); }
__device__ __forceinline__ unsigned f2bf(float f) { unsigned u = __float_as_uint(f); return (u + 0x7fffu + ((u >> 16) & 1u)) >> 16; }
__device__ __forceinline__ unsigned pk2(float lo, float hi) { return f2bf(lo) | (f2bf(hi) << 16); }
__device__ __forceinline__ float wave_sum(float v) {
#pragma unroll
    for (int o = 1; o < 64; o <<= 1) v += __shfl_xor(v, o);
    return v;
}
__device__ __forceinline__ float fexp2(float x) { return __builtin_amdgcn_exp2f(x); }
__device__ __forceinline__ float silu_f(float z) { return z / (1.f + __expf(-z)); }
__device__ __forceinline__ float logsig2(float f) { return LOG2E * (fminf(f, 0.f) - log1pf(__expf(-fabsf(f)))); }
__device__ __forceinline__ float alibi_slope2(int h) { return LOG2E * exp2f(-8.0f * (float)(h + 1) / 12.0f); }

struct Args {
    const float* in[16]; float* out; unsigned char* ws; int ph_lo, ph_hi;
};
constexpr int PRO_NW = 8;

__device__ __forceinline__ int l1_refcol(int n) {
    if (n < 2304) return n;
    if (n < 3584) return n + 12;
    if (n < 3596) return n - 3584 + 2304;
    return -1;
}
__device__ __forceinline__ void pro_transpose_item(const float* W, const float* g, int K, int Nref, int nblk, bf16* WT, bool remap, LAS float* scr, int item, int lane) {
    const int kb = item / nblk, nb = item % nblk, k0 = 64 * kb, n0 = 32 * nb;
    const int np = n0 + (lane & 31); const int rc = remap ? l1_refcol(np) : np;
#pragma unroll 8
    for (int i = 0; i < 32; ++i) { const int kk = 2 * i + (lane >> 5);
        float v = 0.f; if (rc >= 0) v = W[(size_t)(k0 + kk) * Nref + rc] * (g ? g[k0 + kk] : 1.f);
        scr[kk * 33 + (lane & 31)] = v; }
    asm volatile("s_waitcnt lgkmcnt(0)" ::: "memory");
    const int c = lane & 7;
#pragma unroll
    for (int j = 0; j < 4; ++j) { const int n = (lane >> 3) + 8 * j; const LAS float* s = scr + (8 * c) * 33 + n;
        v4u o; o.x = pk2(s[0 * 33], s[1 * 33]); o.y = pk2(s[2 * 33], s[3 * 33]); o.z = pk2(s[4 * 33], s[5 * 33]); o.w = pk2(s[6 * 33], s[7 * 33]);
        *(v4u*)(WT + (size_t)(n0 + n) * K + k0 + 8 * c) = o; }
    asm volatile("s_waitcnt lgkmcnt(0)" ::: "memory");
}
__device__ __forceinline__ void pro_row(const float* xrow, bf16* orow, float* ssrow, int lane) {
    const f32x4* xr = (const f32x4*)xrow + lane; f32x4 v[4]; float s = 0.f;
#pragma unroll
    for (int j = 0; j < 4; ++j) { v[j] = xr[64 * j]; s += (v[j].x * v[j].x + v[j].y * v[j].y) + (v[j].z * v[j].z + v[j].w * v[j].w); }
    s = wave_sum(s);
    v2u* o8 = (v2u*)orow + lane;
#pragma unroll
    for (int j = 0; j < 4; ++j) { v2u w; w.x = pk2(v[j].x, v[j].y); w.y = pk2(v[j].z, v[j].w); o8[64 * j] = w; }
    if (lane < 16) ssrow[lane] = lane == 0 ? s : 0.f;
}
__device__ __forceinline__ void pro_memkv_task(const float* mem, const float* gm, const float* W, const float* kg, bf16* MK, bf16* MV, int rt, int ct, LAS unsigned char* lds) {
    const int tid = threadIdx.x, lane = tid & 63, w = tid >> 6, r32 = lane & 31, hi = lane >> 5;
    LAS float* part = (LAS float*)lds; LAS float* rs = (LAS float*)(lds + 131072);
    for (int i = 0; i < 8; ++i) { const int row = rt * 64 + 8 * w + i; const f32x4* xr = (const f32x4*)(mem + (size_t)row * DM) + lane; float s = 0.f;
#pragma unroll
        for (int j = 0; j < 4; ++j) { const f32x4 v = xr[64 * j]; s += (v.x * v.x + v.y * v.y) + (v.z * v.z + v.w * v.w); }
        s = wave_sum(s); if (lane == 0) rs[8 * w + i] = rsqrtf(s * (1.f / DM) + EPS); }
    f32x16 acc[2][2];
#pragma unroll
    for (int a = 0; a < 2; ++a)
#pragma unroll
        for (int b = 0; b < 2; ++b) acc[a][b] = f32x16{};
    for (int ks = 0; ks < 8; ++ks) { const int k0 = 128 * w + 16 * ks + 8 * hi;
        bf16x8 wf[2], hf[2];
#pragma unroll
        for (int cb = 0; cb < 2; ++cb) { const float* wp = W + (size_t)k0 * 512 + ct * 64 + 32 * cb + r32;
#pragma unroll
            for (int j = 0; j < 8; ++j) wf[cb][j] = (short)f2bf(wp[(size_t)j * 512]); }
        const f32x4 g0 = *(const f32x4*)(gm + k0), g1 = *(const f32x4*)(gm + k0 + 4);
#pragma unroll
        for (int ra = 0; ra < 2; ++ra) { const float* mp = mem + (size_t)(rt * 64 + 32 * ra + r32) * DM + k0; const f32x4 a0 = *(const f32x4*)mp, a1 = *(const f32x4*)(mp + 4);
            hf[ra][0] = (short)f2bf(a0.x * g0.x); hf[ra][1] = (short)f2bf(a0.y * g0.y); hf[ra][2] = (short)f2bf(a0.z * g0.z); hf[ra][3] = (short)f2bf(a0.w * g0.w);
            hf[ra][4] = (short)f2bf(a1.x * g1.x); hf[ra][5] = (short)f2bf(a1.y * g1.y); hf[ra][6] = (short)f2bf(a1.z * g1.z); hf[ra][7] = (short)f2bf(a1.w * g1.w); }
#pragma unroll
        for (int cb = 0; cb < 2; ++cb)
#pragma unroll
            for (int ra = 0; ra < 2; ++ra) acc[cb][ra] = __builtin_amdgcn_mfma_f32_32x32x16_bf16(wf[cb], hf[ra], acc[cb][ra], 0, 0, 0);
    }
#pragma unroll
    for (int cb = 0; cb < 2; ++cb)
#pragma unroll
        for (int ra = 0; ra < 2; ++ra)
#pragma unroll
            for (int r = 0; r < 16; ++r) { const int n = 32 * cb + (r & 3) + 8 * (r >> 2) + 4 * hi; part[(w * 64 + 32 * ra + r32) * 64 + n] = acc[cb][ra][r]; }
    __syncthreads();
    { const int tok = tid >> 3, c0 = (tid & 7) * 8; float v[8];
#pragma unroll
      for (int i = 0; i < 8; ++i) v[i] = 0.f;
      for (int ww = 0; ww < 8; ++ww) {
#pragma unroll
          for (int i = 0; i < 8; ++i) v[i] += part[(ww * 64 + tok) * 64 + c0 + i]; }
      const float r = rs[tok]; float ss = 0.f;
#pragma unroll
      for (int i = 0; i < 8; ++i) { v[i] *= r; ss += v[i] * v[i]; }
      ss += __shfl_xor(ss, 1); ss += __shfl_xor(ss, 2); ss += __shfl_xor(ss, 4);
      const int row = rt * 64 + tok;
      bf16* dst;
      if (ct < 4) { const float inv = rsqrtf(ss * (1.f / 64.f) + EPS);
#pragma unroll
          for (int i = 0; i < 8; ++i) v[i] *= inv * kg[c0 + i];
          dst = MK + (size_t)row * 256 + ct * 64 + c0; }
      else dst = MV + (size_t)row * 256 + (ct - 4) * 64 + c0;
      v4u o; o.x = pk2(v[0], v[1]); o.y = pk2(v[2], v[3]); o.z = pk2(v[4], v[5]); o.w = pk2(v[6], v[7]); *(v4u*)dst = o; }
    __syncthreads();
}

__device__ __forceinline__ void phase_prologue(const Args& a, LAS unsigned char* lds, int vcu, int G) {
    const int tid = threadIdx.x, lane = tid & 63, wave = __builtin_amdgcn_readfirstlane(tid >> 6);
    unsigned char* ws = a.ws;
    for (int wt = (G - 1 - vcu); wt < 128; wt += G) { const int layer = wt >> 6, rt = (wt >> 3) & 7, ct = wt & 7;
        const float* gm = layer ? a.in[13] : a.in[6]; const float* W = layer ? a.in[14] : a.in[7];
        const float* kg = layer ? a.in[11] + 3 * 64 : a.in[4] + 5 * 64;
        bf16* MK = (bf16*)(ws + WS_MKV + (size_t)(2 * layer) * MKV_ONE); bf16* MV = (bf16*)(ws + WS_MKV + (size_t)(2 * layer + 1) * MKV_ONE);
        pro_memkv_task(a.in[1], gm, W, kg, MK, MV, rt, ct, lds); }
    LAS float* scr = (LAS float*)(lds + wave * 16384);
    const int gw = vcu * PRO_NW + wave, NGW = G * PRO_NW;
    constexpr int I_IN0 = 16 * (N0 / 32), I_OUT = 16 * (DM / 32), I_IN1 = 16 * (N1 / 32);
    constexpr int NITEMS = I_IN0 + I_OUT + I_IN1 + I_OUT;
    for (int it = gw; it < NITEMS; it += NGW) { int r = it;
        if (r < I_IN0) { pro_transpose_item(a.in[3], a.in[2], DM, N0, N0 / 32, (bf16*)(ws + WS_WIN0), false, scr, r, lane); continue; } r -= I_IN0;
        if (r < I_OUT) { pro_transpose_item(a.in[8], nullptr, DM, DM, DM / 32, (bf16*)(ws + WS_WOUT0), false, scr, r, lane); continue; } r -= I_OUT;
        if (r < I_IN1) { pro_transpose_item(a.in[10], a.in[9], DM, N1REF, N1 / 32, (bf16*)(ws + WS_WIN1), true, scr, r, lane); continue; } r -= I_IN1;
        pro_transpose_item(a.in[15], nullptr, DM, DM, DM / 32, (bf16*)(ws + WS_WOUT1), false, scr, r, lane); }
    const float* x = a.in[0]; bf16* XB = (bf16*)(ws + WS_XB); float* SS0 = (float*)(ws + WS_SS0);
    for (int m = gw; m < T; m += NGW) pro_row(x + (size_t)m * DM, XB + (size_t)m * DM, SS0 + (size_t)m * 16, lane);
}
enum { HK_QNORM = 0, HK_KNORM = 1, HK_PLAIN = 2, HK_SILU = 3, HK_BK = 4, HK_CF = 5, HK_NONE = 6 };
struct HeadInfo { int kind; int gidx; int dstcol; };
__device__ __forceinline__ HeadInfo head_info(int layer, int hh) {
    HeadInfo h; h.dstcol = hh * 64; h.gidx = 0;
    if (layer == 0) {
        if (hh < 6) { h.kind = HK_QNORM; h.gidx = 0; } else if (hh < 8) { h.kind = HK_KNORM; h.gidx = 1; } else if (hh < 10) h.kind = HK_PLAIN;
        else if (hh < 16) { h.kind = HK_QNORM; h.gidx = 2; } else if (hh < 22) { h.kind = HK_BK; h.gidx = 3; } else if (hh < 28) h.kind = HK_PLAIN;
        else if (hh < 32) { h.kind = HK_QNORM; h.gidx = 4; } else h.kind = HK_SILU;
    } else {
        if (hh < 12) { h.kind = HK_QNORM; h.gidx = 0; } else if (hh < 24) { h.kind = HK_KNORM; h.gidx = 1; } else if (hh < 36) h.kind = HK_PLAIN;
        else if (hh < 40) { h.kind = HK_QNORM; h.gidx = 2; } else if (hh < 56) h.kind = HK_SILU; else if (hh == 56) h.kind = HK_CF; else h.kind = HK_NONE;
    }
    return h;
}

__global__ void __launch_bounds__(64) naive_inproj(int layer, const bf16* XB, const bf16* Wt, const float* SS, const float* qkg, const float* bfp, bf16* P, float* kmean, float* logf2) {
    const int row = blockIdx.x * 64 + threadIdx.x, hh = blockIdx.y; const HeadInfo hi = head_info(layer, hh);
    if (hi.kind == HK_NONE) return;
    float acc[64];
#pragma unroll
    for (int c = 0; c < 64; ++c) acc[c] = 0.f;
    const bf16* xr = XB + (size_t)row * DM; const bf16* wr = Wt + (size_t)hh * 64 * DM;
    for (int k = 0; k < DM; k += 2) { const unsigned xv = *(const unsigned*)(xr + k); const float x0 = __uint_as_float(xv << 16), x1 = __uint_as_float(xv & 0xffff0000u);
#pragma unroll
        for (int c = 0; c < 64; ++c) { const unsigned wv = *(const unsigned*)(wr + (size_t)c * DM + k); acc[c] += x0 * __uint_as_float(wv << 16) + x1 * __uint_as_float(wv & 0xffff0000u); } }
    float ss = 0.f;
#pragma unroll
    for (int j = 0; j < 16; ++j) ss += SS[(size_t)row * 16 + j];
    const float rstd = rsqrtf(ss * (1.f / DM) + EPS);
#pragma unroll
    for (int c = 0; c < 64; ++c) acc[c] *= rstd;
    if (hi.kind == HK_CF) { const int b = row / SEQ, t = row % SEQ;
#pragma unroll
        for (int c = 0; c < 12; ++c) logf2[((size_t)b * 12 + c) * SEQ + t] = logsig2(acc[c] + bfp[c]);
        return; }
    if (hi.kind == HK_QNORM || hi.kind == HK_KNORM || hi.kind == HK_BK) { float q = 0.f;
#pragma unroll
        for (int c = 0; c < 64; ++c) q += acc[c] * acc[c];
        const float inv = rsqrtf(q * (1.f / 64.f) + EPS) * (hi.kind == HK_QNORM ? C2 : 1.f);
#pragma unroll
        for (int c = 0; c < 64; ++c) acc[c] *= inv * qkg[hi.gidx * 64 + c]; }
    if (hi.kind == HK_SILU) {
#pragma unroll
        for (int c = 0; c < 64; ++c) acc[c] = silu_f(acc[c]); }
    if (hi.kind == HK_BK) { const int b = row / SEQ, blk = (row % SEQ) / 256, h = hh - 16;
#pragma unroll
        for (int c = 0; c < 64; ++c) atomicAdd(&kmean[(((size_t)b * 6 + h) * 32 + blk) * 64 + c], acc[c]); }
    bf16* pr = P + (size_t)row * LDP + hi.dstcol;
#pragma unroll
    for (int c = 0; c < 64; c += 2) *(unsigned*)(pr + c) = pk2(acc[c], acc[c + 1]);
}

__device__ __forceinline__ void nv_loadq(float (&q)[64], const bf16* p) {
#pragma unroll
    for (int d = 0; d < 64; d += 2) { const unsigned v = *(const unsigned*)(p + d); q[d] = __uint_as_float(v << 16); q[d + 1] = __uint_as_float(v & 0xffff0000u); }
}
__device__ __forceinline__ float nv_dot(const float (&q)[64], const bf16* p) { float s = 0.f;
#pragma unroll
    for (int d = 0; d < 64; d += 2) { const unsigned v = *(const unsigned*)(p + d); s += q[d] * __uint_as_float(v << 16) + q[d + 1] * __uint_as_float(v & 0xffff0000u); }
    return s; }
__device__ __forceinline__ void nv_axpy(float (&o)[64], float p, const bf16* vp) {
#pragma unroll
    for (int d = 0; d < 64; d += 2) { const unsigned v = *(const unsigned*)(vp + d); o[d] += p * __uint_as_float(v << 16); o[d + 1] += p * __uint_as_float(v & 0xffff0000u); }
}
__device__ __forceinline__ void nv_store_y(const float (&o)[64], float l, const bf16* zp, bf16* yp) { const float il = 1.f / l;
#pragma unroll
    for (int d = 0; d < 64; d += 2) { const unsigned z = *(const unsigned*)(zp + d); *(unsigned*)(yp + d) = pk2(o[d] * il * __uint_as_float(z << 16), o[d + 1] * il * __uint_as_float(z & 0xffff0000u)); }
}
__global__ void __launch_bounds__(64) naive_attn(int layer, const bf16* P, const bf16* MK, const bf16* MV, const float* kmean, const float* sinks, const float* logf2, bf16* Y) {
    const int row = blockIdx.x * 64 + threadIdx.x, h = blockIdx.y, b = row / SEQ, t = row % SEQ;
    const bf16* prow = P + (size_t)row * LDP; const bf16* Pb = P + (size_t)b * SEQ * LDP;
    float q[64], o[64]; float l = 0.f;
#pragma unroll
    for (int d = 0; d < 64; ++d) o[d] = 0.f;
    const int zcol = (layer == 0 ? L0_Z : L1_Z) + h * 64;
    if (h >= 12) {
        const int hm = h - 12; nv_loadq(q, prow + (layer == 0 ? L0_MQ : L1_MQ) + hm * 64);
        for (int m = 0; m < MEML; ++m) { const size_t off = ((size_t)b * MEML + m) * 256 + hm * 64; const float p = fexp2(nv_dot(q, MK + off)); l += p; nv_axpy(o, p, MV + off); }
    } else if (layer == 1) {
        nv_loadq(q, prow + L1_CQ + h * 64); const float* lf = logf2 + ((size_t)b * 12 + h) * SEQ; float dacc = 0.f;
        for (int s = t; s >= 0; --s) { if (s < t) dacc += lf[s + 1]; if (dacc < -300.f) break;
            const bf16* kr = Pb + (size_t)s * LDP; const float p = fexp2(nv_dot(q, kr + L1_CK + h * 64) + dacc); l += p; nv_axpy(o, p, kr + L1_CV + h * 64); }
    } else if (h < 6) {
        nv_loadq(q, prow + L0_AQ + h * 64); const int kvh = h / 3; const float sl = alibi_slope2(h);
        const int s0 = t - 127 < 0 ? 0 : t - 127;
        for (int s = s0; s <= t; ++s) { const bf16* kr = Pb + (size_t)s * LDP; const float p = fexp2(nv_dot(q, kr + L0_AK + kvh * 64) - sl * (float)(t - s)); l += p; nv_axpy(o, p, kr + L0_AV + kvh * 64); }
        l += fexp2(LOG2E * sinks[h]);
    } else {
        const int hb = h - 6; nv_loadq(q, prow + L0_BQ + hb * 64); const float sl = alibi_slope2(h); const int blk = t / 256;
        unsigned chosen = 0u; const int nsel = blk < 3 ? blk : 3;
        for (int i = 0; i < nsel; ++i) { int best = -1; float bestv = -3.0e38f;
            for (int j = 0; j < blk; ++j) { if ((chosen >> j) & 1u) continue; const float* km = kmean + (((size_t)b * 6 + hb) * 32 + j) * 64; float g = 0.f;
#pragma unroll
                for (int d = 0; d < 64; ++d) g += q[d] * km[d];
                if (g > bestv) { bestv = g; best = j; } }
            chosen |= 1u << best; }
        chosen |= 1u << blk;
        for (int j = 0; j <= blk; ++j) { if (!((chosen >> j) & 1u)) continue; const int e = (j == blk) ? t : 256 * j + 255;
            for (int s = 256 * j; s <= e; ++s) { const bf16* kr = Pb + (size_t)s * LDP; const float p = fexp2(nv_dot(q, kr + L0_BK + hb * 64) - sl * (float)(t - s)); l += p; nv_axpy(o, p, kr + L0_BV + hb * 64); } }
    }
    nv_store_y(o, l, prow + zcol, Y + (size_t)row * DM + h * 64);
}

__global__ void __launch_bounds__(64) naive_outproj(const bf16* Y, const bf16* Wt, const float* xin, float* xout, bf16* XB, float* SS) {
    const int row = blockIdx.x * 64 + threadIdx.x, g = blockIdx.y;
    float acc[64];
#pragma unroll
    for (int c = 0; c < 64; ++c) acc[c] = 0.f;
    const bf16* yr = Y + (size_t)row * DM; const bf16* wr = Wt + (size_t)g * 64 * DM;
    for (int k = 0; k < DM; k += 2) { const unsigned xv = *(const unsigned*)(yr + k); const float x0 = __uint_as_float(xv << 16), x1 = __uint_as_float(xv & 0xffff0000u);
#pragma unroll
        for (int c = 0; c < 64; ++c) { const unsigned wv = *(const unsigned*)(wr + (size_t)c * DM + k); acc[c] += x0 * __uint_as_float(wv << 16) + x1 * __uint_as_float(wv & 0xffff0000u); } }
    float ss = 0.f; const size_t off = (size_t)row * DM + g * 64;
#pragma unroll
    for (int c = 0; c < 64; ++c) { acc[c] += xin[off + c]; ss += acc[c] * acc[c]; xout[off + c] = acc[c]; }
    if (XB) {
#pragma unroll
        for (int c = 0; c < 64; c += 2) *(unsigned*)(XB + off + c) = pk2(acc[c], acc[c + 1]);
        SS[(size_t)row * 16 + g] = ss; }
}
namespace pg8 {
#define PG8_LAS __attribute__((address_space(3)))
typedef unsigned short bf16_t;
typedef short bf16x8 __attribute__((ext_vector_type(8)));
typedef float f32x4 __attribute__((ext_vector_type(4)));
typedef unsigned u32x4 __attribute__((ext_vector_type(4)));
constexpr int BM = 256, BK = 64, HALF = 128, HTB = HALF * BK * 2  , STAGE_BYTES = 8 * HTB, NXCD = 8, WGM = 8;

__host__ __device__ __forceinline__ int lds_byte(int r, int c) { const int st = (r >> 4) * 2 + (c >> 5), rr = r & 15, cc = c & 31, ob = rr * 64 + cc * 2; return st * 1024 + (ob ^ (((ob >> 9) & 1) << 5)); }
__host__ __device__ __forceinline__ void stage_rc(int b, int& R, int& C) { const int st = b / 1024, sb = b % 1024, swz = sb ^ (((sb >> 9) & 1) << 5); R = (st >> 1) * 16 + swz / 64; C = (st & 1) * 32 + (swz % 64) / 2; }
__host__ __device__ __forceinline__ int perm32(int rho) { const int n = rho >> 4, i = rho & 15; return 8 * (i >> 2) + 4 * n + (i & 3); }

struct Unit { int pm, pn; };
struct Gemm { const bf16_t* A; const bf16_t* Bt; int M, N, K; };

struct StaticOrder {
    int nM, nN, nwg, G, c;
    __host__ __device__ void init(int M, int N, int G_, int c_) { nM = M / BM; nN = N / BM; nwg = nM * nN; G = G_; c = c_; }
    __host__ __device__ bool next(int i, Unit& u) const {
        const long L = (long)i * G + c; if (L >= nwg) return false;
        int wgid = (int)L; { const int q = nwg / NXCD, r = nwg % NXCD, xcd = wgid % NXCD, off = wgid / NXCD; wgid = (xcd < r ? xcd * (q + 1) : r * (q + 1) + (xcd - r) * q) + off; }
        const int nig = WGM * nN, gid = wgid / nig, fm = gid * WGM, gsz = (nM - fm) < WGM ? (nM - fm) : WGM;
        u.pm = fm + ((wgid % nig) % gsz); u.pn = (wgid % nig) / gsz; return true;
    }
    __device__ __forceinline__ void a_ready(const Unit&) const {}
    __device__ __forceinline__ void done(const Unit&) const {}
};
template <class Epi, class Sched, bool ALIGN_EPI = false, bool SP2 = false>
__device__ __forceinline__ void gemm_phase(PG8_LAS unsigned char* lds, const Gemm g, const Sched& S, const Epi& E) {
    const int tid = threadIdx.x, wid = __builtin_amdgcn_readfirstlane(tid >> 6), lane = tid & 63, wr = wid >> 2, wc = wid & 3, fr = lane & 15, fq = lane >> 4;
    const int K = g.K, nt = K / BK;
    unsigned voffA[2], voffB[2];
#pragma unroll
    for (int i = 0; i < 2; ++i) { int R, C; stage_rc(tid * 16 + i * 8192, R, C); const int Rb = 64 * (R >> 5) + perm32(R & 31);
        voffA[i] = (unsigned)(R * K + C) * 2u; voffB[i] = (unsigned)(Rb * K + C) * 2u; }
    const size_t kstep = (size_t)(BK * 2);
    const size_t hstep = (size_t)HALF * K * 2;
    const size_t hstepB = (size_t)32 * K * 2;
    const size_t tstep = 2 * hstep;
    const unsigned ldsw = (unsigned)wid * 1024u;
    const int aoff = lds_byte(wr * 64 + fr, fq * 8), boff = lds_byte(wc * 32 + fr, fq * 8);
#define PG8_SA(b, h) (((b) * 2 + (h)) * HTB)
#define PG8_SB(b, h) ((4 + (b) * 2 + (h)) * HTB)
#define PG8_STAGE(bufoff, gbase, voff) do { _Pragma("unroll") for (int _i = 0; _i < 2; ++_i) \
        __builtin_amdgcn_global_load_lds((const unsigned*)((const char*)(gbase) + (voff)[_i]), (PG8_LAS unsigned*)(lds + (bufoff) + ldsw + _i * 8192), 16, 0, 0); } while (0)
#define PG8_LDA(dst, b, h) do { _Pragma("unroll") for (int m = 0; m < 4; ++m) _Pragma("unroll") for (int k = 0; k < 2; ++k) dst[m][k] = *(const PG8_LAS bf16x8*)(lds + PG8_SA(b, h) + aoff + m * 2048 + k * 1024); } while (0)
#define PG8_LDB(dst, b, h) do { _Pragma("unroll") for (int n = 0; n < 2; ++n) _Pragma("unroll") for (int k = 0; k < 2; ++k) dst[n][k] = *(const PG8_LAS bf16x8*)(lds + PG8_SB(b, h) + boff + n * 2048 + k * 1024); } while (0)
#define PG8_MMA(ai, bj, At, Bt) do { __builtin_amdgcn_s_setprio(1); _Pragma("unroll") for (int m = 0; m < 4; ++m) _Pragma("unroll") for (int n = 0; n < 2; ++n) _Pragma("unroll") for (int k = 0; k < 2; ++k) \
        acc[ai][bj][m][n] = __builtin_amdgcn_mfma_f32_16x16x32_bf16(Bt[n][k], At[m][k], acc[ai][bj][m][n], 0, 0, 0); __builtin_amdgcn_s_setprio(0); } while (0)
#define PG8_WAIT_V(n) asm volatile("s_waitcnt vmcnt(" #n ")" ::: "memory")
#define PG8_WAIT_L(n) asm volatile("s_waitcnt lgkmcnt(" #n ")" ::: "memory")
#define PG8_BAR __builtin_amdgcn_s_barrier()
#define PG8_SCHED __builtin_amdgcn_sched_barrier(0)
    Unit cur, nxt; int ui = 0;
    if (!S.next(0, cur)) return;
    f32x4 acc[2][2][4][2];
#pragma unroll
    for (int a = 0; a < 2; ++a)
#pragma unroll
        for (int b = 0; b < 2; ++b)
#pragma unroll
            for (int m = 0; m < 4; ++m)
#pragma unroll
                for (int n = 0; n < 2; ++n) acc[a][b][m][n] = (f32x4){0.f, 0.f, 0.f, 0.f};
    bf16x8 At[4][2], B0[2][2], B1[2][2];
    const char* cA = (const char*)g.A + (size_t)cur.pm * tstep; const char* cB = (const char*)g.Bt + (size_t)cur.pn * tstep;
    S.a_ready(cur);
    if constexpr (SP2) {
        PG8_STAGE(PG8_SB(0, 0), cB, voffB); PG8_STAGE(PG8_SB(0, 1), cB + hstepB, voffB); PG8_STAGE(PG8_SA(0, 0), cA, voffA); PG8_STAGE(PG8_SA(0, 1), cA + hstep, voffA);
        if (wr == 1) PG8_BAR;
        PG8_WAIT_V(2); PG8_BAR;
        PG8_STAGE(PG8_SB(1, 0), cB + kstep, voffB); PG8_STAGE(PG8_SA(1, 0), cA + kstep, voffA); PG8_STAGE(PG8_SB(1, 1), cB + hstepB + kstep, voffB);
        PG8_WAIT_V(6); PG8_BAR;
    } else {
        PG8_STAGE(PG8_SB(0, 0), cB, voffB); PG8_STAGE(PG8_SA(0, 0), cA, voffA); PG8_STAGE(PG8_SB(0, 1), cB + hstepB, voffB); PG8_STAGE(PG8_SA(0, 1), cA + hstep, voffA);
        if (wr == 1) PG8_BAR;
        PG8_WAIT_V(4); PG8_BAR;
        PG8_STAGE(PG8_SB(1, 0), cB + kstep, voffB); PG8_STAGE(PG8_SA(1, 0), cA + kstep, voffA); PG8_STAGE(PG8_SB(1, 1), cB + hstepB + kstep, voffB);
        PG8_WAIT_V(6); PG8_BAR;
    }
    for (;;) {
        const bool has_next = S.next(ui + 1, nxt);
        const char* nA = has_next ? (const char*)g.A + (size_t)nxt.pm * tstep : cA; const char* nB = has_next ? (const char*)g.Bt + (size_t)nxt.pn * tstep : cB;
        for (int t = 0; t < nt; t += 2) {
            const bool last = (t == nt - 2);
            const char* a1 = cA + (size_t)(t + 1) * kstep;
            const char* a2 = last ? nA : cA + (size_t)(t + 2) * kstep; const char* b2 = last ? nB : cB + (size_t)(t + 2) * kstep;
            const char* a3 = a2 + kstep; const char* b3 = b2 + kstep;
            if (last && has_next) S.a_ready(nxt);
            if constexpr (SP2) {
            PG8_LDB(B0, 0, 0); PG8_LDB(B1, 0, 1); PG8_SCHED; PG8_LDA(At, 0, 0); PG8_STAGE(PG8_SA(1, 1), a1 + hstep, voffA);
            PG8_WAIT_V(8); PG8_WAIT_L(0); PG8_BAR; PG8_MMA(0, 0, At, B0); PG8_MMA(0, 1, At, B1); PG8_BAR; PG8_SCHED;
            PG8_LDA(At, 0, 1); PG8_STAGE(PG8_SB(0, 0), b2, voffB); PG8_STAGE(PG8_SB(0, 1), b2 + hstepB, voffB); PG8_STAGE(PG8_SA(0, 0), a2, voffA);
            PG8_WAIT_V(8); PG8_WAIT_L(0); PG8_BAR; PG8_MMA(1, 0, At, B0); PG8_MMA(1, 1, At, B1); PG8_BAR; PG8_SCHED;
            PG8_LDB(B0, 1, 0); PG8_LDB(B1, 1, 1); PG8_SCHED; PG8_LDA(At, 1, 0); PG8_STAGE(PG8_SA(0, 1), a2 + hstep, voffA);
            PG8_WAIT_V(8); PG8_WAIT_L(0); PG8_BAR; PG8_MMA(0, 0, At, B0); PG8_MMA(0, 1, At, B1); PG8_BAR; PG8_SCHED;
            PG8_LDA(At, 1, 1); PG8_STAGE(PG8_SB(1, 0), b3, voffB); PG8_STAGE(PG8_SB(1, 1), b3 + hstepB, voffB); PG8_STAGE(PG8_SA(1, 0), a3, voffA);
            PG8_WAIT_V(8); PG8_WAIT_L(0); PG8_BAR; PG8_MMA(1, 0, At, B0); PG8_MMA(1, 1, At, B1); PG8_BAR; PG8_SCHED;
            } else {
            PG8_LDB(B0, 0, 0); PG8_SCHED; PG8_LDA(At, 0, 0); PG8_STAGE(PG8_SA(1, 1), a1 + hstep, voffA);
            PG8_WAIT_L(8); PG8_BAR; PG8_WAIT_L(0); PG8_MMA(0, 0, At, B0); PG8_BAR; PG8_SCHED;
            PG8_LDB(B1, 0, 1); PG8_STAGE(PG8_SB(0, 0), b2, voffB);
            PG8_BAR; PG8_WAIT_L(0); PG8_MMA(0, 1, At, B1); PG8_BAR;
            PG8_LDA(At, 0, 1); PG8_STAGE(PG8_SA(0, 0), a2, voffA);
            PG8_BAR; PG8_WAIT_L(0); PG8_MMA(1, 0, At, B0); PG8_BAR; PG8_SCHED;
            PG8_STAGE(PG8_SB(0, 1), b2 + hstepB, voffB);
            PG8_WAIT_V(6); PG8_BAR; PG8_MMA(1, 1, At, B1); PG8_BAR;
            PG8_LDB(B0, 1, 0); PG8_SCHED; PG8_LDA(At, 1, 0); PG8_STAGE(PG8_SA(0, 1), a2 + hstep, voffA);
            PG8_WAIT_L(8); PG8_BAR; PG8_WAIT_L(0); PG8_MMA(0, 0, At, B0); PG8_BAR; PG8_SCHED;
            PG8_LDB(B1, 1, 1); PG8_STAGE(PG8_SB(1, 0), b3, voffB);
            PG8_BAR; PG8_WAIT_L(0); PG8_MMA(0, 1, At, B1); PG8_BAR;
            PG8_LDA(At, 1, 1); PG8_STAGE(PG8_SA(1, 0), a3, voffA);
            PG8_BAR; PG8_WAIT_L(0); PG8_MMA(1, 0, At, B0); PG8_BAR; PG8_SCHED;
            PG8_STAGE(PG8_SB(1, 1), b3 + hstepB, voffB);
            PG8_WAIT_V(6); PG8_BAR; PG8_MMA(1, 1, At, B1); PG8_BAR;
            }
        }
        if constexpr (ALIGN_EPI) { if (wr == 0) PG8_BAR; }
        if constexpr (!Epi::AFTER_DRAIN) { E(acc, cur, wr, wc, fr, fq); S.done(cur); }
        if (!has_next) break;
#pragma unroll
        for (int a = 0; a < 2; ++a)
#pragma unroll
            for (int b = 0; b < 2; ++b)
#pragma unroll
                for (int m = 0; m < 4; ++m)
#pragma unroll
                    for (int n = 0; n < 2; ++n) acc[a][b][m][n] = (f32x4){0.f, 0.f, 0.f, 0.f};
        cur = nxt; cA = nA; cB = nB; ++ui;
        if constexpr (ALIGN_EPI) { if (wr == 1) PG8_BAR; }
    }
    PG8_WAIT_V(0);
    if constexpr (!ALIGN_EPI) { if (wr == 0) PG8_BAR; }
    PG8_BAR;
    if constexpr (Epi::AFTER_DRAIN) { E.fused(acc, cur, wr, wc, fr, fq, lds, wid, lane); S.done(cur); }
#undef PG8_SA
#undef PG8_SB
#undef PG8_STAGE
#undef PG8_LDA
#undef PG8_LDB
#undef PG8_MMA
#undef PG8_WAIT_V
#undef PG8_WAIT_L
#undef PG8_BAR
#undef PG8_SCHED
}
}
namespace pg8 {
__device__ __forceinline__ unsigned cvt_pk_bf16(float lo, float hi) { unsigned r; asm volatile("v_cvt_pk_bf16_f32 %0, %1, %2" : "=v"(r) : "v"(lo), "v"(hi)); return r; }

struct EpiProj {
    static constexpr bool AFTER_DRAIN = false;
    int layer; bf16* P; const float* SS; const float* qkg; const float* bfp; float* kmean; float* logf2;
    __device__ __forceinline__ void operator()(const f32x4 (&acc)[2][2][4][2], const Unit& u, int wr, int wc, int fr, int fq) const {
        const int hh = u.pn * 4 + wc; const HeadInfo hi = head_info(layer, hh);
        if (hi.kind == HK_NONE) return;
        const bool norm = (hi.kind == HK_QNORM || hi.kind == HK_KNORM || hi.kind == HK_BK);
        f32x4 gv[2][2];
#pragma unroll
        for (int bj = 0; bj < 2; ++bj)
#pragma unroll
            for (int n = 0; n < 2; ++n) gv[bj][n] = norm ? *(const f32x4*)(qkg + hi.gidx * 64 + 32 * bj + 8 * fq + 4 * n) : (f32x4){1.f, 1.f, 1.f, 1.f};
        const float qs = (hi.kind == HK_QNORM) ? C2 : 1.f;
        f32x4 ksum[2][2];
#pragma unroll
        for (int bj = 0; bj < 2; ++bj)
#pragma unroll
            for (int n = 0; n < 2; ++n) ksum[bj][n] = (f32x4){0.f, 0.f, 0.f, 0.f};
#pragma unroll
        for (int ai = 0; ai < 2; ++ai)
#pragma unroll
            for (int m = 0; m < 4; ++m) {
                const int row = u.pm * BM + ai * HALF + wr * 64 + m * 16 + fr;
                const f32x4 sp = *(const f32x4*)(SS + (size_t)row * 16 + 4 * fq);
                float ss = (sp[0] + sp[1]) + (sp[2] + sp[3]); ss += __shfl_xor(ss, 16); ss += __shfl_xor(ss, 32);
                const float rstd = rsqrtf(ss * (1.f / DM) + EPS);
                f32x4 v[2][2];
#pragma unroll
                for (int bj = 0; bj < 2; ++bj)
#pragma unroll
                    for (int n = 0; n < 2; ++n) v[bj][n] = acc[ai][bj][m][n] * rstd;
                if (hi.kind == HK_CF) {
                    const int b = row / SEQ, t = row % SEQ;
                    if (fq < 2) {
#pragma unroll
                        for (int n = 0; n < 2; ++n) if (fq == 0 || n == 0) {
#pragma unroll
                            for (int e = 0; e < 4; ++e) { const int c = 8 * fq + 4 * n + e; logf2[((size_t)b * 12 + c) * SEQ + t] = logsig2(v[0][n][e] + bfp[c]); } } }
                    continue;
                }
                if (norm) { float q = 0.f;
#pragma unroll
                    for (int bj = 0; bj < 2; ++bj)
#pragma unroll
                        for (int n = 0; n < 2; ++n) q += (v[bj][n][0] * v[bj][n][0] + v[bj][n][1] * v[bj][n][1]) + (v[bj][n][2] * v[bj][n][2] + v[bj][n][3] * v[bj][n][3]);
                    q += __shfl_xor(q, 16); q += __shfl_xor(q, 32);
                    const float inv = rsqrtf(q * (1.f / 64.f) + EPS) * qs;
#pragma unroll
                    for (int bj = 0; bj < 2; ++bj)
#pragma unroll
                        for (int n = 0; n < 2; ++n) v[bj][n] = v[bj][n] * gv[bj][n] * inv; }
                if (hi.kind == HK_SILU) {
#pragma unroll
                    for (int bj = 0; bj < 2; ++bj)
#pragma unroll
                        for (int n = 0; n < 2; ++n)
#pragma unroll
                            for (int e = 0; e < 4; ++e) v[bj][n][e] = silu_f(v[bj][n][e]); }
                if (hi.kind == HK_BK) {
#pragma unroll
                    for (int bj = 0; bj < 2; ++bj)
#pragma unroll
                        for (int n = 0; n < 2; ++n) ksum[bj][n] += v[bj][n]; }
                bf16* rowp = P + (size_t)row * LDP + hi.dstcol + 8 * fq;
#pragma unroll
                for (int bj = 0; bj < 2; ++bj) { u32x4 w; w.x = cvt_pk_bf16(v[bj][0][0], v[bj][0][1]); w.y = cvt_pk_bf16(v[bj][0][2], v[bj][0][3]); w.z = cvt_pk_bf16(v[bj][1][0], v[bj][1][1]); w.w = cvt_pk_bf16(v[bj][1][2], v[bj][1][3]);
                    *(u32x4*)(rowp + 32 * bj) = w; }
            }
        if (hi.kind == HK_BK) {
            const int b = u.pm / 32, blk = u.pm % 32, h = hh - 16; float* kp = kmean + (((size_t)b * 6 + h) * 32 + blk) * 64 + 8 * fq;
#pragma unroll
            for (int bj = 0; bj < 2; ++bj)
#pragma unroll
                for (int n = 0; n < 2; ++n)
#pragma unroll
                    for (int e = 0; e < 4; ++e) { float s = ksum[bj][n][e]; s += __shfl_xor(s, 1); s += __shfl_xor(s, 2); s += __shfl_xor(s, 4); s += __shfl_xor(s, 8);
                        if (fr == 0) atomicAdd(kp + 32 * bj + 4 * n + e, s); }
        }
    }
};

struct EpiOut {
    static constexpr bool AFTER_DRAIN = false;
    const float* xin; float* xout; bf16* XB; float* SS;
    __device__ __forceinline__ void operator()(const f32x4 (&acc)[2][2][4][2], const Unit& u, int wr, int wc, int fr, int fq) const {
#pragma unroll
        for (int ai = 0; ai < 2; ++ai)
#pragma unroll
            for (int m = 0; m < 4; ++m) {
                const int row = u.pm * BM + ai * HALF + wr * 64 + m * 16 + fr; const size_t off = (size_t)row * DM + u.pn * BM + 64 * wc + 8 * fq; float ss = 0.f;
#pragma unroll
                for (int bj = 0; bj < 2; ++bj) {
                    const f32x4 x0 = *(const f32x4*)(xin + off + 32 * bj) + acc[ai][bj][m][0], x1 = *(const f32x4*)(xin + off + 32 * bj + 4) + acc[ai][bj][m][1];
                    *(f32x4*)(xout + off + 32 * bj) = x0; *(f32x4*)(xout + off + 32 * bj + 4) = x1;
                    ss += (x0[0] * x0[0] + x0[1] * x0[1]) + (x0[2] * x0[2] + x0[3] * x0[3]) + (x1[0] * x1[0] + x1[1] * x1[1]) + (x1[2] * x1[2] + x1[3] * x1[3]);
                    if (XB) { u32x4 w; w.x = cvt_pk_bf16(x0[0], x0[1]); w.y = cvt_pk_bf16(x0[2], x0[3]); w.z = cvt_pk_bf16(x1[0], x1[1]); w.w = cvt_pk_bf16(x1[2], x1[3]); *(u32x4*)(XB + off + 32 * bj) = w; }
                }
                if (SS) { ss += __shfl_xor(ss, 16); ss += __shfl_xor(ss, 32); if (fq == 0) SS[(size_t)row * 16 + u.pn * 4 + wc] = ss; }
            }
    }
};
}
namespace att {
typedef LAS const char* lds_cptr;
typedef short s16x4 __attribute__((ext_vector_type(4)));
typedef short v4i16_t __attribute__((ext_vector_type(4)));
enum { M_SWA = 0, M_MOBA = 1, M_FOX = 2, M_MEM = 3 };
constexpr int SLOTB = 8192, LDS_K = 0, LDS_V = 3 * SLOTB, LDS_WS = 6 * SLOTB, WSB = 2048, LDS_OST = LDS_WS + 8 * WSB, LDS_END = LDS_OST + 8 * 4096;

__device__ __forceinline__ int crow(int r, int hi) { return (r & 3) + 8 * (r >> 2) + 4 * hi; }
__device__ __forceinline__ void glds16(const void* g, unsigned lds_base) {
    unsigned sv; asm volatile("s_mov_b32 %0, m0\n\ts_mov_b32 m0, %2\n\ts_nop 0\n\tglobal_load_lds_dwordx4 %1, off\n\ts_mov_b32 m0, %0" : "=&s"(sv) : "v"(g), "s"(lds_base) : "memory"); }
__device__ __forceinline__ void glds4(const void* g, unsigned lds_base) {
    unsigned sv; asm volatile("s_mov_b32 %0, m0\n\ts_mov_b32 m0, %2\n\ts_nop 0\n\tglobal_load_lds_dword %1, off\n\ts_mov_b32 m0, %0" : "=&s"(sv) : "v"(g), "s"(lds_base) : "memory"); }
__device__ __forceinline__ s16x4 vtr(lds_cptr p) { return __builtin_bit_cast(s16x4, __builtin_amdgcn_ds_read_tr16_b64_v4i16((LAS v4i16_t*)p)); }
__device__ __forceinline__ unsigned cvtpk(float lo, float hi) { typedef float f2 __attribute__((ext_vector_type(2))); typedef __bf16 b2 __attribute__((ext_vector_type(2))); f2 v = {lo, hi}; b2 b = __builtin_convertvector(v, b2); return __builtin_bit_cast(unsigned, b); }
#define ATT_MFMA(a, b, c) __builtin_amdgcn_mfma_f32_32x32x16_bf16(a, b, c, 0, 0, 0)
#define ATT_WAIT_BAR(N) asm volatile("s_waitcnt vmcnt(" #N ") lgkmcnt(0)\n\ts_barrier" ::: "memory")
#define ATT_RFL(x) ((unsigned)__builtin_amdgcn_readfirstlane((int)(x)))

struct UnitP {
    const bf16* Q;
    const bf16* K; const bf16* V; int pitch;
    const bf16* Z; bf16* Y;
    int qb, t_hi, t_lo;
    float sl2, sinkp, thr2;
    const float* lf; const float* kmean;
};

template <int MODE> __device__ __forceinline__ void attn_unit(const UnitP& u, LAS unsigned char* shm) {
    const int tid = threadIdx.x, lane = tid & 63, r32 = lane & 31, hi = lane >> 5; const int wid = __builtin_amdgcn_readfirstlane(tid >> 6);
    const unsigned lds0 = (unsigned)(size_t)shm;
    LAS float* wsf = (LAS float*)(shm + LDS_WS + wid * WSB);
    const int pitch = u.pitch;
    const bf16* ksrc = u.K + (size_t)lane * pitch + wid * 8;
    const bf16* vsrc = u.V + (size_t)(16 * (wid & 3) + (lane >> 2)) * pitch + (wid >> 2) * 32 + (lane & 3) * 8;
    const float* fsrc = u.lf + lane + 1;
    const unsigned kdst = lds0 + LDS_K + wid * 1024, vdst = lds0 + LDS_V + wid * 1024, fdst = lds0 + LDS_WS + wid * WSB;
    const int NT = u.t_hi - u.t_lo + 1;
#define ATT_DMA(i, slot) do { const int t_ = u.t_hi - (i); glds16(ksrc + (size_t)t_ * 64 * pitch, ATT_RFL(kdst + (slot) * SLOTB)); glds16(vsrc + (size_t)t_ * 64 * pitch, ATT_RFL(vdst + (slot) * SLOTB)); \
        if (MODE == M_FOX) glds4(fsrc + t_ * 64, ATT_RFL(fdst + (slot) * 256)); } while (0)
    ATT_DMA(0, 0); if (NT > 1) ATT_DMA(1, 1);
    bf16x8 qr[4];
    { const bf16* Qw = u.Q + (size_t)(wid * 32 + r32) * LDP + hi * 8;
#pragma unroll
      for (int d0 = 0; d0 < 4; ++d0) qr[d0] = *(const bf16x8*)(Qw + d0 * 16); }
    const int qrel = wid * 32 + r32, qpos = u.qb * 256 + qrel;
    float Eq = 0.f, Eq0 = 0.f, carry = 0.f;
    if (MODE == M_FOX) {
        const int q0 = u.qb * 256;
#pragma unroll 1
        for (int jb = 3; jb >= 0; --jb) { float w = u.lf[q0 + 64 * jb + lane + 1]; if (jb == 3 && lane == 63) w = 0.f;
#pragma unroll
            for (int d = 1; d < 64; d <<= 1) { const float o = __shfl_down(w, d); if (lane + d < 64) w += o; }
            w += carry; wsf[256 + 64 * jb + lane] = w; carry = __builtin_bit_cast(float, __builtin_amdgcn_readfirstlane(__builtin_bit_cast(int, w))); }
        asm volatile("s_waitcnt lgkmcnt(0)" ::: "memory");
        Eq = wsf[256 + qrel]; Eq0 = carry;
    }
    unsigned selmask = 0u;
    if (MODE == M_MOBA) { if (u.qb > 0) {
        f32x16 g = f32x16{}; const float* km = u.kmean + (size_t)r32 * 64 + hi * 8;
#pragma unroll
        for (int d0 = 0; d0 < 4; ++d0) { const f32x4 a0 = *(const f32x4*)(km + 16 * d0), a1 = *(const f32x4*)(km + 16 * d0 + 4); bf16x8 kh, kl;
#pragma unroll
            for (int j = 0; j < 4; ++j) { unsigned h0 = f2bf(a0[j]), h1 = f2bf(a1[j]); kh[j] = (short)h0; kh[j + 4] = (short)h1; kl[j] = (short)f2bf(a0[j] - bf2f((bf16)h0)); kl[j + 4] = (short)f2bf(a1[j] - bf2f((bf16)h1)); }
            g = ATT_MFMA(kh, qr[d0], g); g = ATT_MFMA(kl, qr[d0], g); }
#pragma unroll
        for (int r = 0; r < 16; ++r) if (crow(r, hi) >= u.qb) g[r] = -INFINITY;
#pragma unroll 1
        for (int it = 0; it < 3; ++it) { float bv = -INFINITY; int bj = 99;
#pragma unroll
            for (int r = 0; r < 16; ++r) if (g[r] > bv) { bv = g[r]; bj = crow(r, hi); }
            const float pv = __shfl_xor(bv, 32); const int pj = __shfl_xor(bj, 32);
            if (pv > bv || (pv == bv && pj < bj)) { bv = pv; bj = pj; }
            if (bv > -INFINITY) selmask |= 1u << (bj & 31);
#pragma unroll
            for (int r = 0; r < 16; ++r) if (crow(r, hi) == bj) g[r] = -INFINITY; }
    } }
    f32x16 o0 = f32x16{}, o1 = f32x16{}; float l = 0.f;
    int sl = 0;
    const lds_cptr shc = (lds_cptr)shm;
#pragma unroll 1
    for (int i = 0; i < NT; ++i) {
        if (i + 1 < NT) { if (MODE == M_FOX) ATT_WAIT_BAR(3); else ATT_WAIT_BAR(2); } else ATT_WAIT_BAR(0);
        if (i + 2 < NT) { const int s2 = sl == 0 ? 2 : sl - 1; ATT_DMA(i + 2, s2); }
        const int t = u.t_hi - i, jb = t - 4 * u.qb;
        bool active = true; int esrc = 192;
        if (MODE == M_FOX) {
            if (jb >= 0) esrc = 256 + 64 * jb;
            else { float w = wsf[sl * 64 + lane];
#pragma unroll
                for (int d = 1; d < 64; d <<= 1) { const float o = __shfl_down(w, d); if (lane + d < 64) w += o; }
                w += carry; const float etop = __builtin_bit_cast(float, __builtin_amdgcn_readlane(__builtin_bit_cast(int, w), 63));
                if (__builtin_amdgcn_readfirstlane((int)(etop - Eq0 < -u.thr2))) break;
                wsf[192 + lane] = w; carry = __builtin_bit_cast(float, __builtin_amdgcn_readfirstlane(__builtin_bit_cast(int, w))); }
        }
        if (MODE != M_MEM) { if (jb >= 0) active = (64 * jb <= wid * 32 + 31); }
        if (MODE == M_SWA) active = active && (64 * jb >= wid * 32 - 190);
        bool rowsel = true;
        if (MODE == M_MOBA) { if (jb < 0) { rowsel = (selmask >> (t >> 2)) & 1u; active = (__ballot(rowsel) != 0ull); } }
        if (active) {
            const lds_cptr kp = shc + LDS_K + sl * SLOTB + hi * 1024 + r32 * 16;
            bf16x8 kf[8];
#pragma unroll
            for (int d0 = 0; d0 < 4; ++d0) { kf[2 * d0] = *(const LAS bf16x8*)(kp + d0 * 2048); kf[2 * d0 + 1] = *(const LAS bf16x8*)(kp + d0 * 2048 + 512); }
            f32x16 p0, p1;
            if (MODE == M_MEM) { p0 = f32x16{}; p1 = f32x16{}; }
            else if (MODE == M_FOX) { asm volatile("s_waitcnt lgkmcnt(0)" ::: "memory");
#pragma unroll
                for (int g = 0; g < 4; ++g) { const f32x4 e0 = *(const LAS f32x4*)(wsf + esrc + 8 * g + 4 * hi), e1 = *(const LAS f32x4*)(wsf + esrc + 32 + 8 * g + 4 * hi);
#pragma unroll
                    for (int e = 0; e < 4; ++e) { p0[4 * g + e] = e0[e] - Eq; p1[4 * g + e] = e1[e] - Eq; } } }
            else { float base = u.sl2 * (float)(64 * t + 4 * hi - qpos); if (MODE == M_MOBA) { if (!rowsel) base = -INFINITY; }
#pragma unroll
                for (int r = 0; r < 16; ++r) { p0[r] = __builtin_fmaf(u.sl2, (float)((r & 3) + 8 * (r >> 2)), base); p1[r] = p0[r] + 32.f * u.sl2; } }
            p0 = ATT_MFMA(kf[0], qr[0], p0); p1 = ATT_MFMA(kf[1], qr[0], p1); p0 = ATT_MFMA(kf[2], qr[1], p0); p1 = ATT_MFMA(kf[3], qr[1], p1);
            p0 = ATT_MFMA(kf[4], qr[2], p0); p1 = ATT_MFMA(kf[5], qr[2], p1); p0 = ATT_MFMA(kf[6], qr[3], p0); p1 = ATT_MFMA(kf[7], qr[3], p1);
            if (MODE != M_MEM) { if (jb >= 0) { const int kb = 64 * jb + 4 * hi;
#pragma unroll
                for (int r = 0; r < 16; ++r) { const int kv = kb + (r & 3) + 8 * (r >> 2); if (kv > qrel) p0[r] = -INFINITY; if (kv + 32 > qrel) p1[r] = -INFINITY; } } }
            if (MODE == M_SWA) { const int kb = 64 * jb + 4 * hi;
#pragma unroll
                for (int r = 0; r < 16; ++r) { const int kv = kb + (r & 3) + 8 * (r >> 2); if (qrel - kv >= 128) p0[r] = -INFINITY; if (qrel - kv - 32 >= 128) p1[r] = -INFINITY; } }
#pragma unroll
            for (int r = 0; r < 16; ++r) { p0[r] = fexp2(p0[r]); p1[r] = fexp2(p1[r]); }
            float s = 0.f;
#pragma unroll
            for (int r = 0; r < 16; ++r) s += p0[r] + p1[r];
            l += s;
            u32x4 pw[4];
#pragma unroll
            for (int j = 0; j < 4; ++j) { pw[0][j] = cvtpk(p0[2 * j], p0[2 * j + 1]); pw[1][j] = cvtpk(p0[8 + 2 * j], p0[9 + 2 * j]); pw[2][j] = cvtpk(p1[2 * j], p1[2 * j + 1]); pw[3][j] = cvtpk(p1[8 + 2 * j], p1[9 + 2 * j]); }
            const lds_cptr vp = shc + LDS_V + sl * SLOTB + ((lane >> 4) & 1) * 32 + (lane & 3) * 8 + (4 * hi + ((lane & 15) >> 2)) * 64;
#pragma unroll
            for (int ks = 0; ks < 4; ++ks) { const s16x4 a = vtr(vp + ks * 1024), b = vtr(vp + ks * 1024 + 512), c = vtr(vp + 4096 + ks * 1024), d = vtr(vp + 4096 + ks * 1024 + 512);
                const bf16x8 v0 = (bf16x8){a[0], a[1], a[2], a[3], b[0], b[1], b[2], b[3]}, v1 = (bf16x8){c[0], c[1], c[2], c[3], d[0], d[1], d[2], d[3]};
                o0 = ATT_MFMA(__builtin_bit_cast(bf16x8, pw[ks]), v0, o0); o1 = ATT_MFMA(__builtin_bit_cast(bf16x8, pw[ks]), v1, o1); }
        }
        sl = (sl == 2) ? 0 : sl + 1;
    }
    asm volatile("s_waitcnt vmcnt(0) lgkmcnt(0)" ::: "memory");
    l += __shfl_xor(l, 32); if (MODE == M_SWA) l += u.sinkp;
    if (hi == 0) wsf[r32] = 1.f / l;
    asm volatile("s_waitcnt lgkmcnt(0)" ::: "memory");
    float rl[16];
#pragma unroll
    for (int r = 0; r < 16; ++r) rl[r] = wsf[crow(r, hi)];
    LAS float* ost = (LAS float*)(shm + LDS_OST + wid * 4096);
    const int orow = lane >> 1, oh = lane & 1;
#pragma unroll
    for (int d0 = 0; d0 < 2; ++d0) {
#pragma unroll
        for (int r = 0; r < 16; ++r) ost[crow(r, hi) * 32 + r32] = (d0 == 0 ? o0[r] : o1[r]) * rl[r];
        asm volatile("s_waitcnt lgkmcnt(0)" ::: "memory");
        f32x4 ov[4];
#pragma unroll
        for (int j = 0; j < 4; ++j) ov[j] = *(const LAS f32x4*)(ost + orow * 32 + 16 * oh + 4 * j);
        const bf16* zp = u.Z + (size_t)(wid * 32 + orow) * LDP + 32 * d0 + 16 * oh;
        const u32x4 z0 = *(const u32x4*)zp, z1 = *(const u32x4*)(zp + 8);
        u32x4 y0, y1;
#pragma unroll
        for (int j = 0; j < 4; ++j) { const unsigned za = j < 2 ? z0[2 * j] : z1[2 * (j - 2)], zb = j < 2 ? z0[2 * j + 1] : z1[2 * (j - 2) + 1];
            const unsigned w0 = cvtpk(ov[j][0] * __uint_as_float(za << 16), ov[j][1] * __uint_as_float(za & 0xffff0000u)), w1 = cvtpk(ov[j][2] * __uint_as_float(zb << 16), ov[j][3] * __uint_as_float(zb & 0xffff0000u));
            if (j < 2) { y0[2 * j] = w0; y0[2 * j + 1] = w1; } else { y1[2 * (j - 2)] = w0; y1[2 * (j - 2) + 1] = w1; } }
        bf16* yp = u.Y + (size_t)(wid * 32 + orow) * DM + 32 * d0 + 16 * oh;
        *(u32x4*)yp = y0; *(u32x4*)(yp + 8) = y1;
        asm volatile("s_waitcnt lgkmcnt(0)" ::: "memory");
    }
    asm volatile("s_waitcnt vmcnt(0) lgkmcnt(0)\n\ts_barrier" ::: "memory");
#undef ATT_DMA
}

constexpr int NUNITS = 1024;
__device__ __forceinline__ void attn_phase(int layer, const Args& a, LAS unsigned char* lds, unsigned* qctr) {
    unsigned char* ws = a.ws; const bf16* P = (const bf16*)(ws + WS_P); bf16* Y = (bf16*)(ws + WS_Y);
    LAS unsigned* qw = (LAS unsigned*)(lds + LDS_END);
    const int tid = threadIdx.x, lane = tid & 63;
    float thr2 = 0.f;
    if (layer == 1) { const float* g = a.in[11]; float mq = fabsf(g[lane]), mk = fabsf(g[64 + lane]);
#pragma unroll
        for (int o = 1; o < 64; o <<= 1) { mq = fmaxf(mq, __shfl_xor(mq, o)); mk = fmaxf(mk, __shfl_xor(mk, o)); }
        thr2 = LOG2E * (104.f + 2.f * 8.f * mq * mk); thr2 = __builtin_bit_cast(float, __builtin_amdgcn_readfirstlane(__builtin_bit_cast(int, thr2))); }
    for (;;) {
        if (tid == 0) *qw = __hip_atomic_fetch_add(qctr, 1u, __ATOMIC_RELAXED, __HIP_MEMORY_SCOPE_AGENT);
        __syncthreads();
        const int idx = __builtin_amdgcn_readfirstlane((int)*qw);
        if (idx >= NUNITS) break;
        UnitP u; u.sl2 = 0.f; u.sinkp = 0.f; u.thr2 = thr2; u.lf = nullptr; u.kmean = nullptr; u.pitch = LDP;
        int mode;
        if (idx >= 768) { const int k = idx - 768, qb = k >> 3, bh = k & 7, b = bh >> 2, hm = bh & 3; mode = M_MEM;
            const size_t row0 = (size_t)b * SEQ + qb * 256; const int mq = layer == 0 ? L0_MQ : L1_MQ, zc = (layer == 0 ? L0_Z : L1_Z) + (12 + hm) * 64;
            const bf16* MK = (const bf16*)(ws + WS_MKV + (size_t)(2 * layer) * MKV_ONE) + (size_t)b * MEML * 256 + hm * 64; const bf16* MV = (const bf16*)(ws + WS_MKV + (size_t)(2 * layer + 1) * MKV_ONE) + (size_t)b * MEML * 256 + hm * 64;
            u.Q = P + row0 * LDP + mq + hm * 64; u.K = MK; u.V = MV; u.pitch = 256; u.Z = P + row0 * LDP + zc; u.Y = Y + row0 * DM + (12 + hm) * 64; u.qb = qb; u.t_hi = 3; u.t_lo = 0;
        } else if (layer == 1) { const int qb = 31 - idx / 24, bh = idx % 24, b = bh / 12, h = bh % 12; mode = M_FOX;
            const size_t row0 = (size_t)b * SEQ + qb * 256; const bf16* Pb = P + (size_t)b * SEQ * LDP;
            u.Q = P + row0 * LDP + L1_CQ + h * 64; u.K = Pb + L1_CK + h * 64; u.V = Pb + L1_CV + h * 64; u.Z = P + row0 * LDP + L1_Z + h * 64; u.Y = Y + row0 * DM + h * 64;
            u.qb = qb; u.t_hi = 4 * qb + 3; u.t_lo = 0; u.lf = (const float*)(ws + WS_LOGF) + ((size_t)b * 12 + h) * SEQ;
        } else if (idx < 384) { const int qb = 31 - idx / 12, bh = idx % 12, b = bh / 6, hb = bh % 6; mode = M_MOBA;
            const size_t row0 = (size_t)b * SEQ + qb * 256; const bf16* Pb = P + (size_t)b * SEQ * LDP;
            u.Q = P + row0 * LDP + L0_BQ + hb * 64; u.K = Pb + L0_BK + hb * 64; u.V = Pb + L0_BV + hb * 64; u.Z = P + row0 * LDP + L0_Z + (6 + hb) * 64; u.Y = Y + row0 * DM + (6 + hb) * 64;
            u.qb = qb; u.t_hi = 4 * qb + 3; u.t_lo = 0; u.sl2 = alibi_slope2(6 + hb); u.kmean = (const float*)(ws + WS_KMEAN) + ((size_t)b * 6 + hb) * 32 * 64;
        } else { const int k = idx - 384, qb = k / 12, bh = k % 12, b = bh / 6, h = bh % 6, kvh = h / 3; mode = M_SWA;
            const size_t row0 = (size_t)b * SEQ + qb * 256; const bf16* Pb = P + (size_t)b * SEQ * LDP;
            u.Q = P + row0 * LDP + L0_AQ + h * 64; u.K = Pb + L0_AK + kvh * 64; u.V = Pb + L0_AV + kvh * 64; u.Z = P + row0 * LDP + L0_Z + h * 64; u.Y = Y + row0 * DM + h * 64;
            u.qb = qb; u.t_hi = 4 * qb + 3; u.t_lo = 4 * qb - 2 < 0 ? 0 : 4 * qb - 2; u.sl2 = alibi_slope2(h); u.sinkp = fexp2(LOG2E * a.in[5][h]);
        }
        if (mode == M_MEM) attn_unit<M_MEM>(u, lds); else if (mode == M_FOX) attn_unit<M_FOX>(u, lds); else if (mode == M_MOBA) attn_unit<M_MOBA>(u, lds); else attn_unit<M_SWA>(u, lds);
    }
}
}
constexpr int LDS_BYTES = 147456;
__global__ void __launch_bounds__(512, 2) mk_fwd(Args a) {
    extern __shared__ __attribute__((aligned(16))) unsigned char lds_raw[];
    LAS unsigned char* lds = (LAS unsigned char*)lds_raw;
    const int G = gridDim.x, bx = blockIdx.x; const int vcu = (G % 8 == 0) ? (bx % 8) * (G / 8) + bx / 8 : bx;
    unsigned char* ws = a.ws;
    bf16* XB = (bf16*)(ws + WS_XB); bf16* P = (bf16*)(ws + WS_P); bf16* Y = (bf16*)(ws + WS_Y);
    float* kmean = (float*)(ws + WS_KMEAN); float* logf2 = (float*)(ws + WS_LOGF); float* SS0 = (float*)(ws + WS_SS0); float* SS1 = (float*)(ws + WS_SS1);
#define IN(k) (a.ph_lo <= (k) && (k) < a.ph_hi)
    if (IN(0)) phase_prologue(a, lds, vcu, G);
    if (IN(1)) { pg8::Gemm g{XB, (const bf16*)(ws + WS_WIN0), T, N0, DM}; pg8::StaticOrder S; S.init(T, N0, G, bx);
        pg8::EpiProj E{0, P, SS0, a.in[4], nullptr, kmean, logf2}; pg8::gemm_phase<pg8::EpiProj, pg8::StaticOrder, true, true>(lds, g, S, E); }
    if (IN(2)) att::attn_phase(0, a, lds, (unsigned*)(ws + WS_CTL) + 64);
    if (IN(5)) att::attn_phase(1, a, lds, (unsigned*)(ws + WS_CTL) + 128);
    if (IN(3)) { pg8::Gemm g{Y, (const bf16*)(ws + WS_WOUT0), T, DM, DM}; pg8::StaticOrder S; S.init(T, DM, G, bx);
        pg8::EpiOut E{a.in[0], a.out, XB, SS1}; pg8::gemm_phase<pg8::EpiOut, pg8::StaticOrder, true, true>(lds, g, S, E); }
    if (IN(4)) { pg8::Gemm g{XB, (const bf16*)(ws + WS_WIN1), T, N1, DM}; pg8::StaticOrder S; S.init(T, N1, G, bx);
        pg8::EpiProj E{1, P, SS1, a.in[11], a.in[12], kmean, logf2}; pg8::gemm_phase<pg8::EpiProj, pg8::StaticOrder, true, true>(lds, g, S, E); }
    if (IN(6)) { pg8::Gemm g{Y, (const bf16*)(ws + WS_WOUT1), T, DM, DM}; pg8::StaticOrder S; S.init(T, DM, G, bx);
        pg8::EpiOut E{a.out, a.out, nullptr, nullptr}; pg8::gemm_phase<pg8::EpiOut, pg8::StaticOrder, true, true>(lds, g, S, E); }
#undef IN
}

extern "C" void kernel_launch(void* const* d_in, const int* in_sizes, int n_in, void* d_out, int out_size, void* d_ws, size_t ws_size, hipStream_t stream) {
    static int grid = 0;
    if (grid == 0) {
        if (n_in != 16 || out_size != T * DM || ws_size < WS_END) { fprintf(stderr, "kernel_launch: unexpected shapes (n_in %d out %d ws %zu)\n", n_in, out_size, ws_size); grid = -1; return; }
        int dev = 0, cus = 0, per_cu = 0;
        (void)hipGetDevice(&dev); (void)hipDeviceGetAttribute(&cus, hipDeviceAttributeMultiprocessorCount, dev);
        (void)hipFuncSetAttribute((const void*)mk_fwd, hipFuncAttributeMaxDynamicSharedMemorySize, LDS_BYTES);
        (void)hipOccupancyMaxActiveBlocksPerMultiprocessor(&per_cu, (const void*)mk_fwd, 512, LDS_BYTES);
        (void)hipGetLastError();
        grid = cus * (per_cu >= 1 ? 1 : 0); if (grid <= 0) { fprintf(stderr, "kernel_launch: occupancy query says 0\n"); grid = -1; return; }
    }
    if (grid < 0) return;
    unsigned char* ws = (unsigned char*)d_ws;
    (void)hipMemsetAsync(ws + WS_CTL, 0, CTL_ZERO_BYTES, stream);
    Args a{}; for (int i = 0; i < 16; ++i) a.in[i] = (const float*)d_in[i];
    a.out = (float*)d_out; a.ws = ws;
    bf16* P = (bf16*)(ws + WS_P); bf16* Y = (bf16*)(ws + WS_Y);
    float* kmean = (float*)(ws + WS_KMEAN); float* logf2 = (float*)(ws + WS_LOGF);
    const bf16* MK0 = (const bf16*)(ws + WS_MKV); const bf16* MV0 = (const bf16*)(ws + WS_MKV + MKV_ONE); const bf16* MK1 = (const bf16*)(ws + WS_MKV + 2 * MKV_ONE); const bf16* MV1 = (const bf16*)(ws + WS_MKV + 3 * MKV_ONE);
#define RUN(lo, hi) do { a.ph_lo = (lo); a.ph_hi = (hi); hipLaunchKernelGGL(mk_fwd, dim3(grid), dim3(512), LDS_BYTES, stream, a); } while (0)
    RUN(0, 1); RUN(1, 2);
    RUN(2, 3); RUN(3, 4); RUN(4, 5); RUN(5, 6); RUN(6, 7);
#undef RUN
}
```

```cpp
#include <hip/hip_runtime.h>
#include <cstdint>
#include <cstdio>

#define GAS __attribute__((address_space(1)))
#define LAS __attribute__((address_space(3)))
typedef unsigned short bf16;
typedef unsigned v4u __attribute__((ext_vector_type(4)));
typedef unsigned u32x4 __attribute__((ext_vector_type(4)));
typedef unsigned v2u __attribute__((ext_vector_type(2)));
typedef float f32x4 __attribute__((ext_vector_type(4)));
typedef float f32x16 __attribute__((ext_vector_type(16)));
typedef short bf16x8 __attribute__((ext_vector_type(8)));

constexpr int BATCH = 2, SEQ = 8192, T = BATCH * SEQ, DM = 1024, HD = 64, MEML = 256;
constexpr int N0 = 3072;
constexpr int N1REF = 3596;
constexpr int N1 = 3840;
constexpr int LDP = 3584;
constexpr float EPS = 1e-6f;
constexpr float LOG2E = 1.4426950408889634f;
constexpr float C2 = 0.125f * LOG2E;
constexpr int L0_AQ = 0, L0_AK = 384, L0_AV = 512, L0_BQ = 640, L0_BK = 1024, L0_BV = 1408, L0_MQ = 1792, L0_Z = 2048;
constexpr int L1_CQ = 0, L1_CK = 768, L1_CV = 1536, L1_MQ = 2304, L1_Z = 2560, L1_CF = 3584;

constexpr size_t MiB = 1u << 20;
constexpr size_t WS_CTL = 0, CTL_ZERO_BYTES = 1 * MiB;
constexpr size_t WS_KMEAN = 512 * 1024;
constexpr size_t WS_WIN0 = 2 * MiB, WS_WOUT0 = 8 * MiB, WS_WIN1 = 10 * MiB, WS_WOUT1 = 18 * MiB;
constexpr size_t WS_SS0 = 20 * MiB, WS_SS1 = 21 * MiB;
constexpr size_t WS_LOGF = 22 * MiB;
constexpr size_t WS_MKV = 23 * MiB;
constexpr size_t MKV_ONE = (size_t)BATCH * MEML * 256 * 2;
constexpr size_t WS_XB = 24 * MiB;
constexpr size_t WS_P = 56 * MiB;
constexpr size_t WS_Y = 168 * MiB;
constexpr size_t WS_END = 200 * MiB;

__device__ __forceinline__ float bf2f(bf16 v) { return __uint_as_float((unsigned)v << 16); }
__device__ __forceinline__ unsigned f2bf(float f) { unsigned u = __float_as_uint(f); return (u + 0x7fffu + ((u >> 16) & 1u)) >> 16; }
__device__ __forceinline__ unsigned pk2(float lo, float hi) { return f2bf(lo) | (f2bf(hi) << 16); }
__device__ __forceinline__ float wave_sum(float v) {
#pragma unroll
    for (int o = 1; o < 64; o <<= 1) v += __shfl_xor(v, o);
    return v;
}
__device__ __forceinline__ float fexp2(float x) { return __builtin_amdgcn_exp2f(x); }
__device__ __forceinline__ float silu_f(float z) { return z * __builtin_amdgcn_rcpf(1.f + __builtin_amdgcn_exp2f(-LOG2E * z)); }
__device__ __forceinline__ float logsig2(float f) { return LOG2E * (fminf(f, 0.f) - log1pf(__expf(-fabsf(f)))); }
__device__ __forceinline__ float alibi_slope2(int h) { return LOG2E * exp2f(-8.0f * (float)(h + 1) / 12.0f); }

struct Args {
    const float* in[16]; float* out; unsigned char* ws; int ph_lo, ph_hi;
};
enum { HK_QNORM = 0, HK_KNORM = 1, HK_PLAIN = 2, HK_SILU = 3, HK_BK = 4, HK_CF = 5, HK_NONE = 6 };
struct HeadInfo { int kind; int gidx; int dstcol; };
__device__ __forceinline__ HeadInfo head_info(int layer, int hh) {
    HeadInfo h; h.dstcol = hh * 64; h.gidx = 0;
    if (layer == 0) {
        if (hh < 6) { h.kind = HK_QNORM; h.gidx = 0; } else if (hh < 8) { h.kind = HK_KNORM; h.gidx = 1; } else if (hh < 10) h.kind = HK_PLAIN;
        else if (hh < 16) { h.kind = HK_QNORM; h.gidx = 2; } else if (hh < 22) { h.kind = HK_BK; h.gidx = 3; } else if (hh < 28) h.kind = HK_PLAIN;
        else if (hh < 32) { h.kind = HK_QNORM; h.gidx = 4; } else h.kind = HK_SILU;
    } else {
        if (hh < 12) { h.kind = HK_QNORM; h.gidx = 0; } else if (hh < 24) { h.kind = HK_KNORM; h.gidx = 1; } else if (hh < 36) h.kind = HK_PLAIN;
        else if (hh < 40) { h.kind = HK_QNORM; h.gidx = 2; } else if (hh < 56) h.kind = HK_SILU; else if (hh == 56) h.kind = HK_CF; else h.kind = HK_NONE;
    }
    return h;
}

constexpr int PRO_NW = 8;

__device__ __forceinline__ int l1_refcol(int n) {
    if (n < 2304) return n;
    if (n < 3584) return n + 12;
    if (n < 3596) return n - 3584 + 2304;
    return -1;
}
__device__ __forceinline__ void pro_transpose_item(const float* W, const float* g, int K, int Nref, int nblk, bf16* WT, bool remap, LAS float* scr, int item, int lane) {
    const int kb = item / nblk, nb = item % nblk, k0 = 64 * kb, n0 = 32 * nb;
    const int np = n0 + (lane & 31); const int rc = remap ? l1_refcol(np) : np;
    float wv[32];
#pragma unroll
    for (int i = 0; i < 32; ++i) { const int kk = 2 * i + (lane >> 5); wv[i] = (rc >= 0) ? W[(size_t)(k0 + kk) * Nref + rc] : 0.f; }
    const float gl = g ? g[k0 + (lane & 63)] : 1.f;
#pragma unroll
    for (int i = 0; i < 32; ++i) { const int kk = 2 * i + (lane >> 5); const float gk = __shfl(gl, kk); scr[kk * 33 + (lane & 31)] = wv[i] * gk; }
    asm volatile("s_waitcnt lgkmcnt(0)" ::: "memory");
    const int c = lane & 7;
#pragma unroll
    for (int j = 0; j < 4; ++j) { const int n = (lane >> 3) + 8 * j; const LAS float* s = scr + (8 * c) * 33 + n;
        v4u o; o.x = pk2(s[0 * 33], s[1 * 33]); o.y = pk2(s[2 * 33], s[3 * 33]); o.z = pk2(s[4 * 33], s[5 * 33]); o.w = pk2(s[6 * 33], s[7 * 33]);
        *(v4u*)(WT + (size_t)(n0 + n) * K + k0 + 8 * c) = o; }
    asm volatile("s_waitcnt lgkmcnt(0)" ::: "memory");
}
__device__ __forceinline__ void pro_row(const float* xrow, bf16* orow, float* ssrow, int lane) {
    const f32x4* xr = (const f32x4*)xrow + lane; f32x4 v[4]; float s = 0.f;
#pragma unroll
    for (int j = 0; j < 4; ++j) { v[j] = xr[64 * j]; s += (v[j].x * v[j].x + v[j].y * v[j].y) + (v[j].z * v[j].z + v[j].w * v[j].w); }
    s = wave_sum(s);
    v2u* o8 = (v2u*)orow + lane;
#pragma unroll
    for (int j = 0; j < 4; ++j) { v2u w; w.x = pk2(v[j].x, v[j].y); w.y = pk2(v[j].z, v[j].w); o8[64 * j] = w; }
    if (lane < 16) ssrow[lane] = lane == 0 ? s : 0.f;
}
__device__ __forceinline__ void pro_memkv_task(const float* mem, const float* gm, const float* W, const float* kg, bf16* MK, bf16* MV, int rt, int ct, LAS unsigned char* lds) {
    const int tid = threadIdx.x, lane = tid & 63, w = tid >> 6, r32 = lane & 31, hi = lane >> 5;
    LAS float* part = (LAS float*)lds; LAS float* rs = (LAS float*)(lds + 133120);
    for (int i = 0; i < 8; ++i) { const int row = rt * 64 + 8 * w + i; const f32x4* xr = (const f32x4*)(mem + (size_t)row * DM) + lane; float s = 0.f;
#pragma unroll
        for (int j = 0; j < 4; ++j) { const f32x4 v = xr[64 * j]; s += (v.x * v.x + v.y * v.y) + (v.z * v.z + v.w * v.w); }
        s = wave_sum(s); if (lane == 0) rs[8 * w + i] = rsqrtf(s * (1.f / DM) + EPS); }
    f32x16 acc[2][2];
#pragma unroll
    for (int a = 0; a < 2; ++a)
#pragma unroll
        for (int b = 0; b < 2; ++b) acc[a][b] = f32x16{};
    for (int ks = 0; ks < 8; ++ks) { const int k0 = 128 * w + 16 * ks + 8 * hi;
        bf16x8 wf[2], hf[2];
#pragma unroll
        for (int cb = 0; cb < 2; ++cb) { const float* wp = W + (size_t)k0 * 512 + ct * 64 + 32 * cb + r32;
#pragma unroll
            for (int j = 0; j < 8; ++j) wf[cb][j] = (short)f2bf(wp[(size_t)j * 512]); }
        const f32x4 g0 = *(const f32x4*)(gm + k0), g1 = *(const f32x4*)(gm + k0 + 4);
#pragma unroll
        for (int ra = 0; ra < 2; ++ra) { const float* mp = mem + (size_t)(rt * 64 + 32 * ra + r32) * DM + k0; const f32x4 a0 = *(const f32x4*)mp, a1 = *(const f32x4*)(mp + 4);
            hf[ra][0] = (short)f2bf(a0.x * g0.x); hf[ra][1] = (short)f2bf(a0.y * g0.y); hf[ra][2] = (short)f2bf(a0.z * g0.z); hf[ra][3] = (short)f2bf(a0.w * g0.w);
            hf[ra][4] = (short)f2bf(a1.x * g1.x); hf[ra][5] = (short)f2bf(a1.y * g1.y); hf[ra][6] = (short)f2bf(a1.z * g1.z); hf[ra][7] = (short)f2bf(a1.w * g1.w); }
#pragma unroll
        for (int cb = 0; cb < 2; ++cb)
#pragma unroll
            for (int ra = 0; ra < 2; ++ra) acc[cb][ra] = __builtin_amdgcn_mfma_f32_32x32x16_bf16(wf[cb], hf[ra], acc[cb][ra], 0, 0, 0);
    }
#pragma unroll
    for (int cb = 0; cb < 2; ++cb)
#pragma unroll
        for (int ra = 0; ra < 2; ++ra)
#pragma unroll
            for (int r = 0; r < 16; ++r) { const int n = 32 * cb + (r & 3) + 8 * (r >> 2) + 4 * hi; part[(w * 64 + 32 * ra + r32) * 65 + n] = acc[cb][ra][r]; }
    __syncthreads();
    { const int tok = tid >> 3, c0 = (tid & 7) * 8; float v[8];
#pragma unroll
      for (int i = 0; i < 8; ++i) v[i] = 0.f;
      for (int ww = 0; ww < 8; ++ww) {
#pragma unroll
          for (int i = 0; i < 8; ++i) v[i] += part[(ww * 64 + tok) * 65 + c0 + i]; }
      const float r = rs[tok]; float ss = 0.f;
#pragma unroll
      for (int i = 0; i < 8; ++i) { v[i] *= r; ss += v[i] * v[i]; }
      ss += __shfl_xor(ss, 1); ss += __shfl_xor(ss, 2); ss += __shfl_xor(ss, 4);
      const int row = rt * 64 + tok;
      bf16* dst;
      if (ct < 4) { const float inv = rsqrtf(ss * (1.f / 64.f) + EPS);
#pragma unroll
          for (int i = 0; i < 8; ++i) v[i] *= inv * kg[c0 + i];
          dst = MK + (size_t)row * 256 + ct * 64 + c0; }
      else dst = MV + (size_t)row * 256 + (ct - 4) * 64 + c0;
      v4u o; o.x = pk2(v[0], v[1]); o.y = pk2(v[2], v[3]); o.z = pk2(v[4], v[5]); o.w = pk2(v[6], v[7]); *(v4u*)dst = o; }
    __syncthreads();
}

__device__ __forceinline__ void phase_prologue(const Args& a, LAS unsigned char* lds, int vcu, int G) {
    const int tid = threadIdx.x, lane = tid & 63, wave = __builtin_amdgcn_readfirstlane(tid >> 6);
    unsigned char* ws = a.ws;
    for (int wt = (G - 1 - vcu); wt < 128; wt += G) { const int layer = wt >> 6, rt = (wt >> 3) & 7, ct = wt & 7;
        const float* gm = layer ? a.in[13] : a.in[6]; const float* W = layer ? a.in[14] : a.in[7];
        const float* kg = layer ? a.in[11] + 3 * 64 : a.in[4] + 5 * 64;
        bf16* MK = (bf16*)(ws + WS_MKV + (size_t)(2 * layer) * MKV_ONE); bf16* MV = (bf16*)(ws + WS_MKV + (size_t)(2 * layer + 1) * MKV_ONE);
        pro_memkv_task(a.in[1], gm, W, kg, MK, MV, rt, ct, lds); }
    LAS float* scr = (LAS float*)(lds + wave * 16384);
    const int gw = vcu * PRO_NW + wave, NGW = G * PRO_NW;
    constexpr int I_IN0 = 16 * (N0 / 32), I_OUT = 16 * (DM / 32), I_IN1 = 16 * (N1 / 32);
    constexpr int NITEMS = I_IN0 + I_OUT + I_IN1 + I_OUT;
    for (int it = gw; it < NITEMS; it += NGW) { int r = it;
        if (r < I_IN0) { pro_transpose_item(a.in[3], a.in[2], DM, N0, N0 / 32, (bf16*)(ws + WS_WIN0), false, scr, r, lane); continue; } r -= I_IN0;
        if (r < I_OUT) { pro_transpose_item(a.in[8], nullptr, DM, DM, DM / 32, (bf16*)(ws + WS_WOUT0), false, scr, r, lane); continue; } r -= I_OUT;
        if (r < I_IN1) { pro_transpose_item(a.in[10], a.in[9], DM, N1REF, N1 / 32, (bf16*)(ws + WS_WIN1), true, scr, r, lane); continue; } r -= I_IN1;
        pro_transpose_item(a.in[15], nullptr, DM, DM, DM / 32, (bf16*)(ws + WS_WOUT1), false, scr, r, lane); }
    const float* x = a.in[0]; bf16* XB = (bf16*)(ws + WS_XB); float* SS0 = (float*)(ws + WS_SS0);
    for (int m0 = gw * 8; m0 < T; m0 += NGW * 8) {
        f32x4 v[8][4];
#pragma unroll
        for (int r = 0; r < 8; ++r) { const f32x4* xr = (const f32x4*)(x + (size_t)(m0 + r) * DM) + lane;
#pragma unroll
            for (int j = 0; j < 4; ++j) v[r][j] = xr[64 * j]; }
#pragma unroll
        for (int r = 0; r < 8; ++r) { float sq = 0.f;
#pragma unroll
            for (int j = 0; j < 4; ++j) sq += (v[r][j].x * v[r][j].x + v[r][j].y * v[r][j].y) + (v[r][j].z * v[r][j].z + v[r][j].w * v[r][j].w);
            sq = wave_sum(sq); v2u* o8 = (v2u*)(XB + (size_t)(m0 + r) * DM) + lane;
#pragma unroll
            for (int j = 0; j < 4; ++j) { v2u w; w.x = pk2(v[r][j].x, v[r][j].y); w.y = pk2(v[r][j].z, v[r][j].w); o8[64 * j] = w; }
            if (lane < 16) SS0[(size_t)(m0 + r) * 16 + lane] = lane == 0 ? sq : 0.f; } }
}
namespace pg8 {
#define PG8_LAS __attribute__((address_space(3)))
typedef unsigned short bf16_t;
typedef short bf16x8 __attribute__((ext_vector_type(8)));
typedef float f32x4 __attribute__((ext_vector_type(4)));
typedef unsigned u32x4 __attribute__((ext_vector_type(4)));
constexpr int BM = 256, BK = 64, HALF = 128, HTB = HALF * BK * 2  , STAGE_BYTES = 8 * HTB, NXCD = 8, WGM = 8;

__host__ __device__ __forceinline__ int lds_byte(int r, int c) { const int st = (r >> 4) * 2 + (c >> 5), rr = r & 15, cc = c & 31, ob = rr * 64 + cc * 2; return st * 1024 + (ob ^ (((ob >> 9) & 1) << 5)); }
__host__ __device__ __forceinline__ void stage_rc(int b, int& R, int& C) { const int st = b / 1024, sb = b % 1024, swz = sb ^ (((sb >> 9) & 1) << 5); R = (st >> 1) * 16 + swz / 64; C = (st & 1) * 32 + (swz % 64) / 2; }
__host__ __device__ __forceinline__ int perm32(int rho) { const int n = rho >> 4, i = rho & 15; return 8 * (i >> 2) + 4 * n + (i & 3); }

struct Unit { int pm, pn; };
struct Gemm { const bf16_t* A; const bf16_t* Bt; int M, N, K; };

struct StaticOrder {
    int nM, nN, nwg, G, c;
    __host__ __device__ void init(int M, int N, int G_, int c_) { nM = M / BM; nN = N / BM; nwg = nM * nN; G = G_; c = c_; }
    __host__ __device__ bool next(int i, Unit& u) const {
        const long L = (long)i * G + c; if (L >= nwg) return false;
        int wgid = (int)L; { const int q = nwg / NXCD, r = nwg % NXCD, xcd = wgid % NXCD, off = wgid / NXCD; wgid = (xcd < r ? xcd * (q + 1) : r * (q + 1) + (xcd - r) * q) + off; }
        const int nig = WGM * nN, gid = wgid / nig, fm = gid * WGM, gsz = (nM - fm) < WGM ? (nM - fm) : WGM;
        u.pm = fm + ((wgid % nig) % gsz); u.pn = (wgid % nig) / gsz; return true;
    }
    __device__ __forceinline__ void a_ready(const Unit&) const {}
    __device__ __forceinline__ void done(const Unit&) const {}
};
template <class Epi, class Sched, bool ALIGN_EPI = false, bool SP2 = false>
__device__ __forceinline__ void gemm_phase(PG8_LAS unsigned char* lds, const Gemm g, const Sched& S, const Epi& E) {
    const int tid = threadIdx.x, wid = __builtin_amdgcn_readfirstlane(tid >> 6), lane = tid & 63, wr = wid >> 2, wc = wid & 3, fr = lane & 15, fq = lane >> 4;
    const int K = g.K, nt = K / BK;
    unsigned voffA[2], voffB[2];
#pragma unroll
    for (int i = 0; i < 2; ++i) { int R, C; stage_rc(tid * 16 + i * 8192, R, C); const int Rb = 64 * (R >> 5) + perm32(R & 31);
        voffA[i] = (unsigned)(R * K + C) * 2u; voffB[i] = (unsigned)(Rb * K + C) * 2u; }
    const size_t kstep = (size_t)(BK * 2);
    const size_t hstep = (size_t)HALF * K * 2;
    const size_t hstepB = (size_t)32 * K * 2;
    const size_t tstep = 2 * hstep;
    const unsigned ldsw = (unsigned)wid * 1024u;
    const int aoff = lds_byte(wr * 64 + fr, fq * 8), boff = lds_byte(wc * 32 + fr, fq * 8);
#define PG8_SA(b, h) (((b) * 2 + (h)) * HTB)
#define PG8_SB(b, h) ((4 + (b) * 2 + (h)) * HTB)
#define PG8_STAGE(bufoff, gbase, voff) do { _Pragma("unroll") for (int _i = 0; _i < 2; ++_i) \
        __builtin_amdgcn_global_load_lds((const unsigned*)((const char*)(gbase) + (voff)[_i]), (PG8_LAS unsigned*)(lds + (bufoff) + ldsw + _i * 8192), 16, 0, 0); } while (0)
#define PG8_LDA(dst, b, h) do { _Pragma("unroll") for (int m = 0; m < 4; ++m) _Pragma("unroll") for (int k = 0; k < 2; ++k) dst[m][k] = *(const PG8_LAS bf16x8*)(lds + PG8_SA(b, h) + aoff + m * 2048 + k * 1024); } while (0)
#define PG8_LDB(dst, b, h) do { _Pragma("unroll") for (int n = 0; n < 2; ++n) _Pragma("unroll") for (int k = 0; k < 2; ++k) dst[n][k] = *(const PG8_LAS bf16x8*)(lds + PG8_SB(b, h) + boff + n * 2048 + k * 1024); } while (0)
#define PG8_MMA(ai, bj, At, Bt) do { __builtin_amdgcn_s_setprio(1); _Pragma("unroll") for (int m = 0; m < 4; ++m) _Pragma("unroll") for (int n = 0; n < 2; ++n) _Pragma("unroll") for (int k = 0; k < 2; ++k) \
        acc[ai][bj][m][n] = __builtin_amdgcn_mfma_f32_16x16x32_bf16(Bt[n][k], At[m][k], acc[ai][bj][m][n], 0, 0, 0); __builtin_amdgcn_s_setprio(0); } while (0)
#define PG8_WAIT_V(n) asm volatile("s_waitcnt vmcnt(" #n ")" ::: "memory")
#define PG8_WAIT_L(n) asm volatile("s_waitcnt lgkmcnt(" #n ")" ::: "memory")
#define PG8_BAR __builtin_amdgcn_s_barrier()
#define PG8_SCHED __builtin_amdgcn_sched_barrier(0)
    Unit cur, nxt; int ui = 0;
    if (!S.next(0, cur)) return;
    f32x4 acc[2][2][4][2];
#pragma unroll
    for (int a = 0; a < 2; ++a)
#pragma unroll
        for (int b = 0; b < 2; ++b)
#pragma unroll
            for (int m = 0; m < 4; ++m)
#pragma unroll
                for (int n = 0; n < 2; ++n) acc[a][b][m][n] = (f32x4){0.f, 0.f, 0.f, 0.f};
    bf16x8 At[4][2], B0[2][2], B1[2][2];
    const char* cA = (const char*)g.A + (size_t)cur.pm * tstep; const char* cB = (const char*)g.Bt + (size_t)cur.pn * tstep;
    S.a_ready(cur);
    if constexpr (SP2) {
        PG8_STAGE(PG8_SB(0, 0), cB, voffB); PG8_STAGE(PG8_SB(0, 1), cB + hstepB, voffB); PG8_STAGE(PG8_SA(0, 0), cA, voffA); PG8_STAGE(PG8_SA(0, 1), cA + hstep, voffA);
        if (wr == 1) PG8_BAR;
        PG8_WAIT_V(2); PG8_BAR;
        PG8_STAGE(PG8_SB(1, 0), cB + kstep, voffB); PG8_STAGE(PG8_SA(1, 0), cA + kstep, voffA); PG8_STAGE(PG8_SB(1, 1), cB + hstepB + kstep, voffB);
        PG8_WAIT_V(6); PG8_BAR;
    } else {
        PG8_STAGE(PG8_SB(0, 0), cB, voffB); PG8_STAGE(PG8_SA(0, 0), cA, voffA); PG8_STAGE(PG8_SB(0, 1), cB + hstepB, voffB); PG8_STAGE(PG8_SA(0, 1), cA + hstep, voffA);
        if (wr == 1) PG8_BAR;
        PG8_WAIT_V(4); PG8_BAR;
        PG8_STAGE(PG8_SB(1, 0), cB + kstep, voffB); PG8_STAGE(PG8_SA(1, 0), cA + kstep, voffA); PG8_STAGE(PG8_SB(1, 1), cB + hstepB + kstep, voffB);
        PG8_WAIT_V(6); PG8_BAR;
    }
    for (;;) {
        const bool has_next = S.next(ui + 1, nxt);
        const char* nA = has_next ? (const char*)g.A + (size_t)nxt.pm * tstep : cA; const char* nB = has_next ? (const char*)g.Bt + (size_t)nxt.pn * tstep : cB;
        for (int t = 0; t < nt; t += 2) {
            const bool last = (t == nt - 2);
            const char* a1 = cA + (size_t)(t + 1) * kstep;
            const char* a2 = last ? nA : cA + (size_t)(t + 2) * kstep; const char* b2 = last ? nB : cB + (size_t)(t + 2) * kstep;
            const char* a3 = a2 + kstep; const char* b3 = b2 + kstep;
            if (last && has_next) S.a_ready(nxt);
            if constexpr (SP2) {
            PG8_LDB(B0, 0, 0); PG8_LDB(B1, 0, 1); PG8_SCHED; PG8_LDA(At, 0, 0); PG8_STAGE(PG8_SA(1, 1), a1 + hstep, voffA);
            PG8_WAIT_V(8); PG8_WAIT_L(0); PG8_BAR; PG8_MMA(0, 0, At, B0); PG8_MMA(0, 1, At, B1); PG8_BAR; PG8_SCHED;
            PG8_LDA(At, 0, 1); PG8_STAGE(PG8_SB(0, 0), b2, voffB); PG8_STAGE(PG8_SB(0, 1), b2 + hstepB, voffB); PG8_STAGE(PG8_SA(0, 0), a2, voffA);
            PG8_WAIT_V(8); PG8_WAIT_L(0); PG8_BAR; PG8_MMA(1, 0, At, B0); PG8_MMA(1, 1, At, B1); PG8_BAR; PG8_SCHED;
            PG8_LDB(B0, 1, 0); PG8_LDB(B1, 1, 1); PG8_SCHED; PG8_LDA(At, 1, 0); PG8_STAGE(PG8_SA(0, 1), a2 + hstep, voffA);
            PG8_WAIT_V(8); PG8_WAIT_L(0); PG8_BAR; PG8_MMA(0, 0, At, B0); PG8_MMA(0, 1, At, B1); PG8_BAR; PG8_SCHED;
            PG8_LDA(At, 1, 1); PG8_STAGE(PG8_SB(1, 0), b3, voffB); PG8_STAGE(PG8_SB(1, 1), b3 + hstepB, voffB); PG8_STAGE(PG8_SA(1, 0), a3, voffA);
            PG8_WAIT_V(8); PG8_WAIT_L(0); PG8_BAR; PG8_MMA(1, 0, At, B0); PG8_MMA(1, 1, At, B1); PG8_BAR; PG8_SCHED;
            } else {
            PG8_LDB(B0, 0, 0); PG8_SCHED; PG8_LDA(At, 0, 0); PG8_STAGE(PG8_SA(1, 1), a1 + hstep, voffA);
            PG8_WAIT_L(8); PG8_BAR; PG8_WAIT_L(0); PG8_MMA(0, 0, At, B0); PG8_BAR; PG8_SCHED;
            PG8_LDB(B1, 0, 1); PG8_STAGE(PG8_SB(0, 0), b2, voffB);
            PG8_BAR; PG8_WAIT_L(0); PG8_MMA(0, 1, At, B1); PG8_BAR;
            PG8_LDA(At, 0, 1); PG8_STAGE(PG8_SA(0, 0), a2, voffA);
            PG8_BAR; PG8_WAIT_L(0); PG8_MMA(1, 0, At, B0); PG8_BAR; PG8_SCHED;
            PG8_STAGE(PG8_SB(0, 1), b2 + hstepB, voffB);
            PG8_WAIT_V(6); PG8_BAR; PG8_MMA(1, 1, At, B1); PG8_BAR;
            PG8_LDB(B0, 1, 0); PG8_SCHED; PG8_LDA(At, 1, 0); PG8_STAGE(PG8_SA(0, 1), a2 + hstep, voffA);
            PG8_WAIT_L(8); PG8_BAR; PG8_WAIT_L(0); PG8_MMA(0, 0, At, B0); PG8_BAR; PG8_SCHED;
            PG8_LDB(B1, 1, 1); PG8_STAGE(PG8_SB(1, 0), b3, voffB);
            PG8_BAR; PG8_WAIT_L(0); PG8_MMA(0, 1, At, B1); PG8_BAR;
            PG8_LDA(At, 1, 1); PG8_STAGE(PG8_SA(1, 0), a3, voffA);
            PG8_BAR; PG8_WAIT_L(0); PG8_MMA(1, 0, At, B0); PG8_BAR; PG8_SCHED;
            PG8_STAGE(PG8_SB(1, 1), b3 + hstepB, voffB);
            PG8_WAIT_V(6); PG8_BAR; PG8_MMA(1, 1, At, B1); PG8_BAR;
            }
        }
        if constexpr (ALIGN_EPI) { if (wr == 0) PG8_BAR; }
        if constexpr (!Epi::AFTER_DRAIN) { E(acc, cur, wr, wc, fr, fq); S.done(cur); }
        if (!has_next) break;
#pragma unroll
        for (int a = 0; a < 2; ++a)
#pragma unroll
            for (int b = 0; b < 2; ++b)
#pragma unroll
                for (int m = 0; m < 4; ++m)
#pragma unroll
                    for (int n = 0; n < 2; ++n) acc[a][b][m][n] = (f32x4){0.f, 0.f, 0.f, 0.f};
        cur = nxt; cA = nA; cB = nB; ++ui;
        if constexpr (ALIGN_EPI) { if (wr == 1) PG8_BAR; }
    }
    PG8_WAIT_V(0);
    if constexpr (!ALIGN_EPI) { if (wr == 0) PG8_BAR; }
    PG8_BAR;
    if constexpr (Epi::AFTER_DRAIN) { E.fused(acc, cur, wr, wc, fr, fq, lds, wid, lane); S.done(cur); }
#undef PG8_SA
#undef PG8_SB
#undef PG8_STAGE
#undef PG8_LDA
#undef PG8_LDB
#undef PG8_MMA
#undef PG8_WAIT_V
#undef PG8_WAIT_L
#undef PG8_BAR
#undef PG8_SCHED
}
}
namespace pg8 {
__device__ __forceinline__ unsigned cvt_pk_bf16(float lo, float hi) { unsigned r; asm volatile("v_cvt_pk_bf16_f32 %0, %1, %2" : "=v"(r) : "v"(lo), "v"(hi)); return r; }

struct EpiProj {
    static constexpr bool AFTER_DRAIN = false;
    int layer; bf16* P; const float* SS; const float* qkg; const float* bfp; float* kmean; float* logf2;
    __device__ __forceinline__ void operator()(const f32x4 (&acc)[2][2][4][2], const Unit& u, int wr, int wc, int fr, int fq) const {
        const int hh = u.pn * 4 + wc; const HeadInfo hi = head_info(layer, hh);
        if (hi.kind == HK_NONE) return;
        const bool norm = (hi.kind == HK_QNORM || hi.kind == HK_KNORM || hi.kind == HK_BK);
        f32x4 gv[2][2];
#pragma unroll
        for (int bj = 0; bj < 2; ++bj)
#pragma unroll
            for (int n = 0; n < 2; ++n) gv[bj][n] = norm ? *(const f32x4*)(qkg + hi.gidx * 64 + 32 * bj + 8 * fq + 4 * n) : (f32x4){1.f, 1.f, 1.f, 1.f};
        const float qs = (hi.kind == HK_QNORM) ? C2 : 1.f;
        f32x4 ksum[2][2];
#pragma unroll
        for (int bj = 0; bj < 2; ++bj)
#pragma unroll
            for (int n = 0; n < 2; ++n) ksum[bj][n] = (f32x4){0.f, 0.f, 0.f, 0.f};
#pragma unroll
        for (int ai = 0; ai < 2; ++ai)
#pragma unroll
            for (int m = 0; m < 4; ++m) {
                const int row = u.pm * BM + ai * HALF + wr * 64 + m * 16 + fr;
                const f32x4 sp = *(const f32x4*)(SS + (size_t)row * 16 + 4 * fq);
                float ss = (sp[0] + sp[1]) + (sp[2] + sp[3]); ss += __shfl_xor(ss, 16); ss += __shfl_xor(ss, 32);
                const float rstd = rsqrtf(ss * (1.f / DM) + EPS);
                f32x4 v[2][2];
#pragma unroll
                for (int bj = 0; bj < 2; ++bj)
#pragma unroll
                    for (int n = 0; n < 2; ++n) v[bj][n] = acc[ai][bj][m][n] * rstd;
                if (hi.kind == HK_CF) {
                    const int b = row / SEQ, t = row % SEQ;
                    if (fq < 2) {
#pragma unroll
                        for (int n = 0; n < 2; ++n) if (fq == 0 || n == 0) {
#pragma unroll
                            for (int e = 0; e < 4; ++e) { const int c = 8 * fq + 4 * n + e; logf2[((size_t)b * 12 + c) * SEQ + t] = logsig2(v[0][n][e] + bfp[c]); } } }
                    continue;
                }
                if (norm) { float q = 0.f;
#pragma unroll
                    for (int bj = 0; bj < 2; ++bj)
#pragma unroll
                        for (int n = 0; n < 2; ++n) q += (v[bj][n][0] * v[bj][n][0] + v[bj][n][1] * v[bj][n][1]) + (v[bj][n][2] * v[bj][n][2] + v[bj][n][3] * v[bj][n][3]);
                    q += __shfl_xor(q, 16); q += __shfl_xor(q, 32);
                    const float inv = rsqrtf(q * (1.f / 64.f) + EPS) * qs;
#pragma unroll
                    for (int bj = 0; bj < 2; ++bj)
#pragma unroll
                        for (int n = 0; n < 2; ++n) v[bj][n] = v[bj][n] * gv[bj][n] * inv; }
                if (hi.kind == HK_SILU) {
#pragma unroll
                    for (int bj = 0; bj < 2; ++bj)
#pragma unroll
                        for (int n = 0; n < 2; ++n)
#pragma unroll
                            for (int e = 0; e < 4; ++e) v[bj][n][e] = silu_f(v[bj][n][e]); }
                if (hi.kind == HK_BK) {
#pragma unroll
                    for (int bj = 0; bj < 2; ++bj)
#pragma unroll
                        for (int n = 0; n < 2; ++n) ksum[bj][n] += v[bj][n]; }
                bf16* rowp = P + (size_t)row * LDP + hi.dstcol + 8 * fq;
#pragma unroll
                for (int bj = 0; bj < 2; ++bj) { u32x4 w; w.x = cvt_pk_bf16(v[bj][0][0], v[bj][0][1]); w.y = cvt_pk_bf16(v[bj][0][2], v[bj][0][3]); w.z = cvt_pk_bf16(v[bj][1][0], v[bj][1][1]); w.w = cvt_pk_bf16(v[bj][1][2], v[bj][1][3]);
                    *(u32x4*)(rowp + 32 * bj) = w; }
            }
        if (hi.kind == HK_BK) {
            const int b = u.pm / 32, blk = u.pm % 32, h = hh - 16; float* kp = kmean + (((size_t)b * 6 + h) * 32 + blk) * 64 + 8 * fq;
#pragma unroll
            for (int bj = 0; bj < 2; ++bj)
#pragma unroll
                for (int n = 0; n < 2; ++n)
#pragma unroll
                    for (int e = 0; e < 4; ++e) { float s = ksum[bj][n][e]; s += __shfl_xor(s, 1); s += __shfl_xor(s, 2); s += __shfl_xor(s, 4); s += __shfl_xor(s, 8);
                        if (fr == 0) atomicAdd(kp + 32 * bj + 4 * n + e, s); }
        }
    }
};

struct EpiOut0 {
    static constexpr bool AFTER_DRAIN = false;
    const float* xin; bf16* XB; float* SS;
    __device__ __forceinline__ void operator()(const f32x4 (&acc)[2][2][4][2], const Unit& u, int wr, int wc, int fr, int fq) const {
#pragma unroll
        for (int ai = 0; ai < 2; ++ai)
#pragma unroll
            for (int m = 0; m < 4; ++m) {
                const int row = u.pm * BM + ai * HALF + wr * 64 + m * 16 + fr; const size_t off = (size_t)row * DM + u.pn * BM + 64 * wc + 8 * fq; float ss = 0.f;
#pragma unroll
                for (int bj = 0; bj < 2; ++bj) {
                    const f32x4 x0 = __builtin_nontemporal_load((const f32x4*)(xin + off + 32 * bj)) + acc[ai][bj][m][0], x1 = __builtin_nontemporal_load((const f32x4*)(xin + off + 32 * bj + 4)) + acc[ai][bj][m][1];
                    ss += (x0[0] * x0[0] + x0[1] * x0[1]) + (x0[2] * x0[2] + x0[3] * x0[3]) + (x1[0] * x1[0] + x1[1] * x1[1]) + (x1[2] * x1[2] + x1[3] * x1[3]);
                    u32x4 w; w.x = cvt_pk_bf16(x0[0], x0[1]); w.y = cvt_pk_bf16(x0[2], x0[3]); w.z = cvt_pk_bf16(x1[0], x1[1]); w.w = cvt_pk_bf16(x1[2], x1[3]); *(u32x4*)(XB + off + 32 * bj) = w;
                }
                ss += __shfl_xor(ss, 16); ss += __shfl_xor(ss, 32); if (fq == 0) SS[(size_t)row * 16 + u.pn * 4 + wc] = ss;
            }
    }
};
struct EpiOut1 {
    static constexpr bool AFTER_DRAIN = false;
    const bf16* XB; float* xout;
    __device__ __forceinline__ void operator()(const f32x4 (&acc)[2][2][4][2], const Unit& u, int wr, int wc, int fr, int fq) const {
#pragma unroll
        for (int ai = 0; ai < 2; ++ai)
#pragma unroll
            for (int m = 0; m < 4; ++m) {
                const int row = u.pm * BM + ai * HALF + wr * 64 + m * 16 + fr; const size_t off = (size_t)row * DM + u.pn * BM + 64 * wc + 8 * fq;
#pragma unroll
                for (int bj = 0; bj < 2; ++bj) { const u32x4 w = *(const u32x4*)(XB + off + 32 * bj);
                    f32x4 x0, x1; x0[0] = __uint_as_float(w.x << 16); x0[1] = __uint_as_float(w.x & 0xffff0000u); x0[2] = __uint_as_float(w.y << 16); x0[3] = __uint_as_float(w.y & 0xffff0000u);
                    x1[0] = __uint_as_float(w.z << 16); x1[1] = __uint_as_float(w.z & 0xffff0000u); x1[2] = __uint_as_float(w.w << 16); x1[3] = __uint_as_float(w.w & 0xffff0000u);
                    __builtin_nontemporal_store(x0 + acc[ai][bj][m][0], (f32x4*)(xout + off + 32 * bj)); __builtin_nontemporal_store(x1 + acc[ai][bj][m][1], (f32x4*)(xout + off + 32 * bj + 4)); }
            }
    }
};
}
namespace att {
typedef LAS const char* lds_cptr;
typedef short s16x4 __attribute__((ext_vector_type(4)));
typedef short v4i16_t __attribute__((ext_vector_type(4)));
enum { M_SWA = 0, M_MOBA = 1, M_FOX = 2, M_MEM = 3 };
constexpr int SLOTB = 8192, LDS_K = 0, LDS_V = 3 * SLOTB, LDS_WS = 6 * SLOTB, WSB = 2048, LDS_OST = LDS_WS + 8 * WSB, LDS_END = LDS_OST + 8 * 4096;

__device__ __forceinline__ int crow(int r, int hi) { return (r & 3) + 8 * (r >> 2) + 4 * hi; }
__device__ __forceinline__ void glds16(const void* g, unsigned lds_base) {
    unsigned sv; asm volatile("s_mov_b32 %0, m0\n\ts_mov_b32 m0, %2\n\ts_nop 0\n\tglobal_load_lds_dwordx4 %1, off\n\ts_mov_b32 m0, %0" : "=&s"(sv) : "v"(g), "s"(lds_base) : "memory"); }
__device__ __forceinline__ void glds4(const void* g, unsigned lds_base) {
    unsigned sv; asm volatile("s_mov_b32 %0, m0\n\ts_mov_b32 m0, %2\n\ts_nop 0\n\tglobal_load_lds_dword %1, off\n\ts_mov_b32 m0, %0" : "=&s"(sv) : "v"(g), "s"(lds_base) : "memory"); }
__device__ __forceinline__ s16x4 vtr(lds_cptr p) { return __builtin_bit_cast(s16x4, __builtin_amdgcn_ds_read_tr16_b64_v4i16((LAS v4i16_t*)p)); }
__device__ __forceinline__ unsigned cvtpk(float lo, float hi) { typedef float f2 __attribute__((ext_vector_type(2))); typedef __bf16 b2 __attribute__((ext_vector_type(2))); f2 v = {lo, hi}; b2 b = __builtin_convertvector(v, b2); return __builtin_bit_cast(unsigned, b); }
#define ATT_MFMA(a, b, c) __builtin_amdgcn_mfma_f32_32x32x16_bf16(a, b, c, 0, 0, 0)
#define ATT_WAIT_BAR(N) asm volatile("s_waitcnt vmcnt(" #N ") lgkmcnt(0)\n\ts_barrier" ::: "memory")
#define ATT_RFL(x) ((unsigned)__builtin_amdgcn_readfirstlane((int)(x)))

struct UnitP {
    const bf16* Q;
    const bf16* K; const bf16* V; int pitch;
    const bf16* Z; bf16* Y;
    int qb, t_hi, t_lo;
    float sl2, sinkp, thr2;
    const float* lf; const float* kmean;
    unsigned* qctr; LAS unsigned* qw;
};

template <int MODE> __device__ __forceinline__ void attn_epilogue(const UnitP& u, LAS unsigned char* shm, const f32x16& o0, const f32x16& o1, float l) {
    const int tid = threadIdx.x, lane = tid & 63, r32 = lane & 31, hi = lane >> 5; const int wid = __builtin_amdgcn_readfirstlane(tid >> 6);
    LAS float* wsf = (LAS float*)(shm + LDS_WS + wid * WSB);
    unsigned nxt = 0u; if (tid == 0) nxt = __hip_atomic_fetch_add(u.qctr, 1u, __ATOMIC_RELAXED, __HIP_MEMORY_SCOPE_AGENT);
    const int orow = lane >> 1, oh = lane & 1;
    u32x4 zz[2][2];
#pragma unroll
    for (int d0 = 0; d0 < 2; ++d0) { const bf16* zp = u.Z + (size_t)(wid * 32 + orow) * LDP + 32 * d0 + 16 * oh; zz[d0][0] = *(const u32x4*)zp; zz[d0][1] = *(const u32x4*)(zp + 8); }
    l += __shfl_xor(l, 32); if (MODE == M_SWA) l += u.sinkp;
    if (hi == 0) wsf[r32] = 1.f / l;
    asm volatile("s_waitcnt lgkmcnt(0)" ::: "memory");
    float rl[16];
#pragma unroll
    for (int r = 0; r < 16; ++r) rl[r] = wsf[crow(r, hi)];
    LAS float* ost = (LAS float*)(shm + LDS_OST + wid * 4096);
#pragma unroll
    for (int d0 = 0; d0 < 2; ++d0) {
#pragma unroll
        for (int r = 0; r < 16; ++r) ost[crow(r, hi) * 32 + r32] = (d0 == 0 ? o0[r] : o1[r]) * rl[r];
        asm volatile("s_waitcnt lgkmcnt(0)" ::: "memory");
        f32x4 ov[4];
#pragma unroll
        for (int j = 0; j < 4; ++j) ov[j] = *(const LAS f32x4*)(ost + orow * 32 + 16 * oh + 4 * j);
        const u32x4 z0 = zz[d0][0], z1 = zz[d0][1];
        u32x4 y0, y1;
#pragma unroll
        for (int j = 0; j < 4; ++j) { const unsigned za = j < 2 ? z0[2 * j] : z1[2 * (j - 2)], zb = j < 2 ? z0[2 * j + 1] : z1[2 * (j - 2) + 1];
            const unsigned w0 = cvtpk(ov[j][0] * __uint_as_float(za << 16), ov[j][1] * __uint_as_float(za & 0xffff0000u)), w1 = cvtpk(ov[j][2] * __uint_as_float(zb << 16), ov[j][3] * __uint_as_float(zb & 0xffff0000u));
            if (j < 2) { y0[2 * j] = w0; y0[2 * j + 1] = w1; } else { y1[2 * (j - 2)] = w0; y1[2 * (j - 2) + 1] = w1; } }
        bf16* yp = u.Y + (size_t)(wid * 32 + orow) * DM + 32 * d0 + 16 * oh;
        *(u32x4*)yp = y0; *(u32x4*)(yp + 8) = y1;
        asm volatile("s_waitcnt lgkmcnt(0)" ::: "memory");
    }
    if (tid == 0) *u.qw = nxt;
    asm volatile("s_waitcnt vmcnt(0) lgkmcnt(0)\n\ts_barrier" ::: "memory");
}

template <int MODE> __device__ __forceinline__ void attn_unit(const UnitP& u, LAS unsigned char* shm) {
    const int tid = threadIdx.x, lane = tid & 63, r32 = lane & 31, hi = lane >> 5; const int wid = __builtin_amdgcn_readfirstlane(tid >> 6);
    const unsigned lds0 = (unsigned)(size_t)shm;
    LAS float* wsf = (LAS float*)(shm + LDS_WS + wid * WSB);
    const int pitch = u.pitch;
    const bf16* ksrc = u.K + (size_t)lane * pitch + wid * 8;
    const bf16* vsrc = u.V + (size_t)(16 * (wid & 3) + (lane >> 2)) * pitch + (wid >> 2) * 32 + (lane & 3) * 8;
    const float* fsrc = u.lf + lane + 1;
    const unsigned kdst = lds0 + LDS_K + wid * 1024, vdst = lds0 + LDS_V + wid * 1024, fdst = lds0 + LDS_WS + wid * WSB;
    const int NT = u.t_hi - u.t_lo + 1;
#define ATT_DMA(i, slot) do { const int t_ = u.t_hi - (i); glds16(ksrc + (size_t)t_ * 64 * pitch, ATT_RFL(kdst + (slot) * SLOTB)); glds16(vsrc + (size_t)t_ * 64 * pitch, ATT_RFL(vdst + (slot) * SLOTB)); \
        if (MODE == M_FOX) glds4(fsrc + t_ * 64, ATT_RFL(fdst + (slot) * 256)); } while (0)
    ATT_DMA(0, 0); if (NT > 1) ATT_DMA(1, 1);
    bf16x8 qr[4];
    { const bf16* Qw = u.Q + (size_t)(wid * 32 + r32) * LDP + hi * 8;
#pragma unroll
      for (int d0 = 0; d0 < 4; ++d0) qr[d0] = *(const bf16x8*)(Qw + d0 * 16); }
    asm volatile("" : "+v"(qr[0]), "+v"(qr[1]), "+v"(qr[2]), "+v"(qr[3]));
    const int qrel = wid * 32 + r32, qpos = u.qb * 256 + qrel;
    float Eq = 0.f, Eq0 = 0.f, carry = 0.f;
    if (MODE == M_FOX) {
        const int q0 = u.qb * 256;
#pragma unroll 1
        for (int jb = 3; jb >= 0; --jb) { float w = u.lf[q0 + 64 * jb + lane + 1]; if (jb == 3 && lane == 63) w = 0.f;
#pragma unroll
            for (int d = 1; d < 64; d <<= 1) { const float o = __shfl_down(w, d); if (lane + d < 64) w += o; }
            w += carry; wsf[256 + 64 * jb + lane] = w; carry = __builtin_bit_cast(float, __builtin_amdgcn_readfirstlane(__builtin_bit_cast(int, w))); }
        asm volatile("s_waitcnt lgkmcnt(0)" ::: "memory");
        Eq = wsf[256 + qrel]; Eq0 = carry;
    }
    unsigned selmask = 0u;
    if (MODE == M_MOBA) { if (u.qb > 0) {
        f32x16 g = f32x16{}; const float* km = u.kmean + (size_t)r32 * 64 + hi * 8;
#pragma unroll
        for (int d0 = 0; d0 < 4; ++d0) { const f32x4 a0 = *(const f32x4*)(km + 16 * d0), a1 = *(const f32x4*)(km + 16 * d0 + 4); bf16x8 kh, kl;
#pragma unroll
            for (int j = 0; j < 4; ++j) { unsigned h0 = f2bf(a0[j]), h1 = f2bf(a1[j]); kh[j] = (short)h0; kh[j + 4] = (short)h1; kl[j] = (short)f2bf(a0[j] - bf2f((bf16)h0)); kl[j + 4] = (short)f2bf(a1[j] - bf2f((bf16)h1)); }
            g = ATT_MFMA(kh, qr[d0], g); g = ATT_MFMA(kl, qr[d0], g); }
#pragma unroll
        for (int r = 0; r < 16; ++r) if (crow(r, hi) >= u.qb) g[r] = -INFINITY;
#pragma unroll 1
        for (int it = 0; it < 3; ++it) { float bv = -INFINITY; int bj = 99;
#pragma unroll
            for (int r = 0; r < 16; ++r) if (g[r] > bv) { bv = g[r]; bj = crow(r, hi); }
            const float pv = __shfl_xor(bv, 32); const int pj = __shfl_xor(bj, 32);
            if (pv > bv || (pv == bv && pj < bj)) { bv = pv; bj = pj; }
            if (bv > -INFINITY) selmask |= 1u << (bj & 31);
#pragma unroll
            for (int r = 0; r < 16; ++r) if (crow(r, hi) == bj) g[r] = -INFINITY; }
    } }
    f32x16 o0 = f32x16{}, o1 = f32x16{}; float l = 0.f;
    int sl = 0;
    const lds_cptr shc = (lds_cptr)shm;
#pragma unroll 1
    for (int i = 0; i < NT; ++i) {
        if (i + 1 < NT) { if (MODE == M_FOX) ATT_WAIT_BAR(3); else ATT_WAIT_BAR(2); } else ATT_WAIT_BAR(0);
        if (i + 2 < NT) { const int s2 = sl == 0 ? 2 : sl - 1; ATT_DMA(i + 2, s2); }
        const int t = u.t_hi - i, jb = t - 4 * u.qb;
        bool active = true; int esrc = 192;
        if (MODE == M_FOX) {
            if (jb >= 0) esrc = 256 + 64 * jb;
            else { float w = wsf[sl * 64 + lane];
#pragma unroll
                for (int d = 1; d < 64; d <<= 1) { const float o = __shfl_down(w, d); if (lane + d < 64) w += o; }
                w += carry; const float etop = __builtin_bit_cast(float, __builtin_amdgcn_readlane(__builtin_bit_cast(int, w), 63));
                if (__builtin_amdgcn_readfirstlane((int)(etop - Eq0 < -u.thr2))) break;
                wsf[192 + lane] = w; carry = __builtin_bit_cast(float, __builtin_amdgcn_readfirstlane(__builtin_bit_cast(int, w))); }
        }
        if (MODE != M_MEM) { if (jb >= 0) active = (64 * jb <= wid * 32 + 31); }
        if (MODE == M_SWA) active = active && (64 * jb >= wid * 32 - 190);
        bool rowsel = true;
        if (MODE == M_MOBA) { if (jb < 0) { rowsel = (selmask >> (t >> 2)) & 1u; active = (__ballot(rowsel) != 0ull); } }
        if (active) {
            const lds_cptr kp = shc + LDS_K + sl * SLOTB + hi * 1024 + r32 * 16;
            bf16x8 kf[8];
#pragma unroll
            for (int d0 = 0; d0 < 4; ++d0) { kf[2 * d0] = *(const LAS bf16x8*)(kp + d0 * 2048); kf[2 * d0 + 1] = *(const LAS bf16x8*)(kp + d0 * 2048 + 512); }
            f32x16 p0, p1;
            if (MODE == M_MEM) { p0 = f32x16{}; p1 = f32x16{}; }
            else if (MODE == M_FOX) { asm volatile("s_waitcnt lgkmcnt(0)" ::: "memory");
#pragma unroll
                for (int g = 0; g < 4; ++g) { const f32x4 e0 = *(const LAS f32x4*)(wsf + esrc + 8 * g + 4 * hi), e1 = *(const LAS f32x4*)(wsf + esrc + 32 + 8 * g + 4 * hi);
#pragma unroll
                    for (int e = 0; e < 4; ++e) { p0[4 * g + e] = e0[e] - Eq; p1[4 * g + e] = e1[e] - Eq; } } }
            else { float base = u.sl2 * (float)(64 * t + 4 * hi - qpos); if (MODE == M_MOBA) { if (!rowsel) base = -INFINITY; }
#pragma unroll
                for (int r = 0; r < 16; ++r) { p0[r] = __builtin_fmaf(u.sl2, (float)((r & 3) + 8 * (r >> 2)), base); p1[r] = p0[r] + 32.f * u.sl2; } }
            p0 = ATT_MFMA(kf[0], qr[0], p0); p1 = ATT_MFMA(kf[1], qr[0], p1); p0 = ATT_MFMA(kf[2], qr[1], p0); p1 = ATT_MFMA(kf[3], qr[1], p1);
            p0 = ATT_MFMA(kf[4], qr[2], p0); p1 = ATT_MFMA(kf[5], qr[2], p1); p0 = ATT_MFMA(kf[6], qr[3], p0); p1 = ATT_MFMA(kf[7], qr[3], p1);
            if (MODE != M_MEM) { if (jb >= 0) { const int kb = 64 * jb + 4 * hi;
#pragma unroll
                for (int r = 0; r < 16; ++r) { const int kv = kb + (r & 3) + 8 * (r >> 2); if (kv > qrel) p0[r] = -INFINITY; if (kv + 32 > qrel) p1[r] = -INFINITY; } } }
            if (MODE == M_SWA) { const int kb = 64 * jb + 4 * hi;
#pragma unroll
                for (int r = 0; r < 16; ++r) { const int kv = kb + (r & 3) + 8 * (r >> 2); if (qrel - kv >= 128) p0[r] = -INFINITY; if (qrel - kv - 32 >= 128) p1[r] = -INFINITY; } }
#pragma unroll
            for (int r = 0; r < 16; ++r) { p0[r] = fexp2(p0[r]); p1[r] = fexp2(p1[r]); }
            float s = 0.f;
#pragma unroll
            for (int r = 0; r < 16; ++r) s += p0[r] + p1[r];
            l += s;
            u32x4 pw[4];
#pragma unroll
            for (int j = 0; j < 4; ++j) { pw[0][j] = cvtpk(p0[2 * j], p0[2 * j + 1]); pw[1][j] = cvtpk(p0[8 + 2 * j], p0[9 + 2 * j]); pw[2][j] = cvtpk(p1[2 * j], p1[2 * j + 1]); pw[3][j] = cvtpk(p1[8 + 2 * j], p1[9 + 2 * j]); }
            const lds_cptr vp = shc + LDS_V + sl * SLOTB + ((lane >> 4) & 1) * 32 + (lane & 3) * 8 + (4 * hi + ((lane & 15) >> 2)) * 64;
#pragma unroll
            for (int ks = 0; ks < 4; ++ks) { const s16x4 a = vtr(vp + ks * 1024), b = vtr(vp + ks * 1024 + 512), c = vtr(vp + 4096 + ks * 1024), d = vtr(vp + 4096 + ks * 1024 + 512);
                const bf16x8 v0 = (bf16x8){a[0], a[1], a[2], a[3], b[0], b[1], b[2], b[3]}, v1 = (bf16x8){c[0], c[1], c[2], c[3], d[0], d[1], d[2], d[3]};
                o0 = ATT_MFMA(__builtin_bit_cast(bf16x8, pw[ks]), v0, o0); o1 = ATT_MFMA(__builtin_bit_cast(bf16x8, pw[ks]), v1, o1); }
        }
        sl = (sl == 2) ? 0 : sl + 1;
    }
    asm volatile("s_waitcnt vmcnt(0) lgkmcnt(0)" ::: "memory");
    attn_epilogue<MODE>(u, shm, o0, o1, l);
#undef ATT_DMA
}
}
namespace att {
#define AP_PIN(x) asm volatile("" : "+v"(x))
#define AP_SBAR() __builtin_amdgcn_sched_barrier(0)
#define AP_PKW(P, i) cvtpk(P[i], P[i + 1])
#define AP_PAF(w) __builtin_bit_cast(bf16x8, w)
#define AP_VF(a, b) (bf16x8){a[0], a[1], a[2], a[3], b[0], b[1], b[2], b[3]}

__device__ __forceinline__ float dpp_prefix_sum64(float v) {
    int x = __builtin_bit_cast(int, v);
#define AP_DPP_ADD(ctrl, rmask) { const int t_ = __builtin_amdgcn_update_dpp(0, x, ctrl, rmask, 0xf, false); x = __builtin_bit_cast(int, __builtin_bit_cast(float, x) + __builtin_bit_cast(float, t_)); }
    AP_DPP_ADD(0x111, 0xf) AP_DPP_ADD(0x112, 0xf) AP_DPP_ADD(0x114, 0xf) AP_DPP_ADD(0x118, 0xf)
    AP_DPP_ADD(0x142, 0xa)
    AP_DPP_ADD(0x143, 0xc)
#undef AP_DPP_ADD
    return __builtin_bit_cast(float, x);
}

template <int MODE> __device__ __forceinline__ void attn_unit_pipe(const UnitP& u, LAS unsigned char* shm) {
    static_assert(MODE == M_FOX || MODE == M_MOBA, "pipelined body: FoX and MoBA units");
    const int tid = threadIdx.x, lane = tid & 63, r32 = lane & 31, hi = lane >> 5; const int wid = __builtin_amdgcn_readfirstlane(tid >> 6);
    const unsigned lds0 = (unsigned)(size_t)shm;
    LAS float* wsf = (LAS float*)(shm + LDS_WS + wid * WSB);
    const bf16* ksrc = u.K + (size_t)lane * LDP + wid * 8;
    const bf16* vsrc = u.V + (size_t)(16 * (wid & 3) + (lane >> 2)) * LDP + (wid >> 2) * 32 + (lane & 3) * 8;
    const float* fsrc = u.lf + lane + 1;
    const unsigned kdst = lds0 + LDS_K + wid * 1024, vdst = lds0 + LDS_V + wid * 1024, fdst = lds0 + LDS_WS + wid * WSB;
    const int NT = u.t_hi + 1;
#define AP_TILE(i) ((i) < NT ? u.t_hi - (i) : 0)
#define AP_DMA_K(i, so) glds16(ksrc + (size_t)AP_TILE(i) * 64 * LDP, ATT_RFL(kdst + (so)))
#define AP_DMA_V(i, so) glds16(vsrc + (size_t)AP_TILE(i) * 64 * LDP, ATT_RFL(vdst + (so)))
#define AP_DMA_F(i, so) do { if (MODE == M_FOX) glds4(fsrc + AP_TILE(i) * 64, ATT_RFL(fdst + ((so) >> 5))); } while (0)
    AP_DMA_K(0, 0); AP_DMA_V(0, 0); AP_DMA_F(0, 0); AP_DMA_K(1, SLOTB); AP_DMA_F(1, SLOTB); AP_DMA_K(2, 2 * SLOTB); AP_DMA_F(2, 2 * SLOTB);
    bf16x8 qr[4];
    { const bf16* Qw = u.Q + (size_t)(wid * 32 + r32) * LDP + hi * 8;
#pragma unroll
      for (int d0 = 0; d0 < 4; ++d0) qr[d0] = *(const bf16x8*)(Qw + d0 * 16); }
    asm volatile("" : "+v"(qr[0]), "+v"(qr[1]), "+v"(qr[2]), "+v"(qr[3]));
    const int qrel = wid * 32 + r32, qpos = u.qb * 256 + qrel;
    float Eq = 0.f, Eq0 = 0.f, carry = 0.f;
    if (MODE == M_FOX) {
        const int q0 = u.qb * 256;
        float w4[4];
#pragma unroll
        for (int jb = 0; jb < 4; ++jb) w4[jb] = u.lf[q0 + 64 * jb + (63 - lane) + 1];
        if (lane == 0) w4[3] = 0.f;
#pragma unroll
        for (int jb = 3; jb >= 0; --jb) { float w = dpp_prefix_sum64(w4[jb]) + carry; wsf[256 + 64 * jb + (63 - lane)] = w; carry = __builtin_bit_cast(float, __builtin_amdgcn_readlane(__builtin_bit_cast(int, w), 63)); }
        asm volatile("s_waitcnt lgkmcnt(0)" ::: "memory");
        Eq = wsf[256 + qrel]; Eq0 = carry;
    }
    unsigned selmask = 0u;
    if (MODE == M_MOBA) { if (u.qb > 0) {
        f32x16 g = f32x16{}; const float* km = u.kmean + (size_t)r32 * 64 + hi * 8;
#pragma unroll
        for (int d0 = 0; d0 < 4; ++d0) { const f32x4 a0 = *(const f32x4*)(km + 16 * d0), a1 = *(const f32x4*)(km + 16 * d0 + 4); bf16x8 kh, kl;
#pragma unroll
            for (int j = 0; j < 4; ++j) { unsigned h0 = f2bf(a0[j]), h1 = f2bf(a1[j]); kh[j] = (short)h0; kh[j + 4] = (short)h1; kl[j] = (short)f2bf(a0[j] - bf2f((bf16)h0)); kl[j + 4] = (short)f2bf(a1[j] - bf2f((bf16)h1)); }
            g = ATT_MFMA(kh, qr[d0], g); g = ATT_MFMA(kl, qr[d0], g); }
#pragma unroll
        for (int r = 0; r < 16; ++r) if (crow(r, hi) >= u.qb) g[r] = -INFINITY;
#pragma unroll 1
        for (int it = 0; it < 3; ++it) { float bv = -INFINITY; int bj = 99;
#pragma unroll
            for (int r = 0; r < 16; ++r) if (g[r] > bv) { bv = g[r]; bj = crow(r, hi); }
            const float pv = __shfl_xor(bv, 32); const int pj = __shfl_xor(bj, 32);
            if (pv > bv || (pv == bv && pj < bj)) { bv = pv; bj = pj; }
            if (bv > -INFINITY) selmask |= 1u << (bj & 31);
#pragma unroll
            for (int r = 0; r < 16; ++r) if (crow(r, hi) == bj) g[r] = -INFINITY; }
    } }
    const lds_cptr shc = (lds_cptr)shm;
    const lds_cptr kp0 = shc + LDS_K + hi * 1024 + r32 * 16;
    const lds_cptr vp0 = shc + LDS_V + ((lane >> 4) & 1) * 32 + (lane & 3) * 8 + (4 * hi + ((lane & 15) >> 2)) * 64;
#define AP_CINIT4(X, b, p1, I) do { const int ti_ = u.t_hi - (I); \
        if (MODE == M_FOX) { const int jb2_ = ti_ - 4 * u.qb; const int es_ = jb2_ >= 0 ? 256 + 64 * jb2_ : 192; const f32x4 e_ = *(const LAS f32x4*)(wsf + es_ + ((p1) ? 32 : 0) + 2 * (b) + 4 * hi); \
            X[(b)] = e_[0] - Eq; X[(b) + 1] = e_[1] - Eq; X[(b) + 2] = e_[2] - Eq; X[(b) + 3] = e_[3] - Eq; } \
        else { float base_ = u.sl2 * (float)(64 * ti_ + 4 * hi - qpos + ((p1) ? 32 : 0)); if (ti_ < 4 * u.qb) { if (!((selmask >> (ti_ >> 2)) & 1u)) base_ = -INFINITY; } \
            X[(b)] = __builtin_fmaf(u.sl2, (float)(2 * (b)), base_); X[(b) + 1] = __builtin_fmaf(u.sl2, (float)(2 * (b) + 1), base_); X[(b) + 2] = __builtin_fmaf(u.sl2, (float)(2 * (b) + 2), base_); X[(b) + 3] = __builtin_fmaf(u.sl2, (float)(2 * (b) + 3), base_); } } while (0)
#define AP_CMASK(C0, C1, I) do { const int jbm_ = u.t_hi - (I) - 4 * u.qb; if (jbm_ >= 0) { const int kb_ = 64 * jbm_ + 4 * hi; \
        _Pragma("unroll") for (int r = 0; r < 16; ++r) { const int kv_ = kb_ + (r & 3) + 8 * (r >> 2); if (kv_ > qrel) C0[r] = -INFINITY; if (kv_ + 32 > qrel) C1[r] = -INFINITY; } } } while (0)
    f32x16 pA0, pA1, pB0, pB1, o0 = f32x16{}, o1 = f32x16{}; float l = 0.f;
    bf16x8 kf[8]; u32x4 pw0, pw1, pw2, pw3;
    int so_prev = 0, so_cur = 0, so_n1 = SLOTB, so_n2 = 2 * SLOTB;
#define AP_ROT() do { so_prev = so_cur; so_cur = so_n1; so_n1 = so_n2; so_n2 = so_prev; } while (0)
    bool last = false;
    asm volatile("s_waitcnt vmcnt(0) lgkmcnt(0)\n\ts_barrier" ::: "memory");
#pragma unroll
    for (int g = 0; g < 4; ++g) { AP_CINIT4(pA0, 4 * g, 0, 0); AP_CINIT4(pA1, 4 * g, 1, 0); }
#pragma unroll
    for (int d0 = 0; d0 < 4; ++d0) { kf[2 * d0] = *(const LAS bf16x8*)(kp0 + d0 * 2048); kf[2 * d0 + 1] = *(const LAS bf16x8*)(kp0 + d0 * 2048 + 512); }
    pA0 = ATT_MFMA(kf[0], qr[0], pA0); pA1 = ATT_MFMA(kf[1], qr[0], pA1); pA0 = ATT_MFMA(kf[2], qr[1], pA0); pA1 = ATT_MFMA(kf[3], qr[1], pA1);
    pA0 = ATT_MFMA(kf[4], qr[2], pA0); pA1 = ATT_MFMA(kf[5], qr[2], pA1); pA0 = ATT_MFMA(kf[6], qr[3], pA0); pA1 = ATT_MFMA(kf[7], qr[3], pA1);
    AP_CMASK(pA0, pA1, 0);
#pragma unroll
    for (int r = 0; r < 16; ++r) { pA0[r] = fexp2(pA0[r]); pA1[r] = fexp2(pA1[r]); }
    asm volatile("s_waitcnt vmcnt(0) lgkmcnt(0)\n\ts_barrier" ::: "memory");
    AP_DMA_K(3, 0); AP_DMA_V(1, SLOTB); AP_DMA_F(3, 0);
#pragma unroll
    for (int d0 = 0; d0 < 4; ++d0) { kf[2 * d0] = *(const LAS bf16x8*)(kp0 + SLOTB + d0 * 2048); kf[2 * d0 + 1] = *(const LAS bf16x8*)(kp0 + SLOTB + d0 * 2048 + 512); }
#pragma unroll
    for (int g = 0; g < 4; ++g) { AP_CINIT4(pB0, 4 * g, 0, 1); AP_CINIT4(pB1, 4 * g, 1, 1); }
    if (MODE == M_FOX) ATT_WAIT_BAR(3); else ATT_WAIT_BAR(2);
    AP_ROT();
#define AP_GA(C, g, a0, a1, a2, a3, W0, W1, PW) do { C = ATT_MFMA(kf[g], qr[(g) >> 1], C); kf[g] = *(const LAS bf16x8*)(kn_ + ((g) >> 1) * 2048 + ((g) & 1) * 512); \
        sacc += a0; sacc += a1; sacc += a2; sacc += a3; W0; W1; AP_PIN(PW); AP_PIN(sacc); AP_SBAR(); } while (0)
#define AP_GB(O, PW, VA, VB, NA, NB, noff, X, xb, Pn, pb, p1) do { if ((noff) >= 0) { NA = vtr(vp_ + (noff)); NB = vtr(vp_ + (noff) + 512); } \
        O = ATT_MFMA(AP_PAF(PW), AP_VF(VA, VB), O); X[xb] = fexp2(X[xb]); X[(xb) + 1] = fexp2(X[(xb) + 1]); X[(xb) + 2] = fexp2(X[(xb) + 2]); X[(xb) + 3] = fexp2(X[(xb) + 3]); \
        if (!last) AP_CINIT4(Pn, pb, p1, i_ + 1); AP_PIN(X); AP_PIN(Pn); AP_SBAR(); } while (0)
#define AP_VOFF(i) (((i) >> 2) * 4096 + ((i) & 3) * 1024)
#define AP_STEP(C0, C1, P0, P1, I) do { const int i_ = (I); const lds_cptr kn_ = kp0 + so_n1; AP_SBAR(); \
        float sacc = P0[0] + P0[1]; \
        AP_GA(C0, 0, P0[2], P0[3], P0[4], P0[5], pw0[0] = AP_PKW(P0, 0), pw0[1] = AP_PKW(P0, 2), pw0); \
        AP_GA(C1, 1, P0[6], P0[7], P0[8], P0[9], pw0[2] = AP_PKW(P0, 4), pw0[3] = AP_PKW(P0, 6), pw0); \
        AP_GA(C0, 2, P0[10], P0[11], P0[12], P0[13], pw1[0] = AP_PKW(P0, 8), pw1[1] = AP_PKW(P0, 10), pw1); \
        AP_GA(C1, 3, P0[14], P0[15], P1[0], P1[1], pw1[2] = AP_PKW(P0, 12), pw1[3] = AP_PKW(P0, 14), pw1); \
        AP_GA(C0, 4, P1[2], P1[3], P1[4], P1[5], pw2[0] = AP_PKW(P1, 0), pw2[1] = AP_PKW(P1, 2), pw2); \
        AP_GA(C1, 5, P1[6], P1[7], P1[8], P1[9], pw2[2] = AP_PKW(P1, 4), pw2[3] = AP_PKW(P1, 6), pw2); \
        AP_GA(C0, 6, P1[10], P1[11], P1[12], P1[13], pw3[0] = AP_PKW(P1, 8), pw3[1] = AP_PKW(P1, 10), pw3); \
        AP_GA(C1, 7, P1[14], P1[15], 0.f, 0.f, pw3[2] = AP_PKW(P1, 12), pw3[3] = AP_PKW(P1, 14), pw3); \
        l += sacc; \
        AP_DMA_K(i_ + 3, so_cur); AP_DMA_V(i_ + 1, so_n1); AP_DMA_F(i_ + 3, so_cur); \
        AP_CMASK(C0, C1, i_); \
        last = (i_ + 1 >= NT); \
        if (MODE == M_FOX) { if (!last) { if (u.t_hi - (i_ + 1) < 4 * u.qb) {                                   \
            float w_ = wsf[(so_n1 >> 5) / 4 + (63 - lane)]; w_ = dpp_prefix_sum64(w_) + carry; \
            const float etop_ = __builtin_bit_cast(float, __builtin_amdgcn_readfirstlane(__builtin_bit_cast(int, w_)));       \
            if (__builtin_amdgcn_readfirstlane((int)(etop_ - Eq0 < -u.thr2))) last = true;                                  \
            else { wsf[192 + (63 - lane)] = w_; carry = __builtin_bit_cast(float, __builtin_amdgcn_readlane(__builtin_bit_cast(int, w_), 63)); } } } } \
        AP_SBAR(); \
        const lds_cptr vp_ = vp0 + so_prev; s16x4 va0_, vb0_, va1_, vb1_; va0_ = vtr(vp_ + AP_VOFF(0)); vb0_ = vtr(vp_ + AP_VOFF(0) + 512); \
        AP_GB(o0, pw0, va0_, vb0_, va1_, vb1_, AP_VOFF(4), C0, 0, P0, 0, 0); \
        AP_GB(o1, pw0, va1_, vb1_, va0_, vb0_, AP_VOFF(1), C0, 4, P0, 4, 0); \
        AP_GB(o0, pw1, va0_, vb0_, va1_, vb1_, AP_VOFF(5), C0, 8, P0, 8, 0); \
        AP_GB(o1, pw1, va1_, vb1_, va0_, vb0_, AP_VOFF(2), C0, 12, P0, 12, 0); \
        AP_GB(o0, pw2, va0_, vb0_, va1_, vb1_, AP_VOFF(6), C1, 0, P1, 0, 1); \
        AP_GB(o1, pw2, va1_, vb1_, va0_, vb0_, AP_VOFF(3), C1, 4, P1, 4, 1); \
        AP_GB(o0, pw3, va0_, vb0_, va1_, vb1_, AP_VOFF(7), C1, 8, P1, 8, 1); \
        AP_GB(o1, pw3, va1_, vb1_, va0_, vb0_, -1, C1, 12, P1, 12, 1); \
        if (MODE == M_FOX) ATT_WAIT_BAR(3); else ATT_WAIT_BAR(2); \
        AP_ROT(); } while (0)
#define AP_DRAIN(P0, P1) do { float sacc = 0.f; _Pragma("unroll") for (int r = 0; r < 16; ++r) sacc += P0[r] + P1[r]; l += sacc; \
        pw0 = (u32x4){AP_PKW(P0, 0), AP_PKW(P0, 2), AP_PKW(P0, 4), AP_PKW(P0, 6)}; pw1 = (u32x4){AP_PKW(P0, 8), AP_PKW(P0, 10), AP_PKW(P0, 12), AP_PKW(P0, 14)}; \
        pw2 = (u32x4){AP_PKW(P1, 0), AP_PKW(P1, 2), AP_PKW(P1, 4), AP_PKW(P1, 6)}; pw3 = (u32x4){AP_PKW(P1, 8), AP_PKW(P1, 10), AP_PKW(P1, 12), AP_PKW(P1, 14)}; \
        const lds_cptr vp_ = vp0 + so_prev; \
        _Pragma("unroll") for (int ks = 0; ks < 4; ++ks) { const s16x4 a = vtr(vp_ + ks * 1024), b = vtr(vp_ + ks * 1024 + 512), c = vtr(vp_ + 4096 + ks * 1024), d = vtr(vp_ + 4096 + ks * 1024 + 512); \
            const u32x4 pw_ = ks == 0 ? pw0 : ks == 1 ? pw1 : ks == 2 ? pw2 : pw3; o0 = ATT_MFMA(AP_PAF(pw_), AP_VF(a, b), o0); o1 = ATT_MFMA(AP_PAF(pw_), AP_VF(c, d), o1); } } while (0)
    {
        int i = 1; bool inA = true;
#pragma unroll 1
        for (;;) {
            AP_STEP(pB0, pB1, pA0, pA1, i); inA = false; if (last) break;
            AP_STEP(pA0, pA1, pB0, pB1, i + 1); inA = true; if (last) break;
            i += 2;
        }
        if (inA) AP_DRAIN(pA0, pA1); else AP_DRAIN(pB0, pB1);
    }
    asm volatile("s_waitcnt vmcnt(0) lgkmcnt(0)" ::: "memory");
    attn_epilogue<MODE>(u, shm, o0, o1, l);
#undef AP_TILE
#undef AP_DMA_K
#undef AP_DMA_V
#undef AP_DMA_F
#undef AP_CINIT4
#undef AP_CMASK
#undef AP_ROT
#undef AP_GA
#undef AP_GB
#undef AP_VOFF
#undef AP_STEP
#undef AP_DRAIN
}
}
namespace att {
constexpr int G_K = 0, G_V = 32768, G_WS = 65536, G_OST = G_WS + 8 * WSB, G_END = G_OST + 8 * 4096;
constexpr int G_QW = G_END, G_PARTS = G_END + 64, G_PRE = G_PARTS + 384 * 4, G_SEL = G_PRE + 385 * 4;
constexpr int MLIST_CAP = 8192;

struct MobaBufs { unsigned* mcnt; unsigned short* mlist; bf16* slab_o; float* slab_l; };

__device__ __forceinline__ void moba_gate_item(const bf16* P, const float* kmean_all, const MobaBufs& mb, int b, int hb, int i) {
    const int tid = threadIdx.x, lane = tid & 63, r32 = lane & 31, hi = lane >> 5; const int wid = __builtin_amdgcn_readfirstlane(tid >> 6);
    const size_t row0 = (size_t)b * SEQ + i * 256;
    bf16x8 qr[4];
    { const bf16* Qw = P + (row0 + wid * 32 + r32) * LDP + L0_BQ + hb * 64 + hi * 8;
#pragma unroll
      for (int d0 = 0; d0 < 4; ++d0) qr[d0] = *(const bf16x8*)(Qw + d0 * 16); }
    f32x16 g = f32x16{}; const float* km = kmean_all + ((size_t)b * 6 + hb) * 32 * 64 + (size_t)r32 * 64 + hi * 8;
#pragma unroll
    for (int d0 = 0; d0 < 4; ++d0) { const f32x4 a0 = *(const f32x4*)(km + 16 * d0), a1 = *(const f32x4*)(km + 16 * d0 + 4); bf16x8 kh, kl;
#pragma unroll
        for (int j = 0; j < 4; ++j) { unsigned h0 = f2bf(a0[j]), h1 = f2bf(a1[j]); kh[j] = (short)h0; kh[j + 4] = (short)h1; kl[j] = (short)f2bf(a0[j] - bf2f((bf16)h0)); kl[j + 4] = (short)f2bf(a1[j] - bf2f((bf16)h1)); }
        g = ATT_MFMA(kh, qr[d0], g); g = ATT_MFMA(kl, qr[d0], g); }
#pragma unroll
    for (int r = 0; r < 16; ++r) if (crow(r, hi) >= i) g[r] = -INFINITY;
    unsigned selmask = 0u;
#pragma unroll 1
    for (int it = 0; it < 3; ++it) { float bv = -INFINITY; int bj = 99;
#pragma unroll
        for (int r = 0; r < 16; ++r) if (g[r] > bv) { bv = g[r]; bj = crow(r, hi); }
        const float pv = __shfl_xor(bv, 32); const int pj = __shfl_xor(bj, 32);
        if (pv > bv || (pv == bv && pj < bj)) { bv = pv; bj = pj; }
        if (bv > -INFINITY) selmask |= 1u << (bj & 31);
#pragma unroll
        for (int r = 0; r < 16; ++r) if (crow(r, hi) == bj) g[r] = -INFINITY; }
    const bool rep = (hi == 0);
    unsigned mycnt = 0u;
#pragma unroll 1
    for (int j = 0; j < i; ++j) { const unsigned long long m = __ballot(rep && ((selmask >> j) & 1u)); if (lane == j) mycnt = (unsigned)__popcll(m); }
    unsigned base = 0u; unsigned* cnt = mb.mcnt + ((size_t)b * 6 + hb) * 32;
    if (lane < i && mycnt) base = __hip_atomic_fetch_add(cnt + lane, mycnt, __ATOMIC_RELAXED, __HIP_MEMORY_SCOPE_AGENT);
    unsigned short* lst = mb.mlist + (((size_t)b * 6 + hb) * 32) * MLIST_CAP;
    const unsigned long long lt = (1ull << lane) - 1ull;
#pragma unroll 1
    for (int j = 0; j < i; ++j) { const bool sj = rep && ((selmask >> j) & 1u); const unsigned long long m = __ballot(sj);
        const unsigned bj = (unsigned)__builtin_amdgcn_readlane((int)base, j);
        if (sj) { const unsigned pos = bj + (unsigned)__popcll(m & lt), slot = (unsigned)__popc(selmask & ((1u << j) - 1u));
            lst[(size_t)j * MLIST_CAP + pos] = (unsigned short)((i * 256 + wid * 32 + r32) | (slot << 13)); } }
}

#ifndef KV_SUB
#define KV_SUB 2
#endif
struct SubChunk { int row, slot, S; bool valid, act; };
__device__ __forceinline__ void moba_subchunk(const SubChunk& sc, const bf16x8 (&qr)[4], int b, int hb, int j, float sl2, const MobaBufs& mb, LAS unsigned char* shm) {
    const int tid = threadIdx.x, lane = tid & 63, r32 = lane & 31, hi = lane >> 5; const int wid = __builtin_amdgcn_readfirstlane(tid >> 6);
    LAS float* wsf = (LAS float*)(shm + G_WS + wid * WSB);
    LAS float* ost = (LAS float*)(shm + G_OST + wid * 4096);
    const lds_cptr shc = (lds_cptr)shm;
    const int orow = lane >> 1, oh = lane & 1;
    const int S = sc.S; const bool own = (S < 8); const int k = 32 * S + r32; const int row = sc.row; const bool valid = sc.valid;
    f32x16 o0 = f32x16{}, o1 = f32x16{}; float l = 0.f;
#pragma unroll 1
    for (int tt = 3; tt >= 0; --tt) {
        if (own) { if (64 * tt > 32 * S + 31) continue; }
        const lds_cptr kp = shc + G_K + tt * 8192 + hi * 1024 + r32 * 16;
        bf16x8 kf[8];
#pragma unroll
        for (int d0 = 0; d0 < 4; ++d0) { kf[2 * d0] = *(const LAS bf16x8*)(kp + d0 * 2048); kf[2 * d0 + 1] = *(const LAS bf16x8*)(kp + d0 * 2048 + 512); }
        float base = sl2 * (float)(64 * (4 * j + tt) + 4 * hi - row); if (!valid) base = -INFINITY;
        f32x16 p0, p1;
#pragma unroll
        for (int r = 0; r < 16; ++r) { p0[r] = __builtin_fmaf(sl2, (float)((r & 3) + 8 * (r >> 2)), base); p1[r] = p0[r] + 32.f * sl2; }
        p0 = ATT_MFMA(kf[0], qr[0], p0); p1 = ATT_MFMA(kf[1], qr[0], p1); p0 = ATT_MFMA(kf[2], qr[1], p0); p1 = ATT_MFMA(kf[3], qr[1], p1);
        p0 = ATT_MFMA(kf[4], qr[2], p0); p1 = ATT_MFMA(kf[5], qr[2], p1); p0 = ATT_MFMA(kf[6], qr[3], p0); p1 = ATT_MFMA(kf[7], qr[3], p1);
        if (own) { const int kb = 64 * tt + 4 * hi;
#pragma unroll
            for (int r = 0; r < 16; ++r) { const int kv = kb + (r & 3) + 8 * (r >> 2); if (kv > k) p0[r] = -INFINITY; if (kv + 32 > k) p1[r] = -INFINITY; } }
#pragma unroll
        for (int r = 0; r < 16; ++r) { p0[r] = fexp2(p0[r]); p1[r] = fexp2(p1[r]); }
        float sm = 0.f;
#pragma unroll
        for (int r = 0; r < 16; ++r) sm += p0[r] + p1[r];
        l += sm;
        u32x4 pw[4];
#pragma unroll
        for (int q = 0; q < 4; ++q) { pw[0][q] = cvtpk(p0[2 * q], p0[2 * q + 1]); pw[1][q] = cvtpk(p0[8 + 2 * q], p0[9 + 2 * q]); pw[2][q] = cvtpk(p1[2 * q], p1[2 * q + 1]); pw[3][q] = cvtpk(p1[8 + 2 * q], p1[9 + 2 * q]); }
        const lds_cptr vp = shc + G_V + tt * 8192 + ((lane >> 4) & 1) * 32 + (lane & 3) * 8 + (4 * hi + ((lane & 15) >> 2)) * 64;
#pragma unroll
        for (int ks = 0; ks < 4; ++ks) { const s16x4 va = vtr(vp + ks * 1024), vb = vtr(vp + ks * 1024 + 512), vc = vtr(vp + 4096 + ks * 1024), vd = vtr(vp + 4096 + ks * 1024 + 512);
            const bf16x8 v0 = (bf16x8){va[0], va[1], va[2], va[3], vb[0], vb[1], vb[2], vb[3]}, v1 = (bf16x8){vc[0], vc[1], vc[2], vc[3], vd[0], vd[1], vd[2], vd[3]};
            o0 = ATT_MFMA(__builtin_bit_cast(bf16x8, pw[ks]), v0, o0); o1 = ATT_MFMA(__builtin_bit_cast(bf16x8, pw[ks]), v1, o1); }
    }
    l += __shfl_xor(l, 32);
    const size_t brow = (size_t)b * SEQ + row;
    if (hi == 0) { wsf[r32] = l > 0.f ? 1.f / l : 0.f; if (valid) mb.slab_l[((size_t)sc.slot * T + brow) * 6 + hb] = l; }
    asm volatile("s_waitcnt lgkmcnt(0)" ::: "memory");
    float rl[16];
#pragma unroll
    for (int r = 0; r < 16; ++r) rl[r] = wsf[crow(r, hi)];
    const int row_o = __shfl(row, orow), slot_o = __shfl(sc.slot, orow); const bool valid_o = __shfl((int)valid, orow) != 0;
    bf16* dst = mb.slab_o + (((size_t)slot_o * T + (size_t)b * SEQ + row_o) * 6 + hb) * 64 + 16 * oh;
#pragma unroll
    for (int d0 = 0; d0 < 2; ++d0) {
#pragma unroll
        for (int r = 0; r < 16; ++r) ost[crow(r, hi) * 32 + r32] = (d0 == 0 ? o0[r] : o1[r]) * rl[r];
        asm volatile("s_waitcnt lgkmcnt(0)" ::: "memory");
        f32x4 ov[4];
#pragma unroll
        for (int q = 0; q < 4; ++q) ov[q] = *(const LAS f32x4*)(ost + orow * 32 + 16 * oh + 4 * q);
        u32x4 y0, y1; y0[0] = cvtpk(ov[0][0], ov[0][1]); y0[1] = cvtpk(ov[0][2], ov[0][3]); y0[2] = cvtpk(ov[1][0], ov[1][1]); y0[3] = cvtpk(ov[1][2], ov[1][3]);
        y1[0] = cvtpk(ov[2][0], ov[2][1]); y1[1] = cvtpk(ov[2][2], ov[2][3]); y1[2] = cvtpk(ov[3][0], ov[3][1]); y1[3] = cvtpk(ov[3][2], ov[3][3]);
        if (valid_o) { *(u32x4*)(dst + 32 * d0) = y0; *(u32x4*)(dst + 32 * d0 + 8) = y1; }
        asm volatile("s_waitcnt lgkmcnt(0)" ::: "memory");
    }
}
__device__ __forceinline__ void moba_kv_unit(const bf16* P, const MobaBufs& mb, int b, int hb, int j, int part, unsigned* qctr, LAS unsigned char* shm) {
    const int tid = threadIdx.x, lane = tid & 63, r32 = lane & 31, hi = lane >> 5; const int wid = __builtin_amdgcn_readfirstlane(tid >> 6);
    const unsigned lds0 = (unsigned)(size_t)shm;
    const bf16* Pb = P + (size_t)b * SEQ * LDP;
    { const bf16* ksrc = Pb + L0_BK + hb * 64 + (size_t)(256 * j + lane) * LDP + wid * 8;
      const bf16* vsrc = Pb + L0_BV + hb * 64 + (size_t)(256 * j + 16 * (wid & 3) + (lane >> 2)) * LDP + (wid >> 2) * 32 + (lane & 3) * 8;
#pragma unroll
      for (int tt = 0; tt < 4; ++tt) { glds16(ksrc + (size_t)tt * 64 * LDP, ATT_RFL(lds0 + G_K + tt * 8192 + wid * 1024)); glds16(vsrc + (size_t)tt * 64 * LDP, ATT_RFL(lds0 + G_V + tt * 8192 + wid * 1024)); } }
    const int list = (b * 6 + hb) * 32 + j;
    const int cnt = (int)mb.mcnt[list]; const int rows_total = 256 + cnt;
    const unsigned short* lst = mb.mlist + (size_t)list * MLIST_CAP;
    const float sl2 = alibi_slope2(6 + hb);
    unsigned nxt = 0u; if (tid == 0) nxt = __hip_atomic_fetch_add(qctr, 1u, __ATOMIC_RELAXED, __HIP_MEMORY_SCOPE_AGENT);
    SubChunk cur, nx; bf16x8 qc[4], qn[4];
#define KV_DESC(D, s_) do { const int S_ = 8 * KV_SUB * part + wid + 8 * (s_); D.S = S_; D.act = ((s_) < KV_SUB) && (32 * S_ < rows_total); const int k_ = 32 * S_ + r32; \
        if (S_ < 8) { D.row = 256 * j + k_; D.slot = 3; D.valid = true; } \
        else { const int idx_ = k_ - 256; const bool v_ = D.act && idx_ < cnt; const unsigned e_ = v_ ? (unsigned)lst[idx_] : 0u; D.row = (int)(e_ & 8191u); D.slot = (int)(e_ >> 13); D.valid = v_; } } while (0)
    KV_DESC(cur, 0);
    { const bf16* Q0 = Pb + (size_t)cur.row * LDP + L0_BQ + hb * 64 + hi * 8;
#pragma unroll
      for (int d0 = 0; d0 < 4; ++d0) qc[d0] = *(const bf16x8*)(Q0 + d0 * 16); }
    asm volatile("" : "+v"(qc[0]), "+v"(qc[1]), "+v"(qc[2]), "+v"(qc[3]));
    asm volatile("s_waitcnt vmcnt(0) lgkmcnt(0)\n\ts_barrier" ::: "memory");
#pragma unroll 1
    for (int s = 0; s < KV_SUB; ++s) {
        if (!cur.act) break;
        KV_DESC(nx, s + 1);
        { const bf16* Q1 = Pb + (size_t)nx.row * LDP + L0_BQ + hb * 64 + hi * 8;
#pragma unroll
          for (int d0 = 0; d0 < 4; ++d0) qn[d0] = *(const bf16x8*)(Q1 + d0 * 16); }
        moba_subchunk(cur, qc, b, hb, j, sl2, mb, shm);
        cur = nx;
#pragma unroll
        for (int d0 = 0; d0 < 4; ++d0) qc[d0] = qn[d0];
    }
#undef KV_DESC
    if (tid == 0) *(LAS unsigned*)(shm + G_QW) = nxt;
    asm volatile("s_waitcnt vmcnt(0) lgkmcnt(0)\n\ts_barrier" ::: "memory");
}

__device__ __forceinline__ void moba_kv_phase(const Args& a, const MobaBufs& mb, LAS unsigned char* lds, unsigned* qctr) {
    const bf16* P = (const bf16*)(a.ws + WS_P);
    const int tid = threadIdx.x;
    LAS unsigned* qw = (LAS unsigned*)(lds + G_QW); LAS int* parts = (LAS int*)(lds + G_PARTS); LAS int* pre = (LAS int*)(lds + G_PRE); LAS int* sel = (LAS int*)(lds + G_SEL);
    if (tid == 0) {
        unsigned sp = 0u; while (__hip_atomic_load(mb.mcnt + 512, __ATOMIC_RELAXED, __HIP_MEMORY_SCOPE_AGENT) < 372u) { __builtin_amdgcn_s_sleep(2); if (++sp > (1u << 22)) break; }
        __builtin_amdgcn_fence(__ATOMIC_ACQUIRE, "agent"); asm volatile("s_waitcnt vmcnt(0)" ::: "memory"); }
    __syncthreads();
    if (tid < 384) parts[tid] = (256 + (int)__hip_atomic_load(mb.mcnt + tid, __ATOMIC_RELAXED, __HIP_MEMORY_SCOPE_AGENT) + 256 * KV_SUB - 1) / (256 * KV_SUB);
    if (tid == 0) *qw = __hip_atomic_fetch_add(qctr, 1u, __ATOMIC_RELAXED, __HIP_MEMORY_SCOPE_AGENT);
    __syncthreads();
    if (tid < 385) { int s = 0; for (int k = 0; k < tid; ++k) s += parts[k] - 1; pre[tid] = s; }
    __syncthreads();
    const int nfull = pre[384], total = nfull + 384;
    for (;;) {
        const int idx = __builtin_amdgcn_readfirstlane((int)*qw);
        if (idx >= total) break;
        if (tid < 384) { if (idx < nfull) { if (pre[tid] <= idx && idx < pre[tid + 1]) { sel[0] = tid; sel[1] = idx - pre[tid]; } }
                         else if (tid == idx - nfull) { sel[0] = tid; sel[1] = parts[tid] - 1; } }
        __syncthreads();
        const int list = __builtin_amdgcn_readfirstlane(sel[0]), part = __builtin_amdgcn_readfirstlane(sel[1]);
        const int bh = list >> 5, j = list & 31;
        moba_kv_unit(P, mb, bh / 6, bh % 6, j, part, qctr, lds);
    }
}

__device__ __forceinline__ void moba_combine(const Args& a, const MobaBufs& mb, int vcu, int G) {
    const bf16* P = (const bf16*)(a.ws + WS_P); bf16* Y = (bf16*)(a.ws + WS_Y);
    const int NIT = T * 6 * 8;
    for (int it = vcu * 512 + threadIdx.x; it < NIT; it += G * 512) {
        const int dg = it & 7, rh = it >> 3, hb = rh % 6, brow = rh / 6, blk = (brow & (SEQ - 1)) >> 8, nv = blk < 3 ? blk : 3;
        float O[8], L = 0.f;
#pragma unroll
        for (int e = 0; e < 8; ++e) O[e] = 0.f;
#pragma unroll
        for (int s = 0; s < 4; ++s) { if (s == 3 || s < nv) { const size_t si = ((size_t)s * T + brow) * 6 + hb; const float l = mb.slab_l[si]; const u32x4 w = *(const u32x4*)(mb.slab_o + si * 64 + 8 * dg);
#pragma unroll
            for (int e = 0; e < 4; ++e) { O[2 * e] += l * __uint_as_float(w[e] << 16); O[2 * e + 1] += l * __uint_as_float(w[e] & 0xffff0000u); } L += l; } }
        const float il = 1.f / L;
        const u32x4 z = *(const u32x4*)(P + (size_t)brow * LDP + L0_Z + (6 + hb) * 64 + 8 * dg); u32x4 y;
#pragma unroll
        for (int e = 0; e < 4; ++e) y[e] = cvtpk(O[2 * e] * il * __uint_as_float(z[e] << 16), O[2 * e + 1] * il * __uint_as_float(z[e] & 0xffff0000u));
        *(u32x4*)(Y + (size_t)brow * DM + (6 + hb) * 64 + 8 * dg) = y;
    }
}
}
#ifndef ATT_PIPE
#define ATT_PIPE 1
#endif
#ifndef MOBA_GATHER
#define MOBA_GATHER 1
#endif
namespace att {
constexpr int R_K = 0, R_V = 49152, R_WS = 98304, R_OST = R_WS + 8 * 256, R_END = R_OST + 8 * 4096;
__device__ __forceinline__ void swa_res_unit(const bf16* P, bf16* Y, const float* sinks, int b, int kvh, int qb, unsigned* qctr, LAS unsigned* qw, LAS unsigned char* shm) {
    const int tid = threadIdx.x, lane = tid & 63, r32 = lane & 31, hi = lane >> 5; const int wid = __builtin_amdgcn_readfirstlane(tid >> 6);
    const unsigned lds0 = (unsigned)(size_t)shm;
    const bf16* Pb = P + (size_t)b * SEQ * LDP;
    const int t0 = 4 * qb - 2 < 0 ? 0 : 4 * qb - 2, ntl = 4 * qb + 4 - t0;
    { const bf16* ksrc = Pb + L0_AK + kvh * 64 + (size_t)(64 * t0 + lane) * LDP + wid * 8;
      const bf16* vsrc = Pb + L0_AV + kvh * 64 + (size_t)(64 * t0 + 16 * (wid & 3) + (lane >> 2)) * LDP + (wid >> 2) * 32 + (lane & 3) * 8;
#pragma unroll 1
      for (int tt = 0; tt < ntl; ++tt) { glds16(ksrc + (size_t)tt * 64 * LDP, ATT_RFL(lds0 + R_K + tt * 8192 + wid * 1024)); glds16(vsrc + (size_t)tt * 64 * LDP, ATT_RFL(lds0 + R_V + tt * 8192 + wid * 1024)); } }
    unsigned nxt = 0u; if (tid == 0) nxt = __hip_atomic_fetch_add(qctr, 1u, __ATOMIC_RELAXED, __HIP_MEMORY_SCOPE_AGENT);
    const int qmin = 256 * qb + 32 * wid, qpos = qmin + r32; const size_t brow = (size_t)b * SEQ + qpos;
    asm volatile("s_waitcnt vmcnt(0) lgkmcnt(0)\n\ts_barrier" ::: "memory");
    LAS float* wsf = (LAS float*)(shm + R_WS + wid * 256); LAS float* ost = (LAS float*)(shm + R_OST + wid * 4096);
    const lds_cptr shc = (lds_cptr)shm;
    const int orow = lane >> 1, oh = lane & 1;
    const int t_hi = (qmin + 31) >> 6, t_lo = (qmin - 127) < 0 ? 0 : (qmin - 127) >> 6;
#pragma unroll 1
    for (int g = 0; g < 3; ++g) { const int h = 3 * kvh + g; float sl2v = alibi_slope2(h); asm volatile("" : "+v"(sl2v)); const float sl8v = sl2v * 4.f * 2.f, sl16v = sl8v * 2.f, sl24v = sl8v + sl16v, sl32v = sl16v * 2.f;
        bf16x8 qr[4];
        { const bf16* Qw = P + brow * LDP + L0_AQ + h * 64 + hi * 8;
#pragma unroll
          for (int d0 = 0; d0 < 4; ++d0) qr[d0] = *(const bf16x8*)(Qw + d0 * 16); }
        const size_t srow = (size_t)b * SEQ + qmin + orow;
        u32x4 zz[2][2];
#pragma unroll
        for (int d0 = 0; d0 < 2; ++d0) { const bf16* zp = P + srow * LDP + L0_Z + h * 64 + 32 * d0 + 16 * oh; zz[d0][0] = *(const u32x4*)zp; zz[d0][1] = *(const u32x4*)(zp + 8); }
        f32x16 o0 = f32x16{}, o1 = f32x16{}; float l = 0.f;
#pragma unroll 1
        for (int t = t_hi; t >= t_lo; --t) {
            const lds_cptr kp = shc + R_K + (t - t0) * 8192 + hi * 1024 + r32 * 16;
            bf16x8 kf[8];
#pragma unroll
            for (int d0 = 0; d0 < 4; ++d0) { kf[2 * d0] = *(const LAS bf16x8*)(kp + d0 * 2048); kf[2 * d0 + 1] = *(const LAS bf16x8*)(kp + d0 * 2048 + 512); }
            const float base = sl2v * (float)(64 * t + 4 * hi - qpos);
            f32x16 p0, p1;
#pragma unroll
            for (int g4 = 0; g4 < 4; ++g4) { const float a0 = g4 == 0 ? base : g4 == 1 ? base + sl8v : g4 == 2 ? base + sl16v : base + sl24v;
                p0[4 * g4] = a0; p0[4 * g4 + 1] = a0 + sl2v; p0[4 * g4 + 2] = p0[4 * g4 + 1] + sl2v; p0[4 * g4 + 3] = p0[4 * g4 + 2] + sl2v; }
#pragma unroll
            for (int r = 0; r < 16; ++r) p1[r] = p0[r] + sl32v;
            p0 = ATT_MFMA(kf[0], qr[0], p0); p1 = ATT_MFMA(kf[1], qr[0], p1); p0 = ATT_MFMA(kf[2], qr[1], p0); p1 = ATT_MFMA(kf[3], qr[1], p1);
            p0 = ATT_MFMA(kf[4], qr[2], p0); p1 = ATT_MFMA(kf[5], qr[2], p1); p0 = ATT_MFMA(kf[6], qr[3], p0); p1 = ATT_MFMA(kf[7], qr[3], p1);
            { int d = qpos - (64 * t + 4 * hi); asm volatile("" : "+v"(d));
              if (64 * t + 63 > qmin) {
#pragma unroll
                  for (int r = 0; r < 16; ++r) { const int c = (r & 3) + 8 * (r >> 2); if (c > d) p0[r] = -INFINITY; if (c + 32 > d) p1[r] = -INFINITY; } }
              if (64 * t < qmin + 31 - 127) {
#pragma unroll
                  for (int r = 0; r < 16; ++r) { const int c = (r & 3) + 8 * (r >> 2); if (d - c >= 128) p0[r] = -INFINITY; if (d - c - 32 >= 128) p1[r] = -INFINITY; } } }
#pragma unroll
            for (int r = 0; r < 16; ++r) { p0[r] = fexp2(p0[r]); p1[r] = fexp2(p1[r]); }
            float sm = 0.f;
#pragma unroll
            for (int r = 0; r < 16; ++r) sm += p0[r] + p1[r];
            l += sm;
            u32x4 pw[4];
#pragma unroll
            for (int q = 0; q < 4; ++q) { pw[0][q] = cvtpk(p0[2 * q], p0[2 * q + 1]); pw[1][q] = cvtpk(p0[8 + 2 * q], p0[9 + 2 * q]); pw[2][q] = cvtpk(p1[2 * q], p1[2 * q + 1]); pw[3][q] = cvtpk(p1[8 + 2 * q], p1[9 + 2 * q]); }
            const lds_cptr vp = shc + R_V + (t - t0) * 8192 + ((lane >> 4) & 1) * 32 + (lane & 3) * 8 + (4 * hi + ((lane & 15) >> 2)) * 64;
#pragma unroll
            for (int ks = 0; ks < 4; ++ks) { const s16x4 va = vtr(vp + ks * 1024), vb = vtr(vp + ks * 1024 + 512), vc = vtr(vp + 4096 + ks * 1024), vd = vtr(vp + 4096 + ks * 1024 + 512);
                const bf16x8 v0 = (bf16x8){va[0], va[1], va[2], va[3], vb[0], vb[1], vb[2], vb[3]}, v1 = (bf16x8){vc[0], vc[1], vc[2], vc[3], vd[0], vd[1], vd[2], vd[3]};
                o0 = ATT_MFMA(__builtin_bit_cast(bf16x8, pw[ks]), v0, o0); o1 = ATT_MFMA(__builtin_bit_cast(bf16x8, pw[ks]), v1, o1); }
        }
        l += __shfl_xor(l, 32); l += fexp2(LOG2E * sinks[h]);
        if (hi == 0) wsf[r32] = 1.f / l;
        asm volatile("s_waitcnt lgkmcnt(0)" ::: "memory");
        float rl[16];
#pragma unroll
        for (int r = 0; r < 16; ++r) rl[r] = wsf[crow(r, hi)];
#pragma unroll
        for (int d0 = 0; d0 < 2; ++d0) {
#pragma unroll
            for (int r = 0; r < 16; ++r) ost[crow(r, hi) * 32 + r32] = (d0 == 0 ? o0[r] : o1[r]) * rl[r];
            asm volatile("s_waitcnt lgkmcnt(0)" ::: "memory");
            f32x4 ov[4];
#pragma unroll
            for (int j = 0; j < 4; ++j) ov[j] = *(const LAS f32x4*)(ost + orow * 32 + 16 * oh + 4 * j);
            const u32x4 z0 = zz[d0][0], z1 = zz[d0][1]; u32x4 y0, y1;
#pragma unroll
            for (int j = 0; j < 4; ++j) { const unsigned za = j < 2 ? z0[2 * j] : z1[2 * (j - 2)], zb = j < 2 ? z0[2 * j + 1] : z1[2 * (j - 2) + 1];
                const unsigned w0 = cvtpk(ov[j][0] * __uint_as_float(za << 16), ov[j][1] * __uint_as_float(za & 0xffff0000u)), w1 = cvtpk(ov[j][2] * __uint_as_float(zb << 16), ov[j][3] * __uint_as_float(zb & 0xffff0000u));
                if (j < 2) { y0[2 * j] = w0; y0[2 * j + 1] = w1; } else { y1[2 * (j - 2)] = w0; y1[2 * (j - 2) + 1] = w1; } }
            bf16* yp = Y + srow * DM + h * 64 + 32 * d0 + 16 * oh;
            *(u32x4*)yp = y0; *(u32x4*)(yp + 8) = y1;
            asm volatile("s_waitcnt lgkmcnt(0)" ::: "memory");
        }
    }
    if (tid == 0) *qw = nxt;
    asm volatile("s_waitcnt vmcnt(0) lgkmcnt(0)\n\ts_barrier" ::: "memory");
}

constexpr int NUNITS = 1024;
__device__ __forceinline__ void attn_phase(int layer, const Args& a, LAS unsigned char* lds, unsigned* qctr, const MobaBufs& mb) {
    unsigned char* ws = a.ws; const bf16* P = (const bf16*)(ws + WS_P); bf16* Y = (bf16*)(ws + WS_Y);
    LAS unsigned* qw = (LAS unsigned*)(lds + R_END);
    const int tid = threadIdx.x, lane = tid & 63;
    float thr2 = 0.f; bool zok = false;
    if (layer == 1) { const float* g = a.in[11]; float mq = fabsf(g[lane]), mk = fabsf(g[64 + lane]);
#pragma unroll
        for (int o = 1; o < 64; o <<= 1) { mq = fmaxf(mq, __shfl_xor(mq, o)); mk = fmaxf(mk, __shfl_xor(mk, o)); }
        thr2 = LOG2E * (104.f + 2.f * 8.f * mq * mk); thr2 = __builtin_bit_cast(float, __builtin_amdgcn_readfirstlane(__builtin_bit_cast(int, thr2))); }
    if (tid == 0) *qw = __hip_atomic_fetch_add(qctr, 1u, __ATOMIC_RELAXED, __HIP_MEMORY_SCOPE_AGENT);
    __syncthreads();
    for (;;) {
        int idx = __builtin_amdgcn_readfirstlane((int)*qw);
        if (MOBA_GATHER && layer == 0) {
            if (idx >= 372 + 128 + 256) break;
            if (idx < 372) { moba_gate_item(P, (const float*)(ws + WS_KMEAN), mb, (idx % 12) / 6, (idx % 12) % 6, 1 + idx / 12);
                asm volatile("s_waitcnt vmcnt(0)" ::: "memory");
                __syncthreads();
                if (tid == 0) { __builtin_amdgcn_fence(__ATOMIC_RELEASE, "agent"); asm volatile("s_waitcnt vmcnt(0)" ::: "memory");
                    __hip_atomic_fetch_add(mb.mcnt + 512, 1u, __ATOMIC_RELAXED, __HIP_MEMORY_SCOPE_AGENT);
                    *qw = __hip_atomic_fetch_add(qctr, 1u, __ATOMIC_RELAXED, __HIP_MEMORY_SCOPE_AGENT); }
                __syncthreads(); continue; }
            if (idx < 500) { const int k = idx - 372; swa_res_unit(P, Y, a.in[5], (k & 3) >> 1, k & 1, 31 - (k >> 2), qctr, qw, lds); continue; }
            idx += 768 - 500;
        }
        if (idx >= NUNITS) break;
        if (layer == 1 && idx >= 512 && !zok) {
            if (tid == 0) { unsigned sp = 0u; while (__hip_atomic_load(mb.mcnt + 1024, __ATOMIC_RELAXED, __HIP_MEMORY_SCOPE_AGENT) < 128u) { __builtin_amdgcn_s_sleep(2); if (++sp > (1u << 22)) break; }
                __builtin_amdgcn_fence(__ATOMIC_ACQUIRE, "agent"); asm volatile("s_waitcnt vmcnt(0)" ::: "memory"); }
            __syncthreads(); zok = true; }
        UnitP u; u.qctr = qctr; u.qw = qw; u.sl2 = 0.f; u.sinkp = 0.f; u.thr2 = thr2; u.lf = nullptr; u.kmean = nullptr; u.pitch = LDP;
        int mode;
        if (idx >= 768) { const int k = idx - 768, qb = k >> 3, bh = k & 7, b = bh >> 2, hm = bh & 3; mode = M_MEM;
            const size_t row0 = (size_t)b * SEQ + qb * 256; const int mq = layer == 0 ? L0_MQ : L1_MQ, zc = (layer == 0 ? L0_Z : L1_Z) + (12 + hm) * 64;
            const bf16* MK = (const bf16*)(ws + WS_MKV + (size_t)(2 * layer) * MKV_ONE) + (size_t)b * MEML * 256 + hm * 64; const bf16* MV = (const bf16*)(ws + WS_MKV + (size_t)(2 * layer + 1) * MKV_ONE) + (size_t)b * MEML * 256 + hm * 64;
            u.Q = P + row0 * LDP + mq + hm * 64; u.K = MK; u.V = MV; u.pitch = 256; u.Z = P + row0 * LDP + zc; u.Y = Y + row0 * DM + (12 + hm) * 64; u.qb = qb; u.t_hi = 3; u.t_lo = 0;
        } else if (layer == 1) { int qb, b, h;
            if (idx < 512) { qb = 31 - idx / 16; b = (idx % 16) / 8; h = idx % 8; } else { const int k = idx - 512; qb = 31 - k / 8; b = (k % 8) / 4; h = 8 + k % 4; }
            mode = M_FOX;
            const size_t row0 = (size_t)b * SEQ + qb * 256; const bf16* Pb = P + (size_t)b * SEQ * LDP;
            u.Q = P + row0 * LDP + L1_CQ + h * 64; u.K = Pb + L1_CK + h * 64; u.V = Pb + L1_CV + h * 64; u.Z = P + row0 * LDP + L1_Z + h * 64; u.Y = Y + row0 * DM + h * 64;
            u.qb = qb; u.t_hi = 4 * qb + 3; u.t_lo = 0; u.lf = (const float*)(ws + WS_LOGF) + ((size_t)b * 12 + h) * SEQ;
        } else if (idx < 384) { const int qb = 31 - idx / 12, bh = idx % 12, b = bh / 6, hb = bh % 6; mode = M_MOBA;
            const size_t row0 = (size_t)b * SEQ + qb * 256; const bf16* Pb = P + (size_t)b * SEQ * LDP;
            u.Q = P + row0 * LDP + L0_BQ + hb * 64; u.K = Pb + L0_BK + hb * 64; u.V = Pb + L0_BV + hb * 64; u.Z = P + row0 * LDP + L0_Z + (6 + hb) * 64; u.Y = Y + row0 * DM + (6 + hb) * 64;
            u.qb = qb; u.t_hi = 4 * qb + 3; u.t_lo = 0; u.sl2 = alibi_slope2(6 + hb); u.kmean = (const float*)(ws + WS_KMEAN) + ((size_t)b * 6 + hb) * 32 * 64;
        } else { const int k = idx - 384, qb = k / 12, bh = k % 12, b = bh / 6, h = bh % 6, kvh = h / 3; mode = M_SWA;
            const size_t row0 = (size_t)b * SEQ + qb * 256; const bf16* Pb = P + (size_t)b * SEQ * LDP;
            u.Q = P + row0 * LDP + L0_AQ + h * 64; u.K = Pb + L0_AK + kvh * 64; u.V = Pb + L0_AV + kvh * 64; u.Z = P + row0 * LDP + L0_Z + h * 64; u.Y = Y + row0 * DM + h * 64;
            u.qb = qb; u.t_hi = 4 * qb + 3; u.t_lo = 4 * qb - 2 < 0 ? 0 : 4 * qb - 2; u.sl2 = alibi_slope2(h); u.sinkp = fexp2(LOG2E * a.in[5][h]);
        }
        if (mode == M_MEM) attn_unit<M_MEM>(u, lds); else if (mode == M_FOX) { if (ATT_PIPE) attn_unit_pipe<M_FOX>(u, lds); else attn_unit<M_FOX>(u, lds); } else if (mode == M_MOBA) { if (ATT_PIPE) attn_unit_pipe<M_MOBA>(u, lds); else attn_unit<M_MOBA>(u, lds); } else attn_unit<M_SWA>(u, lds);
    }
}
}
typedef GAS unsigned gu32;
#define RLX_AGENT __ATOMIC_RELAXED, __HIP_MEMORY_SCOPE_AGENT
#define XB_TMO      128
#define XB_XCNT(j)  (256  + 64 * (j))
#define XB_XSUB(j)  (1280 + 64 * (j))
#define XB_XGEN(j)  (2304 + 64 * (j))
#define XB_TOP      3328
#define XB_TOPGEN   3392
#define XCD_BAR_WORDS 3456
#define XB_SPIN_CAP (1u << 18)

__device__ __forceinline__ unsigned xb_ld(unsigned* p)              { return __hip_atomic_load(p, __ATOMIC_RELAXED, __HIP_MEMORY_SCOPE_AGENT); }
__device__ __forceinline__ unsigned xb_add(unsigned* p, unsigned v) { return __hip_atomic_fetch_add(p, v, __ATOMIC_RELAXED, __HIP_MEMORY_SCOPE_AGENT); }
__device__ __forceinline__ unsigned xb_xcc_id() { return (unsigned)__builtin_amdgcn_s_getreg((3 << 11) | 20) & 0xFu; }
#define XB_SPIN(cond, bar) do { unsigned _sp = 0; while (cond) { __builtin_amdgcn_s_sleep(1); \
    if ((++_sp & 255u) == 0u) { if (xb_ld(&(bar)[XB_TMO])) break; if (_sp > XB_SPIN_CAP) { atomicAdd(&(bar)[XB_TMO], 1u); break; } } } } while (0)

struct XcdBarrier {
    unsigned* bar; unsigned x;
    volatile LAS unsigned* st;
};

__device__ __forceinline__ XcdBarrier xcd_barrier_post(unsigned* bar, volatile LAS unsigned* st) {
    XcdBarrier b; b.bar = bar; b.x = xb_xcc_id(); b.st = st;
    if (threadIdx.x == 0) (void)xb_add(&bar[XB_XCNT(b.x)], 1u);
    return b;
}
__device__ __forceinline__ void xcd_barrier_complete(unsigned* bar, unsigned x, unsigned& nloc, unsigned& nx) {
    const unsigned G = gridDim.x * gridDim.y * gridDim.z;
    unsigned sum, cnt, mine, sp = 0u;
    for (;;) {
        sum = 0u; cnt = 0u; mine = 0u;
#pragma unroll
        for (unsigned j = 0; j < 16; ++j) { const unsigned c = xb_ld(&bar[XB_XCNT(j)]); sum += c; cnt += (c > 0u) ? 1u : 0u; mine = (j == x) ? c : mine; }
        if (sum == G) break;
        __builtin_amdgcn_s_sleep(1);
        if ((++sp & 255u) == 0u) { if (xb_ld(&bar[XB_TMO])) break; if (sp > XB_SPIN_CAP) { atomicAdd(&bar[XB_TMO], 1u); break; } }
    }
    nloc = mine > 0u ? mine : 1u; nx = cnt > 0u ? cnt : 1u;
}

__device__ __forceinline__ void xcd_barrier(const XcdBarrier& b) {
    asm volatile("s_waitcnt vmcnt(0)" ::: "memory");
    __syncthreads();
    if (threadIdx.x == 0) {
        unsigned* bar = b.bar;
        __builtin_amdgcn_s_waitcnt(0);
        unsigned nloc = b.st[0], nx = b.st[1];
        if (nloc == 0u) { xcd_barrier_complete(bar, b.x, nloc, nx); b.st[0] = nloc; b.st[1] = nx; }
        const unsigned old = xb_add(&bar[XB_XSUB(b.x)], 1u);
        const unsigned gen = old / nloc;
        if (old + 1u == (gen + 1u) * nloc) {
            __builtin_amdgcn_fence(__ATOMIC_RELEASE, "agent");
            asm volatile("s_waitcnt vmcnt(0)" ::: "memory");
            const unsigned og = xb_add(&bar[XB_TOP], 1u);
            const unsigned tg = og / nx;
            if (og + 1u == (tg + 1u) * nx) xb_add(&bar[XB_TOPGEN], 1u);
            else XB_SPIN(xb_ld(&bar[XB_TOPGEN]) == tg, bar);
            __builtin_amdgcn_fence(__ATOMIC_ACQUIRE, "agent");
            xb_add(&bar[XB_XGEN(b.x)], 1u);
            asm volatile("s_waitcnt vmcnt(0)" ::: "memory");
        } else {
            XB_SPIN(xb_ld(&bar[XB_XGEN(b.x)]) == gen, bar);
            __builtin_amdgcn_fence(__ATOMIC_ACQUIRE, "agent");
            asm volatile("s_waitcnt vmcnt(0)" ::: "memory");
        }
    }
    __syncthreads();
}
constexpr int CW_ZDONE = 9216;
namespace pg8 {
struct OneUnit { int pm, pn;
    __device__ __forceinline__ bool next(int i, Unit& u) const { if (i) return false; u.pm = pm; u.pn = pn; return true; }
    __device__ __forceinline__ void a_ready(const Unit&) const {}
    __device__ __forceinline__ void done(const Unit&) const {} };
}
__device__ __forceinline__ void cf_item(const Args& a, int item, LAS unsigned char* lds) {
    const int tid = threadIdx.x, lane = tid & 63, fr = lane & 15, fq = lane >> 4, wid = tid >> 6;
    const bf16* XB = (const bf16*)(a.ws + WS_XB); const bf16* W = (const bf16*)(a.ws + WS_WIN1) + (size_t)3584 * DM; const float* SS = (const float*)(a.ws + WS_SS1); float* logf2 = (float*)(a.ws + WS_LOGF);
    const int row0 = item * 64, k0 = wid * 128 + 8 * fq;
    const bf16* wp = W + (size_t)fr * DM + k0; const bf16* xp = XB + (size_t)(row0 + fr) * DM + k0;
    bf16x8 wf[4], xf[4][4];
#pragma unroll
    for (int ks = 0; ks < 4; ++ks) { wf[ks] = *(const bf16x8*)(wp + 32 * ks);
#pragma unroll
        for (int g = 0; g < 4; ++g) xf[g][ks] = *(const bf16x8*)(xp + (size_t)(16 * g) * DM + 32 * ks); }
    f32x4 acc[4];
#pragma unroll
    for (int g = 0; g < 4; ++g) { acc[g] = (f32x4){0.f, 0.f, 0.f, 0.f};
#pragma unroll
        for (int ks = 0; ks < 4; ++ks) acc[g] = __builtin_amdgcn_mfma_f32_16x16x32_bf16(wf[ks], xf[g][ks], acc[g], 0, 0, 0); }
    LAS float* part = (LAS float*)lds;
#pragma unroll
    for (int g = 0; g < 4; ++g) *(LAS f32x4*)(part + (wid * 64 + 16 * g + fr) * 16 + 4 * fq) = acc[g];
    __syncthreads();
    { const int r = tid >> 3, n0 = (tid & 7) * 2;
      float v0 = 0.f, v1 = 0.f;
#pragma unroll
      for (int w = 0; w < 8; ++w) { v0 += part[(w * 64 + r) * 16 + n0]; v1 += part[(w * 64 + r) * 16 + n0 + 1]; }
      const int row = row0 + r; float ss = 0.f;
#pragma unroll
      for (int q = 0; q < 4; ++q) { const f32x4 sp = *(const f32x4*)(SS + (size_t)row * 16 + 4 * q); ss += (sp[0] + sp[1]) + (sp[2] + sp[3]); }
      const float rstd = rsqrtf(ss * (1.f / DM) + EPS); const int b = row / SEQ, t = row % SEQ;
      if (n0 < 12) { logf2[((size_t)b * 12 + n0) * SEQ + t] = logsig2(v0 * rstd + a.in[12][n0]); logf2[((size_t)b * 12 + n0 + 1) * SEQ + t] = logsig2(v1 * rstd + a.in[12][n0 + 1]); } }
    __syncthreads();
}

#ifndef PROBE_REP
#define PROBE_REP -1
#endif
#ifndef MK_ONE_LAUNCH
#define MK_ONE_LAUNCH 1
#endif
constexpr int NPHASE = 9;
constexpr int LDS_BYTES = 147456;
constexpr int LDSCTL_OFF = 135168;
constexpr int CW_BAR = 4096;
constexpr int CW_Q0 = 64, CW_Q1 = 128, CW_Q0B = 192;
constexpr int CW_MCNT = 8192;
constexpr size_t WS_SLAB = 200 * MiB;
constexpr size_t WS_END2 = 250 * MiB;
constexpr size_t DO_MLIST = 0, DO_SLABL = 8 * MiB;
__global__ void __launch_bounds__(512, 2) mk_fwd(Args a) {
    extern __shared__ __attribute__((aligned(16))) unsigned char lds_raw[];
    LAS unsigned char* lds = (LAS unsigned char*)lds_raw;
    const int G = gridDim.x, bx = blockIdx.x; const int vcu = (G % 8 == 0) ? (bx % 8) * (G / 8) + bx / 8 : bx;
    unsigned char* ws = a.ws; unsigned* ctl = (unsigned*)(ws + WS_CTL);
    bf16* XB = (bf16*)(ws + WS_XB); bf16* P = (bf16*)(ws + WS_P); bf16* Y = (bf16*)(ws + WS_Y);
    float* kmean = (float*)(ws + WS_KMEAN); float* logf2 = (float*)(ws + WS_LOGF); float* SS0 = (float*)(ws + WS_SS0); float* SS1 = (float*)(ws + WS_SS1);
    const att::MobaBufs mb{ctl + CW_MCNT, (unsigned short*)((unsigned char*)a.out + DO_MLIST), (bf16*)(ws + WS_SLAB), (float*)((unsigned char*)a.out + DO_SLABL)};
    volatile LAS unsigned* MISC = (volatile LAS unsigned*)(lds + LDSCTL_OFF);
    if (threadIdx.x < 64) MISC[threadIdx.x] = 0u;
    __syncthreads();
    XcdBarrier bar; bar.bar = ctl + CW_BAR; bar.x = 0; bar.st = nullptr;
    if (MK_ONE_LAUNCH) bar = xcd_barrier_post(ctl + CW_BAR, MISC + 8);
#define IN(k) (a.ph_lo <= (k) && (k) < a.ph_hi)
#define SEAM(k) do { if (MK_ONE_LAUNCH && IN(k) && IN((k) + 1)) xcd_barrier(bar); } while (0)
#define PH_PRO() do { if (IN(0)) phase_prologue(a, lds, vcu, G); SEAM(0); } while (0)
#define PH_IN0() do { if (IN(1)) { pg8::Gemm g{XB, (const bf16*)(ws + WS_WIN0), T, N0, DM}; pg8::StaticOrder S; S.init(T, N0, G, bx); \
        pg8::EpiProj E{0, P, SS0, a.in[4], nullptr, kmean, logf2}; pg8::gemm_phase<pg8::EpiProj, pg8::StaticOrder, true, true>(lds, g, S, E); } SEAM(1); } while (0)
#define PH_A0A(q) do { if (IN(2)) att::attn_phase(0, a, lds, ctl + (q), mb); } while (0)
#define PH_A0B(q) do { if (MOBA_GATHER) { if (IN(3)) att::moba_kv_phase(a, mb, lds, ctl + (q)); SEAM(3); } } while (0)
#define PH_A0C() do { if (MOBA_GATHER) { if (IN(4)) att::moba_combine(a, mb, vcu, G); SEAM(4); } } while (0)
#define PH_OUT0() do { if (IN(5)) { pg8::Gemm g{Y, (const bf16*)(ws + WS_WOUT0), T, DM, DM}; pg8::StaticOrder S; S.init(T, DM, G, bx); \
        pg8::EpiOut0 E{a.in[0], XB, SS1}; pg8::gemm_phase<pg8::EpiOut0, pg8::StaticOrder, true, true>(lds, g, S, E); } SEAM(5); } while (0)
#define PH_IN1() do { if (IN(6)) { pg8::Gemm g{XB, (const bf16*)(ws + WS_WIN1), T, 3072, DM}; pg8::StaticOrder S; S.init(T, 3072, G, bx); \
        pg8::EpiProj E{1, P, SS1, a.in[11], a.in[12], kmean, logf2}; pg8::gemm_phase<pg8::EpiProj, pg8::StaticOrder, true, true>(lds, g, S, E); \
        for (int it = vcu; it < T / 64; it += G) cf_item(a, it, lds); } SEAM(6); } while (0)
#define PH_A1(q) do { if (IN(7)) { for (int zi = vcu; zi < 128; zi += G) {         \
            pg8::Gemm g{XB, (const bf16*)(ws + WS_WIN1), T, N1, DM}; pg8::OneUnit S{zi >> 1, 12 + (zi & 1)}; \
            pg8::EpiProj E{1, P, SS1, a.in[11], a.in[12], kmean, logf2}; pg8::gemm_phase<pg8::EpiProj, pg8::OneUnit, true, true>(lds, g, S, E); \
            asm volatile("s_waitcnt vmcnt(0)" ::: "memory"); __syncthreads(); \
            if (threadIdx.x == 0) { __builtin_amdgcn_fence(__ATOMIC_RELEASE, "agent"); asm volatile("s_waitcnt vmcnt(0)" ::: "memory"); __hip_atomic_fetch_add(ctl + CW_ZDONE, 1u, __ATOMIC_RELAXED, __HIP_MEMORY_SCOPE_AGENT); } } \
        att::attn_phase(1, a, lds, ctl + (q), mb); } SEAM(7); } while (0)
#define PH_OUT1() do { if (IN(8)) { pg8::Gemm g{Y, (const bf16*)(ws + WS_WOUT1), T, DM, DM}; pg8::StaticOrder S; S.init(T, DM, G, bx); \
        pg8::EpiOut1 E{XB, a.out}; pg8::gemm_phase<pg8::EpiOut1, pg8::StaticOrder, true, true>(lds, g, S, E); } } while (0)
    PH_PRO();
#if PROBE_REP == 0
    PH_PRO();
#endif
    PH_IN0();
#if PROBE_REP == 1
    PH_IN0();
#endif
    PH_A0A(CW_Q0);
    PH_A0B(CW_Q0B);
#if PROBE_REP == 3
    PH_A0B(CW_Q0B + 256);
#endif
    PH_A0C();
#if PROBE_REP == 4
    PH_A0C();
#endif
#if PROBE_REP == 5
    PH_OUT0();
#endif
    PH_OUT0();
    PH_IN1();
#if PROBE_REP == 6
    PH_IN1();
#endif
    PH_A1(CW_Q1);
#if PROBE_REP == 7
    PH_A1(CW_Q1 + 256);
#endif
    PH_OUT1();
#undef IN
#undef SEAM
}

extern "C" void kernel_launch(void* const* d_in, const int* in_sizes, int n_in, void* d_out, int out_size, void* d_ws, size_t ws_size, hipStream_t stream) {
    static int grid = 0;
    if (grid == 0) {
        if (n_in != 16 || out_size != T * DM || ws_size < WS_END2) { fprintf(stderr, "kernel_launch: unexpected shapes (n_in %d out %d ws %zu)\n", n_in, out_size, ws_size); grid = -1; return; }
        int dev = 0, cus = 0, per_cu = 0;
        (void)hipGetDevice(&dev); (void)hipDeviceGetAttribute(&cus, hipDeviceAttributeMultiprocessorCount, dev);
        (void)hipFuncSetAttribute((const void*)mk_fwd, hipFuncAttributeMaxDynamicSharedMemorySize, LDS_BYTES);
        (void)hipOccupancyMaxActiveBlocksPerMultiprocessor(&per_cu, (const void*)mk_fwd, 512, LDS_BYTES);
        (void)hipGetLastError();
        grid = cus * (per_cu >= 1 ? 1 : 0); if (grid <= 0) { fprintf(stderr, "kernel_launch: occupancy query says 0 workgroups per CU\n"); grid = -1; return; }
    }
    if (grid < 0) return;
    unsigned char* ws = (unsigned char*)d_ws;
    (void)hipMemsetAsync(ws + WS_CTL, 0, CTL_ZERO_BYTES, stream);
    Args a{}; for (int i = 0; i < 16; ++i) a.in[i] = (const float*)d_in[i];
    a.out = (float*)d_out; a.ws = ws;
#define RUN(lo, hi) do { a.ph_lo = (lo); a.ph_hi = (hi); hipLaunchKernelGGL(mk_fwd, dim3(grid), dim3(512), LDS_BYTES, stream, a); } while (0)
    if (MK_ONE_LAUNCH) RUN(0, NPHASE);
    else { for (int k = 0; k < NPHASE; ++k) RUN(k, k + 1); }
#undef RUN
}
```

```cpp
#include <hip/hip_runtime.h>
#include <cstdint>
#include <cstdio>

#define GAS __attribute__((address_space(1)))
#define LAS __attribute__((address_space(3)))
typedef unsigned short bf16;
typedef unsigned v4u __attribute__((ext_vector_type(4)));
typedef unsigned u32x4 __attribute__((ext_vector_type(4)));
typedef unsigned v2u __attribute__((ext_vector_type(2)));
typedef float f32x4 __attribute__((ext_vector_type(4)));
typedef float f32x16 __attribute__((ext_vector_type(16)));
typedef short bf16x8 __attribute__((ext_vector_type(8)));

constexpr int BATCH = 2, SEQ = 8192, T = BATCH * SEQ, DM = 1024, HD = 64, MEML = 256;
constexpr int N0 = 3072;
constexpr int N1REF = 3596;
constexpr int N1 = 3840;
constexpr int LDP = 3584;
constexpr float EPS = 1e-6f;
constexpr float LOG2E = 1.4426950408889634f;
constexpr float C2 = 0.125f * LOG2E;
constexpr int L0_AQ = 0, L0_AK = 384, L0_AV = 512, L0_BQ = 640, L0_BK = 1024, L0_BV = 1408, L0_MQ = 1792, L0_Z = 2048;
constexpr int L1_CQ = 0, L1_CK = 768, L1_CV = 1536, L1_MQ = 2304, L1_Z = 2560, L1_CF = 3584;

constexpr size_t MiB = 1u << 20;
constexpr size_t WS_CTL = 0, CTL_ZERO_BYTES = 1 * MiB;
constexpr size_t WS_KMEAN = 512 * 1024;
constexpr size_t WS_WIN0 = 2 * MiB, WS_WOUT0 = 8 * MiB, WS_WIN1 = 10 * MiB, WS_WOUT1 = 18 * MiB;
constexpr size_t WS_SS0 = 20 * MiB, WS_SS1 = 21 * MiB;
constexpr size_t WS_LOGF = 22 * MiB;
constexpr size_t WS_MKV = 23 * MiB;
constexpr size_t MKV_ONE = (size_t)BATCH * MEML * 256 * 2;
constexpr size_t WS_XB = 24 * MiB;
constexpr size_t WS_P = 56 * MiB;
constexpr size_t WS_Y = 168 * MiB;
constexpr size_t WS_END = 200 * MiB;

__device__ __forceinline__ float bf2f(bf16 v) { return __uint_as_float((unsigned)v << 16); }
__device__ __forceinline__ unsigned f2bf(float f) { unsigned u = __float_as_uint(f); return (u + 0x7fffu + ((u >> 16) & 1u)) >> 16; }
__device__ __forceinline__ unsigned pk2(float lo, float hi) { return f2bf(lo) | (f2bf(hi) << 16); }
__device__ __forceinline__ float wave_sum(float v) {
#pragma unroll
    for (int o = 1; o < 64; o <<= 1) v += __shfl_xor(v, o);
    return v;
}
__device__ __forceinline__ float fexp2(float x) { return __builtin_amdgcn_exp2f(x); }
__device__ __forceinline__ float silu_f(float z) { return z * __builtin_amdgcn_rcpf(1.f + __builtin_amdgcn_exp2f(-LOG2E * z)); }
__device__ __forceinline__ float logsig2(float f) { return LOG2E * (fminf(f, 0.f) - log1pf(__expf(-fabsf(f)))); }
__device__ __forceinline__ float alibi_slope2(int h) { return LOG2E * exp2f(-8.0f * (float)(h + 1) / 12.0f); }

struct Args {
    const float* in[16]; float* out; unsigned char* ws; int ph_lo, ph_hi;
};
enum { HK_QNORM = 0, HK_KNORM = 1, HK_PLAIN = 2, HK_SILU = 3, HK_BK = 4, HK_CF = 5, HK_NONE = 6 };
struct HeadInfo { int kind; int gidx; int dstcol; };
__device__ __forceinline__ HeadInfo head_info(int layer, int hh) {
    HeadInfo h; h.dstcol = hh * 64; h.gidx = 0;
    if (layer == 0) {
        if (hh < 6) { h.kind = HK_QNORM; h.gidx = 0; } else if (hh < 8) { h.kind = HK_KNORM; h.gidx = 1; } else if (hh < 10) h.kind = HK_PLAIN;
        else if (hh < 16) { h.kind = HK_QNORM; h.gidx = 2; } else if (hh < 22) { h.kind = HK_BK; h.gidx = 3; } else if (hh < 28) h.kind = HK_PLAIN;
        else if (hh < 32) { h.kind = HK_QNORM; h.gidx = 4; } else h.kind = HK_SILU;
    } else {
        if (hh < 12) { h.kind = HK_QNORM; h.gidx = 0; } else if (hh < 24) { h.kind = HK_KNORM; h.gidx = 1; } else if (hh < 36) h.kind = HK_PLAIN;
        else if (hh < 40) { h.kind = HK_QNORM; h.gidx = 2; } else if (hh < 56) h.kind = HK_SILU; else if (hh == 56) h.kind = HK_CF; else h.kind = HK_NONE;
    }
    return h;
}

constexpr int PRO_NW = 8;

__device__ __forceinline__ int l1_refcol(int n) {
    if (n < 2304) return n;
    if (n < 3584) return n + 12;
    if (n < 3596) return n - 3584 + 2304;
    return -1;
}
__device__ __forceinline__ void pro_transpose_item(const float* W, const float* g, int K, int Nref, int nblk, bf16* WT, bool remap, LAS float* scr, int item, int lane) {
    const int kb = item / nblk, nb = item % nblk, k0 = 64 * kb, n0 = 32 * nb;
    const int np = n0 + (lane & 31); const int rc = remap ? l1_refcol(np) : np;
    float wv[32];
#pragma unroll
    for (int i = 0; i < 32; ++i) { const int kk = 2 * i + (lane >> 5); wv[i] = (rc >= 0) ? W[(size_t)(k0 + kk) * Nref + rc] : 0.f; }
    const float gl = g ? g[k0 + (lane & 63)] : 1.f;
#pragma unroll
    for (int i = 0; i < 32; ++i) { const int kk = 2 * i + (lane >> 5); const float gk = __shfl(gl, kk); scr[kk * 33 + (lane & 31)] = wv[i] * gk; }
    asm volatile("s_waitcnt lgkmcnt(0)" ::: "memory");
    const int c = lane & 7;
#pragma unroll
    for (int j = 0; j < 4; ++j) { const int n = (lane >> 3) + 8 * j; const LAS float* s = scr + (8 * c) * 33 + n;
        v4u o; o.x = pk2(s[0 * 33], s[1 * 33]); o.y = pk2(s[2 * 33], s[3 * 33]); o.z = pk2(s[4 * 33], s[5 * 33]); o.w = pk2(s[6 * 33], s[7 * 33]);
        *(v4u*)(WT + (size_t)(n0 + n) * K + k0 + 8 * c) = o; }
    asm volatile("s_waitcnt lgkmcnt(0)" ::: "memory");
}
__device__ __forceinline__ void pro_row(const float* xrow, bf16* orow, float* ssrow, int lane) {
    const f32x4* xr = (const f32x4*)xrow + lane; f32x4 v[4]; float s = 0.f;
#pragma unroll
    for (int j = 0; j < 4; ++j) { v[j] = xr[64 * j]; s += (v[j].x * v[j].x + v[j].y * v[j].y) + (v[j].z * v[j].z + v[j].w * v[j].w); }
    s = wave_sum(s);
    v2u* o8 = (v2u*)orow + lane;
#pragma unroll
    for (int j = 0; j < 4; ++j) { v2u w; w.x = pk2(v[j].x, v[j].y); w.y = pk2(v[j].z, v[j].w); o8[64 * j] = w; }
    if (lane < 16) ssrow[lane] = lane == 0 ? s : 0.f;
}
__device__ __forceinline__ void pro_memkv_task(const float* mem, const float* gm, const float* W, const float* kg, bf16* MK, bf16* MV, int rt, int ct, LAS unsigned char* lds) {
    const int tid = threadIdx.x, lane = tid & 63, w = tid >> 6, r32 = lane & 31, hi = lane >> 5;
    LAS float* part = (LAS float*)lds; LAS float* rs = (LAS float*)(lds + 133120);
    for (int i = 0; i < 8; ++i) { const int row = rt * 64 + 8 * w + i; const f32x4* xr = (const f32x4*)(mem + (size_t)row * DM) + lane; float s = 0.f;
#pragma unroll
        for (int j = 0; j < 4; ++j) { const f32x4 v = xr[64 * j]; s += (v.x * v.x + v.y * v.y) + (v.z * v.z + v.w * v.w); }
        s = wave_sum(s); if (lane == 0) rs[8 * w + i] = rsqrtf(s * (1.f / DM) + EPS); }
    f32x16 acc[2][2];
#pragma unroll
    for (int a = 0; a < 2; ++a)
#pragma unroll
        for (int b = 0; b < 2; ++b) acc[a][b] = f32x16{};
    for (int ks = 0; ks < 8; ++ks) { const int k0 = 128 * w + 16 * ks + 8 * hi;
        bf16x8 wf[2], hf[2];
#pragma unroll
        for (int cb = 0; cb < 2; ++cb) { const float* wp = W + (size_t)k0 * 512 + ct * 64 + 32 * cb + r32;
#pragma unroll
            for (int j = 0; j < 8; ++j) wf[cb][j] = (short)f2bf(wp[(size_t)j * 512]); }
        const f32x4 g0 = *(const f32x4*)(gm + k0), g1 = *(const f32x4*)(gm + k0 + 4);
#pragma unroll
        for (int ra = 0; ra < 2; ++ra) { const float* mp = mem + (size_t)(rt * 64 + 32 * ra + r32) * DM + k0; const f32x4 a0 = *(const f32x4*)mp, a1 = *(const f32x4*)(mp + 4);
            hf[ra][0] = (short)f2bf(a0.x * g0.x); hf[ra][1] = (short)f2bf(a0.y * g0.y); hf[ra][2] = (short)f2bf(a0.z * g0.z); hf[ra][3] = (short)f2bf(a0.w * g0.w);
            hf[ra][4] = (short)f2bf(a1.x * g1.x); hf[ra][5] = (short)f2bf(a1.y * g1.y); hf[ra][6] = (short)f2bf(a1.z * g1.z); hf[ra][7] = (short)f2bf(a1.w * g1.w); }
#pragma unroll
        for (int cb = 0; cb < 2; ++cb)
#pragma unroll
            for (int ra = 0; ra < 2; ++ra) acc[cb][ra] = __builtin_amdgcn_mfma_f32_32x32x16_bf16(wf[cb], hf[ra], acc[cb][ra], 0, 0, 0);
    }
#pragma unroll
    for (int cb = 0; cb < 2; ++cb)
#pragma unroll
        for (int ra = 0; ra < 2; ++ra)
#pragma unroll
            for (int r = 0; r < 16; ++r) { const int n = 32 * cb + (r & 3) + 8 * (r >> 2) + 4 * hi; part[(w * 64 + 32 * ra + r32) * 65 + n] = acc[cb][ra][r]; }
    __syncthreads();
    { const int tok = tid >> 3, c0 = (tid & 7) * 8; float v[8];
#pragma unroll
      for (int i = 0; i < 8; ++i) v[i] = 0.f;
      for (int ww = 0; ww < 8; ++ww) {
#pragma unroll
          for (int i = 0; i < 8; ++i) v[i] += part[(ww * 64 + tok) * 65 + c0 + i]; }
      const float r = rs[tok]; float ss = 0.f;
#pragma unroll
      for (int i = 0; i < 8; ++i) { v[i] *= r; ss += v[i] * v[i]; }
      ss += __shfl_xor(ss, 1); ss += __shfl_xor(ss, 2); ss += __shfl_xor(ss, 4);
      const int row = rt * 64 + tok;
      bf16* dst;
      if (ct < 4) { const float inv = rsqrtf(ss * (1.f / 64.f) + EPS);
#pragma unroll
          for (int i = 0; i < 8; ++i) v[i] *= inv * kg[c0 + i];
          dst = MK + (size_t)row * 256 + ct * 64 + c0; }
      else dst = MV + (size_t)row * 256 + (ct - 4) * 64 + c0;
      v4u o; o.x = pk2(v[0], v[1]); o.y = pk2(v[2], v[3]); o.z = pk2(v[4], v[5]); o.w = pk2(v[6], v[7]); *(v4u*)dst = o; }
    __syncthreads();
}

__device__ __forceinline__ void phase_prologue(const Args& a, LAS unsigned char* lds, int vcu, int G) {
    const int tid = threadIdx.x, lane = tid & 63, wave = __builtin_amdgcn_readfirstlane(tid >> 6);
    unsigned char* ws = a.ws;
    for (int wt = (G - 1 - vcu); wt < 128; wt += G) { const int layer = wt >> 6, rt = (wt >> 3) & 7, ct = wt & 7;
        const float* gm = layer ? a.in[13] : a.in[6]; const float* W = layer ? a.in[14] : a.in[7];
        const float* kg = layer ? a.in[11] + 3 * 64 : a.in[4] + 5 * 64;
        bf16* MK = (bf16*)(ws + WS_MKV + (size_t)(2 * layer) * MKV_ONE); bf16* MV = (bf16*)(ws + WS_MKV + (size_t)(2 * layer + 1) * MKV_ONE);
        pro_memkv_task(a.in[1], gm, W, kg, MK, MV, rt, ct, lds); }
    LAS float* scr = (LAS float*)(lds + wave * 16384);
    const int gw = vcu * PRO_NW + wave, NGW = G * PRO_NW;
    constexpr int I_IN0 = 16 * (N0 / 32), I_OUT = 16 * (DM / 32), I_IN1 = 16 * (N1 / 32);
    constexpr int NITEMS = I_IN0 + I_OUT + I_IN1 + I_OUT;
    for (int it = gw; it < NITEMS; it += NGW) { int r = it;
        if (r < I_IN0) { pro_transpose_item(a.in[3], a.in[2], DM, N0, N0 / 32, (bf16*)(ws + WS_WIN0), false, scr, r, lane); continue; } r -= I_IN0;
        if (r < I_OUT) { pro_transpose_item(a.in[8], nullptr, DM, DM, DM / 32, (bf16*)(ws + WS_WOUT0), false, scr, r, lane); continue; } r -= I_OUT;
        if (r < I_IN1) { pro_transpose_item(a.in[10], a.in[9], DM, N1REF, N1 / 32, (bf16*)(ws + WS_WIN1), true, scr, r, lane); continue; } r -= I_IN1;
        pro_transpose_item(a.in[15], nullptr, DM, DM, DM / 32, (bf16*)(ws + WS_WOUT1), false, scr, r, lane); }
    const float* x = a.in[0]; bf16* XB = (bf16*)(ws + WS_XB); float* SS0 = (float*)(ws + WS_SS0);
    for (int m0 = gw * 8; m0 < T; m0 += NGW * 8) {
        f32x4 v[8][4];
#pragma unroll
        for (int r = 0; r < 8; ++r) { const f32x4* xr = (const f32x4*)(x + (size_t)(m0 + r) * DM) + lane;
#pragma unroll
            for (int j = 0; j < 4; ++j) v[r][j] = xr[64 * j]; }
#pragma unroll
        for (int r = 0; r < 8; ++r) { float sq = 0.f;
#pragma unroll
            for (int j = 0; j < 4; ++j) sq += (v[r][j].x * v[r][j].x + v[r][j].y * v[r][j].y) + (v[r][j].z * v[r][j].z + v[r][j].w * v[r][j].w);
            sq = wave_sum(sq); v2u* o8 = (v2u*)(XB + (size_t)(m0 + r) * DM) + lane;
#pragma unroll
            for (int j = 0; j < 4; ++j) { v2u w; w.x = pk2(v[r][j].x, v[r][j].y); w.y = pk2(v[r][j].z, v[r][j].w); o8[64 * j] = w; }
            if (lane < 16) SS0[(size_t)(m0 + r) * 16 + lane] = lane == 0 ? sq : 0.f; } }
}
namespace pg8 {
#define PG8_LAS __attribute__((address_space(3)))
typedef unsigned short bf16_t;
typedef short bf16x8 __attribute__((ext_vector_type(8)));
typedef float f32x4 __attribute__((ext_vector_type(4)));
typedef unsigned u32x4 __attribute__((ext_vector_type(4)));
constexpr int BM = 256, BK = 64, HALF = 128, HTB = HALF * BK * 2  , STAGE_BYTES = 8 * HTB, NXCD = 8, WGM = 8;

__host__ __device__ __forceinline__ int lds_byte(int r, int c) { const int st = (r >> 4) * 2 + (c >> 5), rr = r & 15, cc = c & 31, ob = rr * 64 + cc * 2; return st * 1024 + (ob ^ (((ob >> 9) & 1) << 5)); }
__host__ __device__ __forceinline__ void stage_rc(int b, int& R, int& C) { const int st = b / 1024, sb = b % 1024, swz = sb ^ (((sb >> 9) & 1) << 5); R = (st >> 1) * 16 + swz / 64; C = (st & 1) * 32 + (swz % 64) / 2; }
__host__ __device__ __forceinline__ int perm32(int rho) { const int n = rho >> 4, i = rho & 15; return 8 * (i >> 2) + 4 * n + (i & 3); }

struct Unit { int pm, pn; };
struct Gemm { const bf16_t* A; const bf16_t* Bt; int M, N, K; };

struct StaticOrder {
    int nM, nN, nwg, G, c;
    __host__ __device__ void init(int M, int N, int G_, int c_) { nM = M / BM; nN = N / BM; nwg = nM * nN; G = G_; c = c_; }
    __host__ __device__ bool next(int i, Unit& u) const {
        const long L = (long)i * G + c; if (L >= nwg) return false;
        int wgid = (int)L; { const int q = nwg / NXCD, r = nwg % NXCD, xcd = wgid % NXCD, off = wgid / NXCD; wgid = (xcd < r ? xcd * (q + 1) : r * (q + 1) + (xcd - r) * q) + off; }
        const int nig = WGM * nN, gid = wgid / nig, fm = gid * WGM, gsz = (nM - fm) < WGM ? (nM - fm) : WGM;
        u.pm = fm + ((wgid % nig) % gsz); u.pn = (wgid % nig) / gsz; return true;
    }
    __device__ __forceinline__ void a_ready(const Unit&) const {}
    __device__ __forceinline__ void done(const Unit&) const {}
};
template <class Epi, class Sched, bool ALIGN_EPI = false, bool SP2 = false>
__device__ __forceinline__ void gemm_phase(PG8_LAS unsigned char* lds, const Gemm g, const Sched& S, const Epi& E) {
    const int tid = threadIdx.x, wid = __builtin_amdgcn_readfirstlane(tid >> 6), lane = tid & 63, wr = wid >> 2, wc = wid & 3, fr = lane & 15, fq = lane >> 4;
    const int K = g.K, nt = K / BK;
    unsigned voffA[2], voffB[2];
#pragma unroll
    for (int i = 0; i < 2; ++i) { int R, C; stage_rc(tid * 16 + i * 8192, R, C); const int Rb = 64 * (R >> 5) + perm32(R & 31);
        voffA[i] = (unsigned)(R * K + C) * 2u; voffB[i] = (unsigned)(Rb * K + C) * 2u; }
    const size_t kstep = (size_t)(BK * 2);
    const size_t hstep = (size_t)HALF * K * 2;
    const size_t hstepB = (size_t)32 * K * 2;
    const size_t tstep = 2 * hstep;
    const unsigned ldsw = (unsigned)wid * 1024u;
    const int aoff = lds_byte(wr * 64 + fr, fq * 8), boff = lds_byte(wc * 32 + fr, fq * 8);
#define PG8_SA(b, h) (((b) * 2 + (h)) * HTB)
#define PG8_SB(b, h) ((4 + (b) * 2 + (h)) * HTB)
#define PG8_STAGE(bufoff, gbase, voff) do { _Pragma("unroll") for (int _i = 0; _i < 2; ++_i) \
        __builtin_amdgcn_global_load_lds((const unsigned*)((const char*)(gbase) + (voff)[_i]), (PG8_LAS unsigned*)(lds + (bufoff) + ldsw + _i * 8192), 16, 0, 0); } while (0)
#define PG8_LDA(dst, b, h) do { _Pragma("unroll") for (int m = 0; m < 4; ++m) _Pragma("unroll") for (int k = 0; k < 2; ++k) dst[m][k] = *(const PG8_LAS bf16x8*)(lds + PG8_SA(b, h) + aoff + m * 2048 + k * 1024); } while (0)
#define PG8_LDB(dst, b, h) do { _Pragma("unroll") for (int n = 0; n < 2; ++n) _Pragma("unroll") for (int k = 0; k < 2; ++k) dst[n][k] = *(const PG8_LAS bf16x8*)(lds + PG8_SB(b, h) + boff + n * 2048 + k * 1024); } while (0)
#define PG8_MMA(ai, bj, At, Bt) do { __builtin_amdgcn_s_setprio(1); _Pragma("unroll") for (int m = 0; m < 4; ++m) _Pragma("unroll") for (int n = 0; n < 2; ++n) _Pragma("unroll") for (int k = 0; k < 2; ++k) \
        acc[ai][bj][m][n] = __builtin_amdgcn_mfma_f32_16x16x32_bf16(Bt[n][k], At[m][k], acc[ai][bj][m][n], 0, 0, 0); __builtin_amdgcn_s_setprio(0); } while (0)
#define PG8_WAIT_V(n) asm volatile("s_waitcnt vmcnt(" #n ")" ::: "memory")
#define PG8_WAIT_L(n) asm volatile("s_waitcnt lgkmcnt(" #n ")" ::: "memory")
#define PG8_BAR __builtin_amdgcn_s_barrier()
#define PG8_SCHED __builtin_amdgcn_sched_barrier(0)
    Unit cur, nxt; int ui = 0;
    if (!S.next(0, cur)) return;
    f32x4 acc[2][2][4][2];
#pragma unroll
    for (int a = 0; a < 2; ++a)
#pragma unroll
        for (int b = 0; b < 2; ++b)
#pragma unroll
            for (int m = 0; m < 4; ++m)
#pragma unroll
                for (int n = 0; n < 2; ++n) acc[a][b][m][n] = (f32x4){0.f, 0.f, 0.f, 0.f};
    bf16x8 At[4][2], B0[2][2], B1[2][2];
    const char* cA = (const char*)g.A + (size_t)cur.pm * tstep; const char* cB = (const char*)g.Bt + (size_t)cur.pn * tstep;
    S.a_ready(cur);
    if constexpr (SP2) {
        PG8_STAGE(PG8_SB(0, 0), cB, voffB); PG8_STAGE(PG8_SB(0, 1), cB + hstepB, voffB); PG8_STAGE(PG8_SA(0, 0), cA, voffA); PG8_STAGE(PG8_SA(0, 1), cA + hstep, voffA);
        if (wr == 1) PG8_BAR;
        PG8_WAIT_V(2); PG8_BAR;
        PG8_STAGE(PG8_SB(1, 0), cB + kstep, voffB); PG8_STAGE(PG8_SA(1, 0), cA + kstep, voffA); PG8_STAGE(PG8_SB(1, 1), cB + hstepB + kstep, voffB);
        PG8_WAIT_V(6); PG8_BAR;
    } else {
        PG8_STAGE(PG8_SB(0, 0), cB, voffB); PG8_STAGE(PG8_SA(0, 0), cA, voffA); PG8_STAGE(PG8_SB(0, 1), cB + hstepB, voffB); PG8_STAGE(PG8_SA(0, 1), cA + hstep, voffA);
        if (wr == 1) PG8_BAR;
        PG8_WAIT_V(4); PG8_BAR;
        PG8_STAGE(PG8_SB(1, 0), cB + kstep, voffB); PG8_STAGE(PG8_SA(1, 0), cA + kstep, voffA); PG8_STAGE(PG8_SB(1, 1), cB + hstepB + kstep, voffB);
        PG8_WAIT_V(6); PG8_BAR;
    }
    for (;;) {
        const bool has_next = S.next(ui + 1, nxt);
        const char* nA = has_next ? (const char*)g.A + (size_t)nxt.pm * tstep : cA; const char* nB = has_next ? (const char*)g.Bt + (size_t)nxt.pn * tstep : cB;
        for (int t = 0; t < nt; t += 2) {
            const bool last = (t == nt - 2);
            const char* a1 = cA + (size_t)(t + 1) * kstep;
            const char* a2 = last ? nA : cA + (size_t)(t + 2) * kstep; const char* b2 = last ? nB : cB + (size_t)(t + 2) * kstep;
            const char* a3 = a2 + kstep; const char* b3 = b2 + kstep;
            if (last && has_next) S.a_ready(nxt);
            if constexpr (SP2) {
            PG8_LDB(B0, 0, 0); PG8_LDB(B1, 0, 1); PG8_SCHED; PG8_LDA(At, 0, 0); PG8_STAGE(PG8_SA(1, 1), a1 + hstep, voffA);
            PG8_WAIT_V(8); PG8_WAIT_L(0); PG8_BAR; PG8_MMA(0, 0, At, B0); PG8_MMA(0, 1, At, B1); PG8_BAR; PG8_SCHED;
            PG8_LDA(At, 0, 1); PG8_STAGE(PG8_SB(0, 0), b2, voffB); PG8_STAGE(PG8_SB(0, 1), b2 + hstepB, voffB); PG8_STAGE(PG8_SA(0, 0), a2, voffA);
            PG8_WAIT_V(8); PG8_WAIT_L(0); PG8_BAR; PG8_MMA(1, 0, At, B0); PG8_MMA(1, 1, At, B1); PG8_BAR; PG8_SCHED;
            PG8_LDB(B0, 1, 0); PG8_LDB(B1, 1, 1); PG8_SCHED; PG8_LDA(At, 1, 0); PG8_STAGE(PG8_SA(0, 1), a2 + hstep, voffA);
            PG8_WAIT_V(8); PG8_WAIT_L(0); PG8_BAR; PG8_MMA(0, 0, At, B0); PG8_MMA(0, 1, At, B1); PG8_BAR; PG8_SCHED;
            PG8_LDA(At, 1, 1); PG8_STAGE(PG8_SB(1, 0), b3, voffB); PG8_STAGE(PG8_SB(1, 1), b3 + hstepB, voffB); PG8_STAGE(PG8_SA(1, 0), a3, voffA);
            PG8_WAIT_V(8); PG8_WAIT_L(0); PG8_BAR; PG8_MMA(1, 0, At, B0); PG8_MMA(1, 1, At, B1); PG8_BAR; PG8_SCHED;
            } else {
            PG8_LDB(B0, 0, 0); PG8_SCHED; PG8_LDA(At, 0, 0); PG8_STAGE(PG8_SA(1, 1), a1 + hstep, voffA);
            PG8_WAIT_L(8); PG8_BAR; PG8_WAIT_L(0); PG8_MMA(0, 0, At, B0); PG8_BAR; PG8_SCHED;
            PG8_LDB(B1, 0, 1); PG8_STAGE(PG8_SB(0, 0), b2, voffB);
            PG8_BAR; PG8_WAIT_L(0); PG8_MMA(0, 1, At, B1); PG8_BAR;
            PG8_LDA(At, 0, 1); PG8_STAGE(PG8_SA(0, 0), a2, voffA);
            PG8_BAR; PG8_WAIT_L(0); PG8_MMA(1, 0, At, B0); PG8_BAR; PG8_SCHED;
            PG8_STAGE(PG8_SB(0, 1), b2 + hstepB, voffB);
            PG8_WAIT_V(6); PG8_BAR; PG8_MMA(1, 1, At, B1); PG8_BAR;
            PG8_LDB(B0, 1, 0); PG8_SCHED; PG8_LDA(At, 1, 0); PG8_STAGE(PG8_SA(0, 1), a2 + hstep, voffA);
            PG8_WAIT_L(8); PG8_BAR; PG8_WAIT_L(0); PG8_MMA(0, 0, At, B0); PG8_BAR; PG8_SCHED;
            PG8_LDB(B1, 1, 1); PG8_STAGE(PG8_SB(1, 0), b3, voffB);
            PG8_BAR; PG8_WAIT_L(0); PG8_MMA(0, 1, At, B1); PG8_BAR;
            PG8_LDA(At, 1, 1); PG8_STAGE(PG8_SA(1, 0), a3, voffA);
            PG8_BAR; PG8_WAIT_L(0); PG8_MMA(1, 0, At, B0); PG8_BAR; PG8_SCHED;
            PG8_STAGE(PG8_SB(1, 1), b3 + hstepB, voffB);
            PG8_WAIT_V(6); PG8_BAR; PG8_MMA(1, 1, At, B1); PG8_BAR;
            }
        }
        if constexpr (ALIGN_EPI) { if (wr == 0) PG8_BAR; }
        if constexpr (!Epi::AFTER_DRAIN) { E(acc, cur, wr, wc, fr, fq); S.done(cur); }
        if (!has_next) break;
#pragma unroll
        for (int a = 0; a < 2; ++a)
#pragma unroll
            for (int b = 0; b < 2; ++b)
#pragma unroll
                for (int m = 0; m < 4; ++m)
#pragma unroll
                    for (int n = 0; n < 2; ++n) acc[a][b][m][n] = (f32x4){0.f, 0.f, 0.f, 0.f};
        cur = nxt; cA = nA; cB = nB; ++ui;
        if constexpr (ALIGN_EPI) { if (wr == 1) PG8_BAR; }
    }
    PG8_WAIT_V(0);
    if constexpr (!ALIGN_EPI) { if (wr == 0) PG8_BAR; }
    PG8_BAR;
    if constexpr (Epi::AFTER_DRAIN) { E.fused(acc, cur, wr, wc, fr, fq, lds, wid, lane); S.done(cur); }
#undef PG8_SA
#undef PG8_SB
#undef PG8_STAGE
#undef PG8_LDA
#undef PG8_LDB
#undef PG8_MMA
#undef PG8_WAIT_V
#undef PG8_WAIT_L
#undef PG8_BAR
#undef PG8_SCHED
}
}
namespace pg8 {
__device__ __forceinline__ unsigned cvt_pk_bf16(float lo, float hi) { unsigned r; asm volatile("v_cvt_pk_bf16_f32 %0, %1, %2" : "=v"(r) : "v"(lo), "v"(hi)); return r; }

struct EpiProj {
    static constexpr bool AFTER_DRAIN = false;
    int layer; bf16* P; const float* SS; const float* qkg; const float* bfp; float* kmean; float* logf2;
    __device__ __forceinline__ void operator()(const f32x4 (&acc)[2][2][4][2], const Unit& u, int wr, int wc, int fr, int fq) const {
        const int hh = u.pn * 4 + wc; const HeadInfo hi = head_info(layer, hh);
        if (hi.kind == HK_NONE) return;
        const bool norm = (hi.kind == HK_QNORM || hi.kind == HK_KNORM || hi.kind == HK_BK);
        f32x4 gv[2][2];
#pragma unroll
        for (int bj = 0; bj < 2; ++bj)
#pragma unroll
            for (int n = 0; n < 2; ++n) gv[bj][n] = norm ? *(const f32x4*)(qkg + hi.gidx * 64 + 32 * bj + 8 * fq + 4 * n) : (f32x4){1.f, 1.f, 1.f, 1.f};
        const float qs = (hi.kind == HK_QNORM) ? C2 : 1.f;
        f32x4 ksum[2][2];
#pragma unroll
        for (int bj = 0; bj < 2; ++bj)
#pragma unroll
            for (int n = 0; n < 2; ++n) ksum[bj][n] = (f32x4){0.f, 0.f, 0.f, 0.f};
#pragma unroll
        for (int ai = 0; ai < 2; ++ai)
#pragma unroll
            for (int m = 0; m < 4; ++m) {
                const int row = u.pm * BM + ai * HALF + wr * 64 + m * 16 + fr;
                const f32x4 sp = *(const f32x4*)(SS + (size_t)row * 16 + 4 * fq);
                float ss = (sp[0] + sp[1]) + (sp[2] + sp[3]); ss += __shfl_xor(ss, 16); ss += __shfl_xor(ss, 32);
                const float rstd = rsqrtf(ss * (1.f / DM) + EPS);
                f32x4 v[2][2];
#pragma unroll
                for (int bj = 0; bj < 2; ++bj)
#pragma unroll
                    for (int n = 0; n < 2; ++n) v[bj][n] = acc[ai][bj][m][n] * rstd;
                if (hi.kind == HK_CF) {
                    const int b = row / SEQ, t = row % SEQ;
                    if (fq < 2) {
#pragma unroll
                        for (int n = 0; n < 2; ++n) if (fq == 0 || n == 0) {
#pragma unroll
                            for (int e = 0; e < 4; ++e) { const int c = 8 * fq + 4 * n + e; logf2[((size_t)b * 12 + c) * SEQ + t] = logsig2(v[0][n][e] + bfp[c]); } } }
                    continue;
                }
                if (norm) { float q = 0.f;
#pragma unroll
                    for (int bj = 0; bj < 2; ++bj)
#pragma unroll
                        for (int n = 0; n < 2; ++n) q += (v[bj][n][0] * v[bj][n][0] + v[bj][n][1] * v[bj][n][1]) + (v[bj][n][2] * v[bj][n][2] + v[bj][n][3] * v[bj][n][3]);
                    q += __shfl_xor(q, 16); q += __shfl_xor(q, 32);
                    const float inv = rsqrtf(q * (1.f / 64.f) + EPS) * qs;
#pragma unroll
                    for (int bj = 0; bj < 2; ++bj)
#pragma unroll
                        for (int n = 0; n < 2; ++n) v[bj][n] = v[bj][n] * gv[bj][n] * inv; }
                if (hi.kind == HK_SILU) {
#pragma unroll
                    for (int bj = 0; bj < 2; ++bj)
#pragma unroll
                        for (int n = 0; n < 2; ++n)
#pragma unroll
                            for (int e = 0; e < 4; ++e) v[bj][n][e] = silu_f(v[bj][n][e]); }
                if (hi.kind == HK_BK) {
#pragma unroll
                    for (int bj = 0; bj < 2; ++bj)
#pragma unroll
                        for (int n = 0; n < 2; ++n) ksum[bj][n] += v[bj][n]; }
                bf16* rowp = P + (size_t)row * LDP + hi.dstcol + 8 * fq;
#pragma unroll
                for (int bj = 0; bj < 2; ++bj) { u32x4 w; w.x = cvt_pk_bf16(v[bj][0][0], v[bj][0][1]); w.y = cvt_pk_bf16(v[bj][0][2], v[bj][0][3]); w.z = cvt_pk_bf16(v[bj][1][0], v[bj][1][1]); w.w = cvt_pk_bf16(v[bj][1][2], v[bj][1][3]);
                    *(u32x4*)(rowp + 32 * bj) = w; }
            }
        if (hi.kind == HK_BK) {
            const int b = u.pm / 32, blk = u.pm % 32, h = hh - 16; float* kp = kmean + (((size_t)b * 6 + h) * 32 + blk) * 64 + 8 * fq;
#pragma unroll
            for (int bj = 0; bj < 2; ++bj)
#pragma unroll
                for (int n = 0; n < 2; ++n)
#pragma unroll
                    for (int e = 0; e < 4; ++e) { float s = ksum[bj][n][e]; s += __shfl_xor(s, 1); s += __shfl_xor(s, 2); s += __shfl_xor(s, 4); s += __shfl_xor(s, 8);
                        if (fr == 0) atomicAdd(kp + 32 * bj + 4 * n + e, s); }
        }
    }
};

struct EpiOut0 {
    static constexpr bool AFTER_DRAIN = false;
    const float* xin; bf16* XB; float* SS;
    __device__ __forceinline__ void operator()(const f32x4 (&acc)[2][2][4][2], const Unit& u, int wr, int wc, int fr, int fq) const {
#pragma unroll
        for (int ai = 0; ai < 2; ++ai)
#pragma unroll
            for (int m = 0; m < 4; ++m) {
                const int row = u.pm * BM + ai * HALF + wr * 64 + m * 16 + fr; const size_t off = (size_t)row * DM + u.pn * BM + 64 * wc + 8 * fq; float ss = 0.f;
#pragma unroll
                for (int bj = 0; bj < 2; ++bj) {
                    const f32x4 x0 = __builtin_nontemporal_load((const f32x4*)(xin + off + 32 * bj)) + acc[ai][bj][m][0], x1 = __builtin_nontemporal_load((const f32x4*)(xin + off + 32 * bj + 4)) + acc[ai][bj][m][1];
                    ss += (x0[0] * x0[0] + x0[1] * x0[1]) + (x0[2] * x0[2] + x0[3] * x0[3]) + (x1[0] * x1[0] + x1[1] * x1[1]) + (x1[2] * x1[2] + x1[3] * x1[3]);
                    u32x4 w; w.x = cvt_pk_bf16(x0[0], x0[1]); w.y = cvt_pk_bf16(x0[2], x0[3]); w.z = cvt_pk_bf16(x1[0], x1[1]); w.w = cvt_pk_bf16(x1[2], x1[3]); *(u32x4*)(XB + off + 32 * bj) = w;
                }
                ss += __shfl_xor(ss, 16); ss += __shfl_xor(ss, 32); if (fq == 0) SS[(size_t)row * 16 + u.pn * 4 + wc] = ss;
            }
    }
};
struct EpiOut1 {
    static constexpr bool AFTER_DRAIN = false;
    const bf16* XB; float* xout;
    __device__ __forceinline__ void operator()(const f32x4 (&acc)[2][2][4][2], const Unit& u, int wr, int wc, int fr, int fq) const {
#pragma unroll
        for (int ai = 0; ai < 2; ++ai)
#pragma unroll
            for (int m = 0; m < 4; ++m) {
                const int row = u.pm * BM + ai * HALF + wr * 64 + m * 16 + fr; const size_t off = (size_t)row * DM + u.pn * BM + 64 * wc + 8 * fq;
#pragma unroll
                for (int bj = 0; bj < 2; ++bj) { const u32x4 w = *(const u32x4*)(XB + off + 32 * bj);
                    f32x4 x0, x1; x0[0] = __uint_as_float(w.x << 16); x0[1] = __uint_as_float(w.x & 0xffff0000u); x0[2] = __uint_as_float(w.y << 16); x0[3] = __uint_as_float(w.y & 0xffff0000u);
                    x1[0] = __uint_as_float(w.z << 16); x1[1] = __uint_as_float(w.z & 0xffff0000u); x1[2] = __uint_as_float(w.w << 16); x1[3] = __uint_as_float(w.w & 0xffff0000u);
                    __builtin_nontemporal_store(x0 + acc[ai][bj][m][0], (f32x4*)(xout + off + 32 * bj)); __builtin_nontemporal_store(x1 + acc[ai][bj][m][1], (f32x4*)(xout + off + 32 * bj + 4)); }
            }
    }
};
}
namespace att {
typedef LAS const char* lds_cptr;
typedef short s16x4 __attribute__((ext_vector_type(4)));
typedef short v4i16_t __attribute__((ext_vector_type(4)));
enum { M_SWA = 0, M_MOBA = 1, M_FOX = 2, M_MEM = 3 };
constexpr int SLOTB = 8192, LDS_K = 0, LDS_V = 3 * SLOTB, LDS_WS = 6 * SLOTB, WSB = 2048, LDS_OST = LDS_WS + 8 * WSB, LDS_END = LDS_OST + 8 * 4096;

__device__ __forceinline__ int crow(int r, int hi) { return (r & 3) + 8 * (r >> 2) + 4 * hi; }
__device__ __forceinline__ void glds16(const void* g, unsigned lds_base) {
    unsigned sv; asm volatile("s_mov_b32 %0, m0\n\ts_mov_b32 m0, %2\n\ts_nop 0\n\tglobal_load_lds_dwordx4 %1, off\n\ts_mov_b32 m0, %0" : "=&s"(sv) : "v"(g), "s"(lds_base) : "memory"); }
__device__ __forceinline__ void glds4(const void* g, unsigned lds_base) {
    unsigned sv; asm volatile("s_mov_b32 %0, m0\n\ts_mov_b32 m0, %2\n\ts_nop 0\n\tglobal_load_lds_dword %1, off\n\ts_mov_b32 m0, %0" : "=&s"(sv) : "v"(g), "s"(lds_base) : "memory"); }
__device__ __forceinline__ s16x4 vtr(lds_cptr p) { return __builtin_bit_cast(s16x4, __builtin_amdgcn_ds_read_tr16_b64_v4i16((LAS v4i16_t*)p)); }
__device__ __forceinline__ unsigned cvtpk(float lo, float hi) { typedef float f2 __attribute__((ext_vector_type(2))); typedef __bf16 b2 __attribute__((ext_vector_type(2))); f2 v = {lo, hi}; b2 b = __builtin_convertvector(v, b2); return __builtin_bit_cast(unsigned, b); }
#define ATT_MFMA(a, b, c) __builtin_amdgcn_mfma_f32_32x32x16_bf16(a, b, c, 0, 0, 0)
#define ATT_WAIT_BAR(N) asm volatile("s_waitcnt vmcnt(" #N ") lgkmcnt(0)\n\ts_barrier" ::: "memory")
#define ATT_RFL(x) ((unsigned)__builtin_amdgcn_readfirstlane((int)(x)))

struct UnitP {
    const bf16* Q;
    const bf16* K; const bf16* V; int pitch;
    const bf16* Z; bf16* Y;
    int qb, t_hi, t_lo;
    float sl2, sinkp, thr2;
    const float* lf; const float* kmean;
    unsigned* qctr; LAS unsigned* qw;
};

template <int MODE> __device__ __forceinline__ void attn_epilogue(const UnitP& u, LAS unsigned char* shm, const f32x16& o0, const f32x16& o1, float l) {
    const int tid = threadIdx.x, lane = tid & 63, r32 = lane & 31, hi = lane >> 5; const int wid = __builtin_amdgcn_readfirstlane(tid >> 6);
    LAS float* wsf = (LAS float*)(shm + LDS_WS + wid * WSB);
    unsigned nxt = 0u; if (tid == 0) nxt = __hip_atomic_fetch_add(u.qctr, 1u, __ATOMIC_RELAXED, __HIP_MEMORY_SCOPE_AGENT);
    const int orow = lane >> 1, oh = lane & 1;
    u32x4 zz[2][2];
#pragma unroll
    for (int d0 = 0; d0 < 2; ++d0) { const bf16* zp = u.Z + (size_t)(wid * 32 + orow) * LDP + 32 * d0 + 16 * oh; zz[d0][0] = *(const u32x4*)zp; zz[d0][1] = *(const u32x4*)(zp + 8); }
    l += __shfl_xor(l, 32); if (MODE == M_SWA) l += u.sinkp;
    if (hi == 0) wsf[r32] = 1.f / l;
    asm volatile("s_waitcnt lgkmcnt(0)" ::: "memory");
    float rl[16];
#pragma unroll
    for (int r = 0; r < 16; ++r) rl[r] = wsf[crow(r, hi)];
    LAS float* ost = (LAS float*)(shm + LDS_OST + wid * 4096);
#pragma unroll
    for (int d0 = 0; d0 < 2; ++d0) {
#pragma unroll
        for (int r = 0; r < 16; ++r) ost[crow(r, hi) * 32 + r32] = (d0 == 0 ? o0[r] : o1[r]) * rl[r];
        asm volatile("s_waitcnt lgkmcnt(0)" ::: "memory");
        f32x4 ov[4];
#pragma unroll
        for (int j = 0; j < 4; ++j) ov[j] = *(const LAS f32x4*)(ost + orow * 32 + 16 * oh + 4 * j);
        const u32x4 z0 = zz[d0][0], z1 = zz[d0][1];
        u32x4 y0, y1;
#pragma unroll
        for (int j = 0; j < 4; ++j) { const unsigned za = j < 2 ? z0[2 * j] : z1[2 * (j - 2)], zb = j < 2 ? z0[2 * j + 1] : z1[2 * (j - 2) + 1];
            const unsigned w0 = cvtpk(ov[j][0] * __uint_as_float(za << 16), ov[j][1] * __uint_as_float(za & 0xffff0000u)), w1 = cvtpk(ov[j][2] * __uint_as_float(zb << 16), ov[j][3] * __uint_as_float(zb & 0xffff0000u));
            if (j < 2) { y0[2 * j] = w0; y0[2 * j + 1] = w1; } else { y1[2 * (j - 2)] = w0; y1[2 * (j - 2) + 1] = w1; } }
        bf16* yp = u.Y + (size_t)(wid * 32 + orow) * DM + 32 * d0 + 16 * oh;
        *(u32x4*)yp = y0; *(u32x4*)(yp + 8) = y1;
        asm volatile("s_waitcnt lgkmcnt(0)" ::: "memory");
    }
    if (tid == 0) *u.qw = nxt;
    asm volatile("s_waitcnt vmcnt(0) lgkmcnt(0)\n\ts_barrier" ::: "memory");
}

template <int MODE> __device__ __forceinline__ void attn_unit(const UnitP& u, LAS unsigned char* shm) {
    const int tid = threadIdx.x, lane = tid & 63, r32 = lane & 31, hi = lane >> 5; const int wid = __builtin_amdgcn_readfirstlane(tid >> 6);
    const unsigned lds0 = (unsigned)(size_t)shm;
    LAS float* wsf = (LAS float*)(shm + LDS_WS + wid * WSB);
    const int pitch = u.pitch;
    const bf16* ksrc = u.K + (size_t)lane * pitch + wid * 8;
    const bf16* vsrc = u.V + (size_t)(16 * (wid & 3) + (lane >> 2)) * pitch + (wid >> 2) * 32 + (lane & 3) * 8;
    const float* fsrc = u.lf + lane + 1;
    const unsigned kdst = lds0 + LDS_K + wid * 1024, vdst = lds0 + LDS_V + wid * 1024, fdst = lds0 + LDS_WS + wid * WSB;
    const int NT = u.t_hi - u.t_lo + 1;
#define ATT_DMA(i, slot) do { const int t_ = u.t_hi - (i); glds16(ksrc + (size_t)t_ * 64 * pitch, ATT_RFL(kdst + (slot) * SLOTB)); glds16(vsrc + (size_t)t_ * 64 * pitch, ATT_RFL(vdst + (slot) * SLOTB)); \
        if (MODE == M_FOX) glds4(fsrc + t_ * 64, ATT_RFL(fdst + (slot) * 256)); } while (0)
    ATT_DMA(0, 0); if (NT > 1) ATT_DMA(1, 1);
    bf16x8 qr[4];
    { const bf16* Qw = u.Q + (size_t)(wid * 32 + r32) * LDP + hi * 8;
#pragma unroll
      for (int d0 = 0; d0 < 4; ++d0) qr[d0] = *(const bf16x8*)(Qw + d0 * 16); }
    asm volatile("" : "+v"(qr[0]), "+v"(qr[1]), "+v"(qr[2]), "+v"(qr[3]));
    const int qrel = wid * 32 + r32, qpos = u.qb * 256 + qrel;
    float Eq = 0.f, Eq0 = 0.f, carry = 0.f;
    if (MODE == M_FOX) {
        const int q0 = u.qb * 256;
#pragma unroll 1
        for (int jb = 3; jb >= 0; --jb) { float w = u.lf[q0 + 64 * jb + lane + 1]; if (jb == 3 && lane == 63) w = 0.f;
#pragma unroll
            for (int d = 1; d < 64; d <<= 1) { const float o = __shfl_down(w, d); if (lane + d < 64) w += o; }
            w += carry; wsf[256 + 64 * jb + lane] = w; carry = __builtin_bit_cast(float, __builtin_amdgcn_readfirstlane(__builtin_bit_cast(int, w))); }
        asm volatile("s_waitcnt lgkmcnt(0)" ::: "memory");
        Eq = wsf[256 + qrel]; Eq0 = carry;
    }
    unsigned selmask = 0u;
    if (MODE == M_MOBA) { if (u.qb > 0) {
        f32x16 g = f32x16{}; const float* km = u.kmean + (size_t)r32 * 64 + hi * 8;
#pragma unroll
        for (int d0 = 0; d0 < 4; ++d0) { const f32x4 a0 = *(const f32x4*)(km + 16 * d0), a1 = *(const f32x4*)(km + 16 * d0 + 4); bf16x8 kh, kl;
#pragma unroll
            for (int j = 0; j < 4; ++j) { unsigned h0 = f2bf(a0[j]), h1 = f2bf(a1[j]); kh[j] = (short)h0; kh[j + 4] = (short)h1; kl[j] = (short)f2bf(a0[j] - bf2f((bf16)h0)); kl[j + 4] = (short)f2bf(a1[j] - bf2f((bf16)h1)); }
            g = ATT_MFMA(kh, qr[d0], g); g = ATT_MFMA(kl, qr[d0], g); }
#pragma unroll
        for (int r = 0; r < 16; ++r) if (crow(r, hi) >= u.qb) g[r] = -INFINITY;
#pragma unroll 1
        for (int it = 0; it < 3; ++it) { float bv = -INFINITY; int bj = 99;
#pragma unroll
            for (int r = 0; r < 16; ++r) if (g[r] > bv) { bv = g[r]; bj = crow(r, hi); }
            const float pv = __shfl_xor(bv, 32); const int pj = __shfl_xor(bj, 32);
            if (pv > bv || (pv == bv && pj < bj)) { bv = pv; bj = pj; }
            if (bv > -INFINITY) selmask |= 1u << (bj & 31);
#pragma unroll
            for (int r = 0; r < 16; ++r) if (crow(r, hi) == bj) g[r] = -INFINITY; }
    } }
    f32x16 o0 = f32x16{}, o1 = f32x16{}; float l = 0.f;
    int sl = 0;
    const lds_cptr shc = (lds_cptr)shm;
#pragma unroll 1
    for (int i = 0; i < NT; ++i) {
        if (i + 1 < NT) { if (MODE == M_FOX) ATT_WAIT_BAR(3); else ATT_WAIT_BAR(2); } else ATT_WAIT_BAR(0);
        if (i + 2 < NT) { const int s2 = sl == 0 ? 2 : sl - 1; ATT_DMA(i + 2, s2); }
        const int t = u.t_hi - i, jb = t - 4 * u.qb;
        bool active = true; int esrc = 192;
        if (MODE == M_FOX) {
            if (jb >= 0) esrc = 256 + 64 * jb;
            else { float w = wsf[sl * 64 + lane];
#pragma unroll
                for (int d = 1; d < 64; d <<= 1) { const float o = __shfl_down(w, d); if (lane + d < 64) w += o; }
                w += carry; const float etop = __builtin_bit_cast(float, __builtin_amdgcn_readlane(__builtin_bit_cast(int, w), 63));
                if (__builtin_amdgcn_readfirstlane((int)(etop - Eq0 < -u.thr2))) break;
                wsf[192 + lane] = w; carry = __builtin_bit_cast(float, __builtin_amdgcn_readfirstlane(__builtin_bit_cast(int, w))); }
        }
        if (MODE != M_MEM) { if (jb >= 0) active = (64 * jb <= wid * 32 + 31); }
        if (MODE == M_SWA) active = active && (64 * jb >= wid * 32 - 190);
        bool rowsel = true;
        if (MODE == M_MOBA) { if (jb < 0) { rowsel = (selmask >> (t >> 2)) & 1u; active = (__ballot(rowsel) != 0ull); } }
        if (active) {
            const lds_cptr kp = shc + LDS_K + sl * SLOTB + hi * 1024 + r32 * 16;
            bf16x8 kf[8];
#pragma unroll
            for (int d0 = 0; d0 < 4; ++d0) { kf[2 * d0] = *(const LAS bf16x8*)(kp + d0 * 2048); kf[2 * d0 + 1] = *(const LAS bf16x8*)(kp + d0 * 2048 + 512); }
            f32x16 p0, p1;
            if (MODE == M_MEM) { p0 = f32x16{}; p1 = f32x16{}; }
            else if (MODE == M_FOX) { asm volatile("s_waitcnt lgkmcnt(0)" ::: "memory");
#pragma unroll
                for (int g = 0; g < 4; ++g) { const f32x4 e0 = *(const LAS f32x4*)(wsf + esrc + 8 * g + 4 * hi), e1 = *(const LAS f32x4*)(wsf + esrc + 32 + 8 * g + 4 * hi);
#pragma unroll
                    for (int e = 0; e < 4; ++e) { p0[4 * g + e] = e0[e] - Eq; p1[4 * g + e] = e1[e] - Eq; } } }
            else { float base = u.sl2 * (float)(64 * t + 4 * hi - qpos); if (MODE == M_MOBA) { if (!rowsel) base = -INFINITY; }
#pragma unroll
                for (int r = 0; r < 16; ++r) { p0[r] = __builtin_fmaf(u.sl2, (float)((r & 3) + 8 * (r >> 2)), base); p1[r] = p0[r] + 32.f * u.sl2; } }
            p0 = ATT_MFMA(kf[0], qr[0], p0); p1 = ATT_MFMA(kf[1], qr[0], p1); p0 = ATT_MFMA(kf[2], qr[1], p0); p1 = ATT_MFMA(kf[3], qr[1], p1);
            p0 = ATT_MFMA(kf[4], qr[2], p0); p1 = ATT_MFMA(kf[5], qr[2], p1); p0 = ATT_MFMA(kf[6], qr[3], p0); p1 = ATT_MFMA(kf[7], qr[3], p1);
            if (MODE != M_MEM) { if (jb >= 0) { const int kb = 64 * jb + 4 * hi;
#pragma unroll
                for (int r = 0; r < 16; ++r) { const int kv = kb + (r & 3) + 8 * (r >> 2); if (kv > qrel) p0[r] = -INFINITY; if (kv + 32 > qrel) p1[r] = -INFINITY; } } }
            if (MODE == M_SWA) { const int kb = 64 * jb + 4 * hi;
#pragma unroll
                for (int r = 0; r < 16; ++r) { const int kv = kb + (r & 3) + 8 * (r >> 2); if (qrel - kv >= 128) p0[r] = -INFINITY; if (qrel - kv - 32 >= 128) p1[r] = -INFINITY; } }
#pragma unroll
            for (int r = 0; r < 16; ++r) { p0[r] = fexp2(p0[r]); p1[r] = fexp2(p1[r]); }
            float s = 0.f;
#pragma unroll
            for (int r = 0; r < 16; ++r) s += p0[r] + p1[r];
            l += s;
            u32x4 pw[4];
#pragma unroll
            for (int j = 0; j < 4; ++j) { pw[0][j] = cvtpk(p0[2 * j], p0[2 * j + 1]); pw[1][j] = cvtpk(p0[8 + 2 * j], p0[9 + 2 * j]); pw[2][j] = cvtpk(p1[2 * j], p1[2 * j + 1]); pw[3][j] = cvtpk(p1[8 + 2 * j], p1[9 + 2 * j]); }
            const lds_cptr vp = shc + LDS_V + sl * SLOTB + ((lane >> 4) & 1) * 32 + (lane & 3) * 8 + (4 * hi + ((lane & 15) >> 2)) * 64;
#pragma unroll
            for (int ks = 0; ks < 4; ++ks) { const s16x4 a = vtr(vp + ks * 1024), b = vtr(vp + ks * 1024 + 512), c = vtr(vp + 4096 + ks * 1024), d = vtr(vp + 4096 + ks * 1024 + 512);
                const bf16x8 v0 = (bf16x8){a[0], a[1], a[2], a[3], b[0], b[1], b[2], b[3]}, v1 = (bf16x8){c[0], c[1], c[2], c[3], d[0], d[1], d[2], d[3]};
                o0 = ATT_MFMA(__builtin_bit_cast(bf16x8, pw[ks]), v0, o0); o1 = ATT_MFMA(__builtin_bit_cast(bf16x8, pw[ks]), v1, o1); }
        }
        sl = (sl == 2) ? 0 : sl + 1;
    }
    asm volatile("s_waitcnt vmcnt(0) lgkmcnt(0)" ::: "memory");
    attn_epilogue<MODE>(u, shm, o0, o1, l);
#undef ATT_DMA
}
}
namespace att {
#define AP_PIN(x) asm volatile("" : "+v"(x))
#define AP_SBAR() __builtin_amdgcn_sched_barrier(0)
#define AP_PKW(P, i) cvtpk(P[i], P[i + 1])
#define AP_PAF(w) __builtin_bit_cast(bf16x8, w)
#define AP_VF(a, b) (bf16x8){a[0], a[1], a[2], a[3], b[0], b[1], b[2], b[3]}

__device__ __forceinline__ float dpp_prefix_sum64(float v) {
    int x = __builtin_bit_cast(int, v);
#define AP_DPP_ADD(ctrl, rmask) { const int t_ = __builtin_amdgcn_update_dpp(0, x, ctrl, rmask, 0xf, false); x = __builtin_bit_cast(int, __builtin_bit_cast(float, x) + __builtin_bit_cast(float, t_)); }
    AP_DPP_ADD(0x111, 0xf) AP_DPP_ADD(0x112, 0xf) AP_DPP_ADD(0x114, 0xf) AP_DPP_ADD(0x118, 0xf)
    AP_DPP_ADD(0x142, 0xa)
    AP_DPP_ADD(0x143, 0xc)
#undef AP_DPP_ADD
    return __builtin_bit_cast(float, x);
}

template <int MODE> __device__ __forceinline__ void attn_unit_pipe(const UnitP& u, LAS unsigned char* shm) {
    static_assert(MODE == M_FOX || MODE == M_MOBA, "pipelined body: FoX and MoBA units");
    const int tid = threadIdx.x, lane = tid & 63, r32 = lane & 31, hi = lane >> 5; const int wid = __builtin_amdgcn_readfirstlane(tid >> 6);
    const unsigned lds0 = (unsigned)(size_t)shm;
    LAS float* wsf = (LAS float*)(shm + LDS_WS + wid * WSB);
    const bf16* ksrc = u.K + (size_t)lane * LDP + wid * 8;
    const bf16* vsrc = u.V + (size_t)(16 * (wid & 3) + (lane >> 2)) * LDP + (wid >> 2) * 32 + (lane & 3) * 8;
    const float* fsrc = u.lf + lane + 1;
    const unsigned kdst = lds0 + LDS_K + wid * 1024, vdst = lds0 + LDS_V + wid * 1024, fdst = lds0 + LDS_WS + wid * WSB;
    const int NT = u.t_hi + 1;
#define AP_TILE(i) ((i) < NT ? u.t_hi - (i) : 0)
#define AP_DMA_K(i, so) glds16(ksrc + (size_t)AP_TILE(i) * 64 * LDP, ATT_RFL(kdst + (so)))
#define AP_DMA_V(i, so) glds16(vsrc + (size_t)AP_TILE(i) * 64 * LDP, ATT_RFL(vdst + (so)))
#define AP_DMA_F(i, so) do { if (MODE == M_FOX) glds4(fsrc + AP_TILE(i) * 64, ATT_RFL(fdst + ((so) >> 5))); } while (0)
    AP_DMA_K(0, 0); AP_DMA_V(0, 0); AP_DMA_F(0, 0); AP_DMA_K(1, SLOTB); AP_DMA_F(1, SLOTB); AP_DMA_K(2, 2 * SLOTB); AP_DMA_F(2, 2 * SLOTB);
    bf16x8 qr[4];
    { const bf16* Qw = u.Q + (size_t)(wid * 32 + r32) * LDP + hi * 8;
#pragma unroll
      for (int d0 = 0; d0 < 4; ++d0) qr[d0] = *(const bf16x8*)(Qw + d0 * 16); }
    asm volatile("" : "+v"(qr[0]), "+v"(qr[1]), "+v"(qr[2]), "+v"(qr[3]));
    const int qrel = wid * 32 + r32, qpos = u.qb * 256 + qrel;
    float Eq = 0.f, Eq0 = 0.f, carry = 0.f;
    if (MODE == M_FOX) {
        const int q0 = u.qb * 256;
        float w4[4];
#pragma unroll
        for (int jb = 0; jb < 4; ++jb) w4[jb] = u.lf[q0 + 64 * jb + (63 - lane) + 1];
        if (lane == 0) w4[3] = 0.f;
#pragma unroll
        for (int jb = 3; jb >= 0; --jb) { float w = dpp_prefix_sum64(w4[jb]) + carry; wsf[256 + 64 * jb + (63 - lane)] = w; carry = __builtin_bit_cast(float, __builtin_amdgcn_readlane(__builtin_bit_cast(int, w), 63)); }
        asm volatile("s_waitcnt lgkmcnt(0)" ::: "memory");
        Eq = wsf[256 + qrel]; Eq0 = carry;
    }
    unsigned selmask = 0u;
    if (MODE == M_MOBA) { if (u.qb > 0) {
        f32x16 g = f32x16{}; const float* km = u.kmean + (size_t)r32 * 64 + hi * 8;
#pragma unroll
        for (int d0 = 0; d0 < 4; ++d0) { const f32x4 a0 = *(const f32x4*)(km + 16 * d0), a1 = *(const f32x4*)(km + 16 * d0 + 4); bf16x8 kh, kl;
#pragma unroll
            for (int j = 0; j < 4; ++j) { unsigned h0 = f2bf(a0[j]), h1 = f2bf(a1[j]); kh[j] = (short)h0; kh[j + 4] = (short)h1; kl[j] = (short)f2bf(a0[j] - bf2f((bf16)h0)); kl[j + 4] = (short)f2bf(a1[j] - bf2f((bf16)h1)); }
            g = ATT_MFMA(kh, qr[d0], g); g = ATT_MFMA(kl, qr[d0], g); }
#pragma unroll
        for (int r = 0; r < 16; ++r) if (crow(r, hi) >= u.qb) g[r] = -INFINITY;
#pragma unroll 1
        for (int it = 0; it < 3; ++it) { float bv = -INFINITY; int bj = 99;
#pragma unroll
            for (int r = 0; r < 16; ++r) if (g[r] > bv) { bv = g[r]; bj = crow(r, hi); }
            const float pv = __shfl_xor(bv, 32); const int pj = __shfl_xor(bj, 32);
            if (pv > bv || (pv == bv && pj < bj)) { bv = pv; bj = pj; }
            if (bv > -INFINITY) selmask |= 1u << (bj & 31);
#pragma unroll
            for (int r = 0; r < 16; ++r) if (crow(r, hi) == bj) g[r] = -INFINITY; }
    } }
    const lds_cptr shc = (lds_cptr)shm;
    const lds_cptr kp0 = shc + LDS_K + hi * 1024 + r32 * 16;
    const lds_cptr vp0 = shc + LDS_V + ((lane >> 4) & 1) * 32 + (lane & 3) * 8 + (4 * hi + ((lane & 15) >> 2)) * 64;
#define AP_CINIT4(X, b, p1, I) do { const int ti_ = u.t_hi - (I); \
        if (MODE == M_FOX) { const int jb2_ = ti_ - 4 * u.qb; const int es_ = jb2_ >= 0 ? 256 + 64 * jb2_ : 192; const f32x4 e_ = *(const LAS f32x4*)(wsf + es_ + ((p1) ? 32 : 0) + 2 * (b) + 4 * hi); \
            X[(b)] = e_[0] - Eq; X[(b) + 1] = e_[1] - Eq; X[(b) + 2] = e_[2] - Eq; X[(b) + 3] = e_[3] - Eq; } \
        else { float base_ = u.sl2 * (float)(64 * ti_ + 4 * hi - qpos + ((p1) ? 32 : 0)); if (ti_ < 4 * u.qb) { if (!((selmask >> (ti_ >> 2)) & 1u)) base_ = -INFINITY; } \
            X[(b)] = __builtin_fmaf(u.sl2, (float)(2 * (b)), base_); X[(b) + 1] = __builtin_fmaf(u.sl2, (float)(2 * (b) + 1), base_); X[(b) + 2] = __builtin_fmaf(u.sl2, (float)(2 * (b) + 2), base_); X[(b) + 3] = __builtin_fmaf(u.sl2, (float)(2 * (b) + 3), base_); } } while (0)
#define AP_CMASK(C0, C1, I) do { const int jbm_ = u.t_hi - (I) - 4 * u.qb; if (jbm_ >= 0) { const int kb_ = 64 * jbm_ + 4 * hi; \
        _Pragma("unroll") for (int r = 0; r < 16; ++r) { const int kv_ = kb_ + (r & 3) + 8 * (r >> 2); if (kv_ > qrel) C0[r] = -INFINITY; if (kv_ + 32 > qrel) C1[r] = -INFINITY; } } } while (0)
    f32x16 pA0, pA1, pB0, pB1, o0 = f32x16{}, o1 = f32x16{}; float l = 0.f;
    bf16x8 kf[8]; u32x4 pw0, pw1, pw2, pw3;
    int so_prev = 0, so_cur = 0, so_n1 = SLOTB, so_n2 = 2 * SLOTB;
#define AP_ROT() do { so_prev = so_cur; so_cur = so_n1; so_n1 = so_n2; so_n2 = so_prev; } while (0)
    bool last = false;
    asm volatile("s_waitcnt vmcnt(0) lgkmcnt(0)\n\ts_barrier" ::: "memory");
#pragma unroll
    for (int g = 0; g < 4; ++g) { AP_CINIT4(pA0, 4 * g, 0, 0); AP_CINIT4(pA1, 4 * g, 1, 0); }
#pragma unroll
    for (int d0 = 0; d0 < 4; ++d0) { kf[2 * d0] = *(const LAS bf16x8*)(kp0 + d0 * 2048); kf[2 * d0 + 1] = *(const LAS bf16x8*)(kp0 + d0 * 2048 + 512); }
    pA0 = ATT_MFMA(kf[0], qr[0], pA0); pA1 = ATT_MFMA(kf[1], qr[0], pA1); pA0 = ATT_MFMA(kf[2], qr[1], pA0); pA1 = ATT_MFMA(kf[3], qr[1], pA1);
    pA0 = ATT_MFMA(kf[4], qr[2], pA0); pA1 = ATT_MFMA(kf[5], qr[2], pA1); pA0 = ATT_MFMA(kf[6], qr[3], pA0); pA1 = ATT_MFMA(kf[7], qr[3], pA1);
    AP_CMASK(pA0, pA1, 0);
#pragma unroll
    for (int r = 0; r < 16; ++r) { pA0[r] = fexp2(pA0[r]); pA1[r] = fexp2(pA1[r]); }
    asm volatile("s_waitcnt vmcnt(0) lgkmcnt(0)\n\ts_barrier" ::: "memory");
    AP_DMA_K(3, 0); AP_DMA_V(1, SLOTB); AP_DMA_F(3, 0);
#pragma unroll
    for (int d0 = 0; d0 < 4; ++d0) { kf[2 * d0] = *(const LAS bf16x8*)(kp0 + SLOTB + d0 * 2048); kf[2 * d0 + 1] = *(const LAS bf16x8*)(kp0 + SLOTB + d0 * 2048 + 512); }
#pragma unroll
    for (int g = 0; g < 4; ++g) { AP_CINIT4(pB0, 4 * g, 0, 1); AP_CINIT4(pB1, 4 * g, 1, 1); }
    if (MODE == M_FOX) ATT_WAIT_BAR(3); else ATT_WAIT_BAR(2);
    AP_ROT();
#define AP_GA(C, g, a0, a1, a2, a3, W0, W1, PW, SC) do { C = ATT_MFMA(kf[g], qr[(g) >> 1], C); kf[g] = *(const LAS bf16x8*)(kn_ + ((g) >> 1) * 2048 + ((g) & 1) * 512); \
        sacc += a0; sacc += a1; sacc += a2; sacc += a3; W0; W1; SC; AP_PIN(PW); AP_PIN(sacc); AP_SBAR(); } while (0)
#define AP_SCD(ctrl, rmask) do { if (MODE == M_FOX) { const int t_ = __builtin_amdgcn_update_dpp(0, sx_, ctrl, rmask, 0xf, false); sx_ = __builtin_bit_cast(int, __builtin_bit_cast(float, sx_) + __builtin_bit_cast(float, t_)); AP_PIN(sx_); } } while (0)
#define AP_GB(O, PW, VA, VB, NA, NB, noff, X, xb, Pn, pb, p1) do { if ((noff) >= 0) { NA = vtr(vp_ + (noff)); NB = vtr(vp_ + (noff) + 512); } \
        O = ATT_MFMA(AP_PAF(PW), AP_VF(VA, VB), O); X[xb] = fexp2(X[xb]); X[(xb) + 1] = fexp2(X[(xb) + 1]); X[(xb) + 2] = fexp2(X[(xb) + 2]); X[(xb) + 3] = fexp2(X[(xb) + 3]); \
        if (MODE == M_FOX) { Pn[pb] -= Eq; Pn[(pb) + 1] -= Eq; Pn[(pb) + 2] -= Eq; Pn[(pb) + 3] -= Eq; } else if (!last) AP_CINIT4(Pn, pb, p1, i_ + 1); AP_PIN(X); AP_PIN(Pn); AP_SBAR(); } while (0)
#define AP_VOFF(i) (((i) >> 2) * 4096 + ((i) & 3) * 1024)
#define AP_STEP(C0, C1, P0, P1, I) do { const int i_ = (I); const lds_cptr kn_ = kp0 + so_n1; AP_SBAR(); \
        int sx_ = 0; if (MODE == M_FOX) sx_ = __builtin_bit_cast(int, wsf[(so_n1 >> 5) / 4 + (63 - lane)]);                   \
        float sacc = P0[0] + P0[1]; \
        AP_GA(C0, 0, P0[2], P0[3], P0[4], P0[5], pw0[0] = AP_PKW(P0, 0), pw0[1] = AP_PKW(P0, 2), pw0, (void)0); \
        AP_GA(C1, 1, P0[6], P0[7], P0[8], P0[9], pw0[2] = AP_PKW(P0, 4), pw0[3] = AP_PKW(P0, 6), pw0, AP_SCD(0x111, 0xf)); \
        AP_GA(C0, 2, P0[10], P0[11], P0[12], P0[13], pw1[0] = AP_PKW(P0, 8), pw1[1] = AP_PKW(P0, 10), pw1, AP_SCD(0x112, 0xf)); \
        AP_GA(C1, 3, P0[14], P0[15], P1[0], P1[1], pw1[2] = AP_PKW(P0, 12), pw1[3] = AP_PKW(P0, 14), pw1, AP_SCD(0x114, 0xf)); \
        AP_GA(C0, 4, P1[2], P1[3], P1[4], P1[5], pw2[0] = AP_PKW(P1, 0), pw2[1] = AP_PKW(P1, 2), pw2, AP_SCD(0x118, 0xf)); \
        AP_GA(C1, 5, P1[6], P1[7], P1[8], P1[9], pw2[2] = AP_PKW(P1, 4), pw2[3] = AP_PKW(P1, 6), pw2, AP_SCD(0x142, 0xa)); \
        AP_GA(C0, 6, P1[10], P1[11], P1[12], P1[13], pw3[0] = AP_PKW(P1, 8), pw3[1] = AP_PKW(P1, 10), pw3, AP_SCD(0x143, 0xc)); \
        AP_GA(C1, 7, P1[14], P1[15], 0.f, 0.f, pw3[2] = AP_PKW(P1, 12), pw3[3] = AP_PKW(P1, 14), pw3, (void)0); \
        l += sacc; \
        last = (i_ + 1 >= NT); \
        if (MODE == M_FOX) { if (!last) { if (u.t_hi - (i_ + 1) < 4 * u.qb) {                                   \
            const float w_ = __builtin_bit_cast(float, sx_) + carry; \
            const float etop_ = __builtin_bit_cast(float, __builtin_amdgcn_readfirstlane(__builtin_bit_cast(int, w_)));       \
            if (__builtin_amdgcn_readfirstlane((int)(etop_ - Eq0 < -u.thr2))) last = true;                                  \
            else { wsf[192 + (63 - lane)] = w_; carry = __builtin_bit_cast(float, __builtin_amdgcn_readlane(__builtin_bit_cast(int, w_), 63)); } } } } \
        const lds_cptr vp_ = vp0 + so_prev; s16x4 va0_, vb0_, va1_, vb1_; va0_ = vtr(vp_ + AP_VOFF(0)); vb0_ = vtr(vp_ + AP_VOFF(0) + 512); \
        if (MODE == M_FOX) { const int jb2_ = u.t_hi - (i_ + 1) - 4 * u.qb; const LAS float* ep_ = wsf + (jb2_ >= 0 ? 256 + 64 * jb2_ : 192) + 4 * hi;     \
            _Pragma("unroll") for (int g_ = 0; g_ < 4; ++g_) { const f32x4 e0_ = *(const LAS f32x4*)(ep_ + 8 * g_), e1_ = *(const LAS f32x4*)(ep_ + 32 + 8 * g_); \
                P0[4 * g_] = e0_[0]; P0[4 * g_ + 1] = e0_[1]; P0[4 * g_ + 2] = e0_[2]; P0[4 * g_ + 3] = e0_[3]; P1[4 * g_] = e1_[0]; P1[4 * g_ + 1] = e1_[1]; P1[4 * g_ + 2] = e1_[2]; P1[4 * g_ + 3] = e1_[3]; } } \
        AP_SBAR(); \
        AP_DMA_K(i_ + 3, so_cur); AP_DMA_V(i_ + 1, so_n1); AP_DMA_F(i_ + 3, so_cur); \
        AP_CMASK(C0, C1, i_); \
        AP_SBAR(); \
        AP_GB(o0, pw0, va0_, vb0_, va1_, vb1_, AP_VOFF(4), C0, 0, P0, 0, 0); \
        AP_GB(o1, pw0, va1_, vb1_, va0_, vb0_, AP_VOFF(1), C0, 4, P0, 4, 0); \
        AP_GB(o0, pw1, va0_, vb0_, va1_, vb1_, AP_VOFF(5), C0, 8, P0, 8, 0); \
        AP_GB(o1, pw1, va1_, vb1_, va0_, vb0_, AP_VOFF(2), C0, 12, P0, 12, 0); \
        AP_GB(o0, pw2, va0_, vb0_, va1_, vb1_, AP_VOFF(6), C1, 0, P1, 0, 1); \
        AP_GB(o1, pw2, va1_, vb1_, va0_, vb0_, AP_VOFF(3), C1, 4, P1, 4, 1); \
        AP_GB(o0, pw3, va0_, vb0_, va1_, vb1_, AP_VOFF(7), C1, 8, P1, 8, 1); \
        AP_GB(o1, pw3, va1_, vb1_, va0_, vb0_, -1, C1, 12, P1, 12, 1); \
        if (MODE == M_FOX) ATT_WAIT_BAR(3); else ATT_WAIT_BAR(2); \
        AP_ROT(); } while (0)
#define AP_DRAIN(P0, P1) do { float sacc = 0.f; _Pragma("unroll") for (int r = 0; r < 16; ++r) sacc += P0[r] + P1[r]; l += sacc; \
        pw0 = (u32x4){AP_PKW(P0, 0), AP_PKW(P0, 2), AP_PKW(P0, 4), AP_PKW(P0, 6)}; pw1 = (u32x4){AP_PKW(P0, 8), AP_PKW(P0, 10), AP_PKW(P0, 12), AP_PKW(P0, 14)}; \
        pw2 = (u32x4){AP_PKW(P1, 0), AP_PKW(P1, 2), AP_PKW(P1, 4), AP_PKW(P1, 6)}; pw3 = (u32x4){AP_PKW(P1, 8), AP_PKW(P1, 10), AP_PKW(P1, 12), AP_PKW(P1, 14)}; \
        const lds_cptr vp_ = vp0 + so_prev; \
        _Pragma("unroll") for (int ks = 0; ks < 4; ++ks) { const s16x4 a = vtr(vp_ + ks * 1024), b = vtr(vp_ + ks * 1024 + 512), c = vtr(vp_ + 4096 + ks * 1024), d = vtr(vp_ + 4096 + ks * 1024 + 512); \
            const u32x4 pw_ = ks == 0 ? pw0 : ks == 1 ? pw1 : ks == 2 ? pw2 : pw3; o0 = ATT_MFMA(AP_PAF(pw_), AP_VF(a, b), o0); o1 = ATT_MFMA(AP_PAF(pw_), AP_VF(c, d), o1); } } while (0)
    {
        int i = 1; bool inA = true;
#pragma unroll 1
        for (;;) {
            AP_STEP(pB0, pB1, pA0, pA1, i); inA = false; if (last) break;
            AP_STEP(pA0, pA1, pB0, pB1, i + 1); inA = true; if (last) break;
            i += 2;
        }
        if (inA) AP_DRAIN(pA0, pA1); else AP_DRAIN(pB0, pB1);
    }
    asm volatile("s_waitcnt vmcnt(0) lgkmcnt(0)" ::: "memory");
    attn_epilogue<MODE>(u, shm, o0, o1, l);
#undef AP_TILE
#undef AP_DMA_K
#undef AP_DMA_V
#undef AP_DMA_F
#undef AP_CINIT4
#undef AP_CMASK
#undef AP_ROT
#undef AP_GA
#undef AP_SCD
#undef AP_GB
#undef AP_VOFF
#undef AP_STEP
#undef AP_DRAIN
}
}
namespace att {
constexpr int G_K = 0, G_V = 32768, G_WS = 65536, G_OST = G_WS + 8 * WSB, G_END = G_OST + 8 * 4096;
constexpr int G_QW = G_END, G_PARTS = G_END + 64, G_PRE = G_PARTS + 384 * 4, G_SEL = G_PRE + 385 * 4;
constexpr int MLIST_CAP = 8192;

struct MobaBufs { unsigned* mcnt; unsigned short* mlist; bf16* slab_o; float* slab_l; };

__device__ __forceinline__ void moba_gate_item(const bf16* P, const float* kmean_all, const MobaBufs& mb, int b, int hb, int i) {
    const int tid = threadIdx.x, lane = tid & 63, r32 = lane & 31, hi = lane >> 5; const int wid = __builtin_amdgcn_readfirstlane(tid >> 6);
    const size_t row0 = (size_t)b * SEQ + i * 256;
    bf16x8 qr[4];
    { const bf16* Qw = P + (row0 + wid * 32 + r32) * LDP + L0_BQ + hb * 64 + hi * 8;
#pragma unroll
      for (int d0 = 0; d0 < 4; ++d0) qr[d0] = *(const bf16x8*)(Qw + d0 * 16); }
    f32x16 g = f32x16{}; const float* km = kmean_all + ((size_t)b * 6 + hb) * 32 * 64 + (size_t)r32 * 64 + hi * 8;
#pragma unroll
    for (int d0 = 0; d0 < 4; ++d0) { const f32x4 a0 = *(const f32x4*)(km + 16 * d0), a1 = *(const f32x4*)(km + 16 * d0 + 4); bf16x8 kh, kl;
#pragma unroll
        for (int j = 0; j < 4; ++j) { unsigned h0 = f2bf(a0[j]), h1 = f2bf(a1[j]); kh[j] = (short)h0; kh[j + 4] = (short)h1; kl[j] = (short)f2bf(a0[j] - bf2f((bf16)h0)); kl[j + 4] = (short)f2bf(a1[j] - bf2f((bf16)h1)); }
        g = ATT_MFMA(kh, qr[d0], g); g = ATT_MFMA(kl, qr[d0], g); }
#pragma unroll
    for (int r = 0; r < 16; ++r) if (crow(r, hi) >= i) g[r] = -INFINITY;
    unsigned selmask = 0u;
#pragma unroll 1
    for (int it = 0; it < 3; ++it) { float bv = -INFINITY; int bj = 99;
#pragma unroll
        for (int r = 0; r < 16; ++r) if (g[r] > bv) { bv = g[r]; bj = crow(r, hi); }
        const float pv = __shfl_xor(bv, 32); const int pj = __shfl_xor(bj, 32);
        if (pv > bv || (pv == bv && pj < bj)) { bv = pv; bj = pj; }
        if (bv > -INFINITY) selmask |= 1u << (bj & 31);
#pragma unroll
        for (int r = 0; r < 16; ++r) if (crow(r, hi) == bj) g[r] = -INFINITY; }
    const bool rep = (hi == 0);
    unsigned mycnt = 0u;
#pragma unroll 1
    for (int j = 0; j < i; ++j) { const unsigned long long m = __ballot(rep && ((selmask >> j) & 1u)); if (lane == j) mycnt = (unsigned)__popcll(m); }
    unsigned base = 0u; unsigned* cnt = mb.mcnt + ((size_t)b * 6 + hb) * 32;
    if (lane < i && mycnt) base = __hip_atomic_fetch_add(cnt + lane, mycnt, __ATOMIC_RELAXED, __HIP_MEMORY_SCOPE_AGENT);
    unsigned short* lst = mb.mlist + (((size_t)b * 6 + hb) * 32) * MLIST_CAP;
    const unsigned long long lt = (1ull << lane) - 1ull;
#pragma unroll 1
    for (int j = 0; j < i; ++j) { const bool sj = rep && ((selmask >> j) & 1u); const unsigned long long m = __ballot(sj);
        const unsigned bj = (unsigned)__builtin_amdgcn_readlane((int)base, j);
        if (sj) { const unsigned pos = bj + (unsigned)__popcll(m & lt), slot = (unsigned)__popc(selmask & ((1u << j) - 1u));
            lst[(size_t)j * MLIST_CAP + pos] = (unsigned short)((i * 256 + wid * 32 + r32) | (slot << 13)); } }
}

#ifndef KV_SUB
#define KV_SUB 2
#endif
struct SubChunk { int row, slot, S; bool valid, act; };
__device__ __forceinline__ void moba_subchunk(const SubChunk& sc, const bf16x8 (&qr)[4], int b, int hb, int j, float sl2, const MobaBufs& mb, LAS unsigned char* shm) {
    const int tid = threadIdx.x, lane = tid & 63, r32 = lane & 31, hi = lane >> 5; const int wid = __builtin_amdgcn_readfirstlane(tid >> 6);
    LAS float* wsf = (LAS float*)(shm + G_WS + wid * WSB);
    LAS float* ost = (LAS float*)(shm + G_OST + wid * 4096);
    const lds_cptr shc = (lds_cptr)shm;
    const int orow = lane >> 1, oh = lane & 1;
    const int S = sc.S; const bool own = (S < 8); const int k = 32 * S + r32; const int row = sc.row; const bool valid = sc.valid;
    f32x16 o0 = f32x16{}, o1 = f32x16{}; float l = 0.f;
#pragma unroll 1
    for (int tt = 3; tt >= 0; --tt) {
        if (own) { if (64 * tt > 32 * S + 31) continue; }
        const lds_cptr kp = shc + G_K + tt * 8192 + hi * 1024 + r32 * 16;
        bf16x8 kf[8];
#pragma unroll
        for (int d0 = 0; d0 < 4; ++d0) { kf[2 * d0] = *(const LAS bf16x8*)(kp + d0 * 2048); kf[2 * d0 + 1] = *(const LAS bf16x8*)(kp + d0 * 2048 + 512); }
        float base = sl2 * (float)(64 * (4 * j + tt) + 4 * hi - row); if (!valid) base = -INFINITY;
        f32x16 p0, p1;
#pragma unroll
        for (int r = 0; r < 16; ++r) { p0[r] = __builtin_fmaf(sl2, (float)((r & 3) + 8 * (r >> 2)), base); p1[r] = p0[r] + 32.f * sl2; }
        p0 = ATT_MFMA(kf[0], qr[0], p0); p1 = ATT_MFMA(kf[1], qr[0], p1); p0 = ATT_MFMA(kf[2], qr[1], p0); p1 = ATT_MFMA(kf[3], qr[1], p1);
        p0 = ATT_MFMA(kf[4], qr[2], p0); p1 = ATT_MFMA(kf[5], qr[2], p1); p0 = ATT_MFMA(kf[6], qr[3], p0); p1 = ATT_MFMA(kf[7], qr[3], p1);
        if (own) { const int kb = 64 * tt + 4 * hi;
#pragma unroll
            for (int r = 0; r < 16; ++r) { const int kv = kb + (r & 3) + 8 * (r >> 2); if (kv > k) p0[r] = -INFINITY; if (kv + 32 > k) p1[r] = -INFINITY; } }
#pragma unroll
        for (int r = 0; r < 16; ++r) { p0[r] = fexp2(p0[r]); p1[r] = fexp2(p1[r]); }
        float sm = 0.f;
#pragma unroll
        for (int r = 0; r < 16; ++r) sm += p0[r] + p1[r];
        l += sm;
        u32x4 pw[4];
#pragma unroll
        for (int q = 0; q < 4; ++q) { pw[0][q] = cvtpk(p0[2 * q], p0[2 * q + 1]); pw[1][q] = cvtpk(p0[8 + 2 * q], p0[9 + 2 * q]); pw[2][q] = cvtpk(p1[2 * q], p1[2 * q + 1]); pw[3][q] = cvtpk(p1[8 + 2 * q], p1[9 + 2 * q]); }
        const lds_cptr vp = shc + G_V + tt * 8192 + ((lane >> 4) & 1) * 32 + (lane & 3) * 8 + (4 * hi + ((lane & 15) >> 2)) * 64;
#pragma unroll
        for (int ks = 0; ks < 4; ++ks) { const s16x4 va = vtr(vp + ks * 1024), vb = vtr(vp + ks * 1024 + 512), vc = vtr(vp + 4096 + ks * 1024), vd = vtr(vp + 4096 + ks * 1024 + 512);
            const bf16x8 v0 = (bf16x8){va[0], va[1], va[2], va[3], vb[0], vb[1], vb[2], vb[3]}, v1 = (bf16x8){vc[0], vc[1], vc[2], vc[3], vd[0], vd[1], vd[2], vd[3]};
            o0 = ATT_MFMA(__builtin_bit_cast(bf16x8, pw[ks]), v0, o0); o1 = ATT_MFMA(__builtin_bit_cast(bf16x8, pw[ks]), v1, o1); }
    }
    l += __shfl_xor(l, 32);
    const size_t brow = (size_t)b * SEQ + row;
    if (hi == 0) { wsf[r32] = l > 0.f ? 1.f / l : 0.f; if (valid) mb.slab_l[((size_t)sc.slot * T + brow) * 6 + hb] = l; }
    asm volatile("s_waitcnt lgkmcnt(0)" ::: "memory");
    float rl[16];
#pragma unroll
    for (int r = 0; r < 16; ++r) rl[r] = wsf[crow(r, hi)];
    const int row_o = __shfl(row, orow), slot_o = __shfl(sc.slot, orow); const bool valid_o = __shfl((int)valid, orow) != 0;
    bf16* dst = mb.slab_o + (((size_t)slot_o * T + (size_t)b * SEQ + row_o) * 6 + hb) * 64 + 16 * oh;
#pragma unroll
    for (int d0 = 0; d0 < 2; ++d0) {
#pragma unroll
        for (int r = 0; r < 16; ++r) ost[crow(r, hi) * 32 + r32] = (d0 == 0 ? o0[r] : o1[r]) * rl[r];
        asm volatile("s_waitcnt lgkmcnt(0)" ::: "memory");
        f32x4 ov[4];
#pragma unroll
        for (int q = 0; q < 4; ++q) ov[q] = *(const LAS f32x4*)(ost + orow * 32 + 16 * oh + 4 * q);
        u32x4 y0, y1; y0[0] = cvtpk(ov[0][0], ov[0][1]); y0[1] = cvtpk(ov[0][2], ov[0][3]); y0[2] = cvtpk(ov[1][0], ov[1][1]); y0[3] = cvtpk(ov[1][2], ov[1][3]);
        y1[0] = cvtpk(ov[2][0], ov[2][1]); y1[1] = cvtpk(ov[2][2], ov[2][3]); y1[2] = cvtpk(ov[3][0], ov[3][1]); y1[3] = cvtpk(ov[3][2], ov[3][3]);
        if (valid_o) { *(u32x4*)(dst + 32 * d0) = y0; *(u32x4*)(dst + 32 * d0 + 8) = y1; }
        asm volatile("s_waitcnt lgkmcnt(0)" ::: "memory");
    }
}
__device__ __forceinline__ void moba_kv_unit(const bf16* P, const MobaBufs& mb, int b, int hb, int j, int part, unsigned* qctr, LAS unsigned char* shm) {
    const int tid = threadIdx.x, lane = tid & 63, r32 = lane & 31, hi = lane >> 5; const int wid = __builtin_amdgcn_readfirstlane(tid >> 6);
    const unsigned lds0 = (unsigned)(size_t)shm;
    const bf16* Pb = P + (size_t)b * SEQ * LDP;
    { const bf16* ksrc = Pb + L0_BK + hb * 64 + (size_t)(256 * j + lane) * LDP + wid * 8;
      const bf16* vsrc = Pb + L0_BV + hb * 64 + (size_t)(256 * j + 16 * (wid & 3) + (lane >> 2)) * LDP + (wid >> 2) * 32 + (lane & 3) * 8;
#pragma unroll
      for (int tt = 0; tt < 4; ++tt) { glds16(ksrc + (size_t)tt * 64 * LDP, ATT_RFL(lds0 + G_K + tt * 8192 + wid * 1024)); glds16(vsrc + (size_t)tt * 64 * LDP, ATT_RFL(lds0 + G_V + tt * 8192 + wid * 1024)); } }
    const int list = (b * 6 + hb) * 32 + j;
    const int cnt = (int)mb.mcnt[list]; const int rows_total = 256 + cnt;
    const unsigned short* lst = mb.mlist + (size_t)list * MLIST_CAP;
    const float sl2 = alibi_slope2(6 + hb);
    unsigned nxt = 0u; if (tid == 0) nxt = __hip_atomic_fetch_add(qctr, 1u, __ATOMIC_RELAXED, __HIP_MEMORY_SCOPE_AGENT);
    SubChunk cur, nx; bf16x8 qc[4], qn[4];
#define KV_DESC(D, s_) do { const int S_ = 8 * KV_SUB * part + wid + 8 * (s_); D.S = S_; D.act = ((s_) < KV_SUB) && (32 * S_ < rows_total); const int k_ = 32 * S_ + r32; \
        if (S_ < 8) { D.row = 256 * j + k_; D.slot = 3; D.valid = true; } \
        else { const int idx_ = k_ - 256; const bool v_ = D.act && idx_ < cnt; const unsigned e_ = v_ ? (unsigned)lst[idx_] : 0u; D.row = (int)(e_ & 8191u); D.slot = (int)(e_ >> 13); D.valid = v_; } } while (0)
    KV_DESC(cur, 0);
    { const bf16* Q0 = Pb + (size_t)cur.row * LDP + L0_BQ + hb * 64 + hi * 8;
#pragma unroll
      for (int d0 = 0; d0 < 4; ++d0) qc[d0] = *(const bf16x8*)(Q0 + d0 * 16); }
    asm volatile("" : "+v"(qc[0]), "+v"(qc[1]), "+v"(qc[2]), "+v"(qc[3]));
    asm volatile("s_waitcnt vmcnt(0) lgkmcnt(0)\n\ts_barrier" ::: "memory");
#pragma unroll 1
    for (int s = 0; s < KV_SUB; ++s) {
        if (!cur.act) break;
        KV_DESC(nx, s + 1);
        { const bf16* Q1 = Pb + (size_t)nx.row * LDP + L0_BQ + hb * 64 + hi * 8;
#pragma unroll
          for (int d0 = 0; d0 < 4; ++d0) qn[d0] = *(const bf16x8*)(Q1 + d0 * 16); }
        moba_subchunk(cur, qc, b, hb, j, sl2, mb, shm);
        cur = nx;
#pragma unroll
        for (int d0 = 0; d0 < 4; ++d0) qc[d0] = qn[d0];
    }
#undef KV_DESC
    if (tid == 0) *(LAS unsigned*)(shm + G_QW) = nxt;
    asm volatile("s_waitcnt vmcnt(0) lgkmcnt(0)\n\ts_barrier" ::: "memory");
}

__device__ __forceinline__ void moba_kv_phase(const Args& a, const MobaBufs& mb, LAS unsigned char* lds, unsigned* qctr) {
    const bf16* P = (const bf16*)(a.ws + WS_P);
    const int tid = threadIdx.x;
    LAS unsigned* qw = (LAS unsigned*)(lds + G_QW); LAS int* parts = (LAS int*)(lds + G_PARTS); LAS int* pre = (LAS int*)(lds + G_PRE); LAS int* sel = (LAS int*)(lds + G_SEL);
    if (tid == 0) {
        unsigned sp = 0u; while (__hip_atomic_load(mb.mcnt + 512, __ATOMIC_RELAXED, __HIP_MEMORY_SCOPE_AGENT) < 372u) { __builtin_amdgcn_s_sleep(2); if (++sp > (1u << 22)) break; }
        __builtin_amdgcn_fence(__ATOMIC_ACQUIRE, "agent"); asm volatile("s_waitcnt vmcnt(0)" ::: "memory"); }
    __syncthreads();
    if (tid < 384) parts[tid] = (256 + (int)__hip_atomic_load(mb.mcnt + tid, __ATOMIC_RELAXED, __HIP_MEMORY_SCOPE_AGENT) + 256 * KV_SUB - 1) / (256 * KV_SUB);
    if (tid == 0) *qw = __hip_atomic_fetch_add(qctr, 1u, __ATOMIC_RELAXED, __HIP_MEMORY_SCOPE_AGENT);
    __syncthreads();
    if (tid < 385) { int s = 0; for (int k = 0; k < tid; ++k) s += parts[k] - 1; pre[tid] = s; }
    __syncthreads();
    const int nfull = pre[384], total = nfull + 384;
    for (;;) {
        const int idx = __builtin_amdgcn_readfirstlane((int)*qw);
        if (idx >= total) break;
        if (tid < 384) { if (idx < nfull) { if (pre[tid] <= idx && idx < pre[tid + 1]) { sel[0] = tid; sel[1] = idx - pre[tid]; } }
                         else if (tid == idx - nfull) { sel[0] = tid; sel[1] = parts[tid] - 1; } }
        __syncthreads();
        const int list = __builtin_amdgcn_readfirstlane(sel[0]), part = __builtin_amdgcn_readfirstlane(sel[1]);
        const int bh = list >> 5, j = list & 31;
        moba_kv_unit(P, mb, bh / 6, bh % 6, j, part, qctr, lds);
    }
}

__device__ __forceinline__ void moba_combine(const Args& a, const MobaBufs& mb, int vcu, int G) {
    const bf16* P = (const bf16*)(a.ws + WS_P); bf16* Y = (bf16*)(a.ws + WS_Y);
    const int NIT = T * 6 * 8;
    for (int it = vcu * 512 + threadIdx.x; it < NIT; it += G * 512) {
        const int dg = it & 7, rh = it >> 3, hb = rh % 6, brow = rh / 6, blk = (brow & (SEQ - 1)) >> 8, nv = blk < 3 ? blk : 3;
        float O[8], L = 0.f;
#pragma unroll
        for (int e = 0; e < 8; ++e) O[e] = 0.f;
#pragma unroll
        for (int s = 0; s < 4; ++s) { if (s == 3 || s < nv) { const size_t si = ((size_t)s * T + brow) * 6 + hb; const float l = mb.slab_l[si]; const u32x4 w = *(const u32x4*)(mb.slab_o + si * 64 + 8 * dg);
#pragma unroll
            for (int e = 0; e < 4; ++e) { O[2 * e] += l * __uint_as_float(w[e] << 16); O[2 * e + 1] += l * __uint_as_float(w[e] & 0xffff0000u); } L += l; } }
        const float il = 1.f / L;
        const u32x4 z = *(const u32x4*)(P + (size_t)brow * LDP + L0_Z + (6 + hb) * 64 + 8 * dg); u32x4 y;
#pragma unroll
        for (int e = 0; e < 4; ++e) y[e] = cvtpk(O[2 * e] * il * __uint_as_float(z[e] << 16), O[2 * e + 1] * il * __uint_as_float(z[e] & 0xffff0000u));
        *(u32x4*)(Y + (size_t)brow * DM + (6 + hb) * 64 + 8 * dg) = y;
    }
}
}
#ifndef ATT_PIPE
#define ATT_PIPE 1
#endif
#ifndef MOBA_GATHER
#define MOBA_GATHER 1
#endif
namespace att {
constexpr int R_K = 0, R_V = 49152, R_WS = 98304, R_OST = R_WS + 8 * 256, R_END = R_OST + 8 * 4096;
__device__ __forceinline__ void swa_res_unit(const bf16* P, bf16* Y, const float* sinks, int b, int kvh, int qb, unsigned* qctr, LAS unsigned* qw, LAS unsigned char* shm) {
    const int tid = threadIdx.x, lane = tid & 63, r32 = lane & 31, hi = lane >> 5; const int wid = __builtin_amdgcn_readfirstlane(tid >> 6);
    const unsigned lds0 = (unsigned)(size_t)shm;
    const bf16* Pb = P + (size_t)b * SEQ * LDP;
    const int t0 = 4 * qb - 2 < 0 ? 0 : 4 * qb - 2, ntl = 4 * qb + 4 - t0;
    { const bf16* ksrc = Pb + L0_AK + kvh * 64 + (size_t)(64 * t0 + lane) * LDP + wid * 8;
      const bf16* vsrc = Pb + L0_AV + kvh * 64 + (size_t)(64 * t0 + 16 * (wid & 3) + (lane >> 2)) * LDP + (wid >> 2) * 32 + (lane & 3) * 8;
#pragma unroll 1
      for (int tt = 0; tt < ntl; ++tt) { glds16(ksrc + (size_t)tt * 64 * LDP, ATT_RFL(lds0 + R_K + tt * 8192 + wid * 1024)); glds16(vsrc + (size_t)tt * 64 * LDP, ATT_RFL(lds0 + R_V + tt * 8192 + wid * 1024)); } }
    unsigned nxt = 0u; if (tid == 0) nxt = __hip_atomic_fetch_add(qctr, 1u, __ATOMIC_RELAXED, __HIP_MEMORY_SCOPE_AGENT);
    const int qmin = 256 * qb + 32 * wid, qpos = qmin + r32; const size_t brow = (size_t)b * SEQ + qpos;
    asm volatile("s_waitcnt vmcnt(0) lgkmcnt(0)\n\ts_barrier" ::: "memory");
    LAS float* wsf = (LAS float*)(shm + R_WS + wid * 256); LAS float* ost = (LAS float*)(shm + R_OST + wid * 4096);
    const lds_cptr shc = (lds_cptr)shm;
    const int orow = lane >> 1, oh = lane & 1;
    const int t_hi = (qmin + 31) >> 6, t_lo = (qmin - 127) < 0 ? 0 : (qmin - 127) >> 6;
#pragma unroll 1
    for (int g = 0; g < 3; ++g) { const int h = 3 * kvh + g; float sl2v = alibi_slope2(h); asm volatile("" : "+v"(sl2v)); const float sl8v = sl2v * 4.f * 2.f, sl16v = sl8v * 2.f, sl24v = sl8v + sl16v, sl32v = sl16v * 2.f;
        bf16x8 qr[4];
        { const bf16* Qw = P + brow * LDP + L0_AQ + h * 64 + hi * 8;
#pragma unroll
          for (int d0 = 0; d0 < 4; ++d0) qr[d0] = *(const bf16x8*)(Qw + d0 * 16); }
        const size_t srow = (size_t)b * SEQ + qmin + orow;
        u32x4 zz[2][2];
#pragma unroll
        for (int d0 = 0; d0 < 2; ++d0) { const bf16* zp = P + srow * LDP + L0_Z + h * 64 + 32 * d0 + 16 * oh; zz[d0][0] = *(const u32x4*)zp; zz[d0][1] = *(const u32x4*)(zp + 8); }
        f32x16 o0 = f32x16{}, o1 = f32x16{}; float l = 0.f;
#pragma unroll 1
        for (int t = t_hi; t >= t_lo; --t) {
            const lds_cptr kp = shc + R_K + (t - t0) * 8192 + hi * 1024 + r32 * 16;
            bf16x8 kf[8];
#pragma unroll
            for (int d0 = 0; d0 < 4; ++d0) { kf[2 * d0] = *(const LAS bf16x8*)(kp + d0 * 2048); kf[2 * d0 + 1] = *(const LAS bf16x8*)(kp + d0 * 2048 + 512); }
            const float base = sl2v * (float)(64 * t + 4 * hi - qpos);
            f32x16 p0, p1;
#pragma unroll
            for (int g4 = 0; g4 < 4; ++g4) { const float a0 = g4 == 0 ? base : g4 == 1 ? base + sl8v : g4 == 2 ? base + sl16v : base + sl24v;
                p0[4 * g4] = a0; p0[4 * g4 + 1] = a0 + sl2v; p0[4 * g4 + 2] = p0[4 * g4 + 1] + sl2v; p0[4 * g4 + 3] = p0[4 * g4 + 2] + sl2v; }
#pragma unroll
            for (int r = 0; r < 16; ++r) p1[r] = p0[r] + sl32v;
            p0 = ATT_MFMA(kf[0], qr[0], p0); p1 = ATT_MFMA(kf[1], qr[0], p1); p0 = ATT_MFMA(kf[2], qr[1], p0); p1 = ATT_MFMA(kf[3], qr[1], p1);
            p0 = ATT_MFMA(kf[4], qr[2], p0); p1 = ATT_MFMA(kf[5], qr[2], p1); p0 = ATT_MFMA(kf[6], qr[3], p0); p1 = ATT_MFMA(kf[7], qr[3], p1);
            { int d = qpos - (64 * t + 4 * hi); asm volatile("" : "+v"(d));
              if (64 * t + 63 > qmin) {
#pragma unroll
                  for (int r = 0; r < 16; ++r) { const int c = (r & 3) + 8 * (r >> 2); if (c > d) p0[r] = -INFINITY; if (c + 32 > d) p1[r] = -INFINITY; } }
              if (64 * t < qmin + 31 - 127) {
#pragma unroll
                  for (int r = 0; r < 16; ++r) { const int c = (r & 3) + 8 * (r >> 2); if (d - c >= 128) p0[r] = -INFINITY; if (d - c - 32 >= 128) p1[r] = -INFINITY; } } }
#pragma unroll
            for (int r = 0; r < 16; ++r) { p0[r] = fexp2(p0[r]); p1[r] = fexp2(p1[r]); }
            float sm = 0.f;
#pragma unroll
            for (int r = 0; r < 16; ++r) sm += p0[r] + p1[r];
            l += sm;
            u32x4 pw[4];
#pragma unroll
            for (int q = 0; q < 4; ++q) { pw[0][q] = cvtpk(p0[2 * q], p0[2 * q + 1]); pw[1][q] = cvtpk(p0[8 + 2 * q], p0[9 + 2 * q]); pw[2][q] = cvtpk(p1[2 * q], p1[2 * q + 1]); pw[3][q] = cvtpk(p1[8 + 2 * q], p1[9 + 2 * q]); }
            const lds_cptr vp = shc + R_V + (t - t0) * 8192 + ((lane >> 4) & 1) * 32 + (lane & 3) * 8 + (4 * hi + ((lane & 15) >> 2)) * 64;
#pragma unroll
            for (int ks = 0; ks < 4; ++ks) { const s16x4 va = vtr(vp + ks * 1024), vb = vtr(vp + ks * 1024 + 512), vc = vtr(vp + 4096 + ks * 1024), vd = vtr(vp + 4096 + ks * 1024 + 512);
                const bf16x8 v0 = (bf16x8){va[0], va[1], va[2], va[3], vb[0], vb[1], vb[2], vb[3]}, v1 = (bf16x8){vc[0], vc[1], vc[2], vc[3], vd[0], vd[1], vd[2], vd[3]};
                o0 = ATT_MFMA(__builtin_bit_cast(bf16x8, pw[ks]), v0, o0); o1 = ATT_MFMA(__builtin_bit_cast(bf16x8, pw[ks]), v1, o1); }
        }
        l += __shfl_xor(l, 32); l += fexp2(LOG2E * sinks[h]);
        if (hi == 0) wsf[r32] = 1.f / l;
        asm volatile("s_waitcnt lgkmcnt(0)" ::: "memory");
        float rl[16];
#pragma unroll
        for (int r = 0; r < 16; ++r) rl[r] = wsf[crow(r, hi)];
#pragma unroll
        for (int d0 = 0; d0 < 2; ++d0) {
#pragma unroll
            for (int r = 0; r < 16; ++r) ost[crow(r, hi) * 32 + r32] = (d0 == 0 ? o0[r] : o1[r]) * rl[r];
            asm volatile("s_waitcnt lgkmcnt(0)" ::: "memory");
            f32x4 ov[4];
#pragma unroll
            for (int j = 0; j < 4; ++j) ov[j] = *(const LAS f32x4*)(ost + orow * 32 + 16 * oh + 4 * j);
            const u32x4 z0 = zz[d0][0], z1 = zz[d0][1]; u32x4 y0, y1;
#pragma unroll
            for (int j = 0; j < 4; ++j) { const unsigned za = j < 2 ? z0[2 * j] : z1[2 * (j - 2)], zb = j < 2 ? z0[2 * j + 1] : z1[2 * (j - 2) + 1];
                const unsigned w0 = cvtpk(ov[j][0] * __uint_as_float(za << 16), ov[j][1] * __uint_as_float(za & 0xffff0000u)), w1 = cvtpk(ov[j][2] * __uint_as_float(zb << 16), ov[j][3] * __uint_as_float(zb & 0xffff0000u));
                if (j < 2) { y0[2 * j] = w0; y0[2 * j + 1] = w1; } else { y1[2 * (j - 2)] = w0; y1[2 * (j - 2) + 1] = w1; } }
            bf16* yp = Y + srow * DM + h * 64 + 32 * d0 + 16 * oh;
            *(u32x4*)yp = y0; *(u32x4*)(yp + 8) = y1;
            asm volatile("s_waitcnt lgkmcnt(0)" ::: "memory");
        }
    }
    if (tid == 0) *qw = nxt;
    asm volatile("s_waitcnt vmcnt(0) lgkmcnt(0)\n\ts_barrier" ::: "memory");
}

constexpr int NUNITS = 1024;
__device__ __forceinline__ void attn_phase(int layer, const Args& a, LAS unsigned char* lds, unsigned* qctr, const MobaBufs& mb) {
    unsigned char* ws = a.ws; const bf16* P = (const bf16*)(ws + WS_P); bf16* Y = (bf16*)(ws + WS_Y);
    LAS unsigned* qw = (LAS unsigned*)(lds + R_END);
    const int tid = threadIdx.x, lane = tid & 63;
    float thr2 = 0.f; bool zok = false;
    if (layer == 1) { const float* g = a.in[11]; float mq = fabsf(g[lane]), mk = fabsf(g[64 + lane]);
#pragma unroll
        for (int o = 1; o < 64; o <<= 1) { mq = fmaxf(mq, __shfl_xor(mq, o)); mk = fmaxf(mk, __shfl_xor(mk, o)); }
        thr2 = LOG2E * (104.f + 2.f * 8.f * mq * mk); thr2 = __builtin_bit_cast(float, __builtin_amdgcn_readfirstlane(__builtin_bit_cast(int, thr2))); }
    if (tid == 0) *qw = __hip_atomic_fetch_add(qctr, 1u, __ATOMIC_RELAXED, __HIP_MEMORY_SCOPE_AGENT);
    __syncthreads();
    for (;;) {
        int idx = __builtin_amdgcn_readfirstlane((int)*qw);
        if (MOBA_GATHER && layer == 0) {
            if (idx >= 372 + 128 + 256) break;
            if (idx < 372) { moba_gate_item(P, (const float*)(ws + WS_KMEAN), mb, (idx % 12) / 6, (idx % 12) % 6, 1 + idx / 12);
                asm volatile("s_waitcnt vmcnt(0)" ::: "memory");
                __syncthreads();
                if (tid == 0) { __builtin_amdgcn_fence(__ATOMIC_RELEASE, "agent"); asm volatile("s_waitcnt vmcnt(0)" ::: "memory");
                    __hip_atomic_fetch_add(mb.mcnt + 512, 1u, __ATOMIC_RELAXED, __HIP_MEMORY_SCOPE_AGENT);
                    *qw = __hip_atomic_fetch_add(qctr, 1u, __ATOMIC_RELAXED, __HIP_MEMORY_SCOPE_AGENT); }
                __syncthreads(); continue; }
            if (idx < 500) { const int k = idx - 372; swa_res_unit(P, Y, a.in[5], (k & 3) >> 1, k & 1, 31 - (k >> 2), qctr, qw, lds); continue; }
            idx += 768 - 500;
        }
        if (idx >= NUNITS) break;
        if (layer == 1 && idx >= 512 && !zok) {
            if (tid == 0) { unsigned sp = 0u; while (__hip_atomic_load(mb.mcnt + 1024, __ATOMIC_RELAXED, __HIP_MEMORY_SCOPE_AGENT) < 128u) { __builtin_amdgcn_s_sleep(2); if (++sp > (1u << 22)) break; }
                __builtin_amdgcn_fence(__ATOMIC_ACQUIRE, "agent"); asm volatile("s_waitcnt vmcnt(0)" ::: "memory"); }
            __syncthreads(); zok = true; }
        UnitP u; u.qctr = qctr; u.qw = qw; u.sl2 = 0.f; u.sinkp = 0.f; u.thr2 = thr2; u.lf = nullptr; u.kmean = nullptr; u.pitch = LDP;
        int mode;
        if (idx >= 768) { const int k = idx - 768, qb = k >> 3, bh = k & 7, b = bh >> 2, hm = bh & 3; mode = M_MEM;
            const size_t row0 = (size_t)b * SEQ + qb * 256; const int mq = layer == 0 ? L0_MQ : L1_MQ, zc = (layer == 0 ? L0_Z : L1_Z) + (12 + hm) * 64;
            const bf16* MK = (const bf16*)(ws + WS_MKV + (size_t)(2 * layer) * MKV_ONE) + (size_t)b * MEML * 256 + hm * 64; const bf16* MV = (const bf16*)(ws + WS_MKV + (size_t)(2 * layer + 1) * MKV_ONE) + (size_t)b * MEML * 256 + hm * 64;
            u.Q = P + row0 * LDP + mq + hm * 64; u.K = MK; u.V = MV; u.pitch = 256; u.Z = P + row0 * LDP + zc; u.Y = Y + row0 * DM + (12 + hm) * 64; u.qb = qb; u.t_hi = 3; u.t_lo = 0;
        } else if (layer == 1) { int qb, b, h;
            if (idx < 512) { qb = 31 - idx / 16; b = (idx % 16) / 8; h = idx % 8; } else { const int k = idx - 512; qb = 31 - k / 8; b = (k % 8) / 4; h = 8 + k % 4; }
            mode = M_FOX;
            const size_t row0 = (size_t)b * SEQ + qb * 256; const bf16* Pb = P + (size_t)b * SEQ * LDP;
            u.Q = P + row0 * LDP + L1_CQ + h * 64; u.K = Pb + L1_CK + h * 64; u.V = Pb + L1_CV + h * 64; u.Z = P + row0 * LDP + L1_Z + h * 64; u.Y = Y + row0 * DM + h * 64;
            u.qb = qb; u.t_hi = 4 * qb + 3; u.t_lo = 0; u.lf = (const float*)(ws + WS_LOGF) + ((size_t)b * 12 + h) * SEQ;
        } else if (idx < 384) { const int qb = 31 - idx / 12, bh = idx % 12, b = bh / 6, hb = bh % 6; mode = M_MOBA;
            const size_t row0 = (size_t)b * SEQ + qb * 256; const bf16* Pb = P + (size_t)b * SEQ * LDP;
            u.Q = P + row0 * LDP + L0_BQ + hb * 64; u.K = Pb + L0_BK + hb * 64; u.V = Pb + L0_BV + hb * 64; u.Z = P + row0 * LDP + L0_Z + (6 + hb) * 64; u.Y = Y + row0 * DM + (6 + hb) * 64;
            u.qb = qb; u.t_hi = 4 * qb + 3; u.t_lo = 0; u.sl2 = alibi_slope2(6 + hb); u.kmean = (const float*)(ws + WS_KMEAN) + ((size_t)b * 6 + hb) * 32 * 64;
        } else { const int k = idx - 384, qb = k / 12, bh = k % 12, b = bh / 6, h = bh % 6, kvh = h / 3; mode = M_SWA;
            const size_t row0 = (size_t)b * SEQ + qb * 256; const bf16* Pb = P + (size_t)b * SEQ * LDP;
            u.Q = P + row0 * LDP + L0_AQ + h * 64; u.K = Pb + L0_AK + kvh * 64; u.V = Pb + L0_AV + kvh * 64; u.Z = P + row0 * LDP + L0_Z + h * 64; u.Y = Y + row0 * DM + h * 64;
            u.qb = qb; u.t_hi = 4 * qb + 3; u.t_lo = 4 * qb - 2 < 0 ? 0 : 4 * qb - 2; u.sl2 = alibi_slope2(h); u.sinkp = fexp2(LOG2E * a.in[5][h]);
        }
        if (mode == M_MEM) attn_unit<M_MEM>(u, lds); else if (mode == M_FOX) { if (ATT_PIPE) attn_unit_pipe<M_FOX>(u, lds); else attn_unit<M_FOX>(u, lds); } else if (mode == M_MOBA) { if (ATT_PIPE) attn_unit_pipe<M_MOBA>(u, lds); else attn_unit<M_MOBA>(u, lds); } else attn_unit<M_SWA>(u, lds);
    }
}
}
typedef GAS unsigned gu32;
#define RLX_AGENT __ATOMIC_RELAXED, __HIP_MEMORY_SCOPE_AGENT
#define XB_TMO      128
#define XB_XCNT(j)  (256  + 64 * (j))
#define XB_XSUB(j)  (1280 + 64 * (j))
#define XB_XGEN(j)  (2304 + 64 * (j))
#define XB_TOP      3328
#define XB_TOPGEN   3392
#define XCD_BAR_WORDS 3456
#define XB_SPIN_CAP (1u << 18)

__device__ __forceinline__ unsigned xb_ld(unsigned* p)              { return __hip_atomic_load(p, __ATOMIC_RELAXED, __HIP_MEMORY_SCOPE_AGENT); }
__device__ __forceinline__ unsigned xb_add(unsigned* p, unsigned v) { return __hip_atomic_fetch_add(p, v, __ATOMIC_RELAXED, __HIP_MEMORY_SCOPE_AGENT); }
__device__ __forceinline__ unsigned xb_xcc_id() { return (unsigned)__builtin_amdgcn_s_getreg((3 << 11) | 20) & 0xFu; }
#define XB_SPIN(cond, bar) do { unsigned _sp = 0; while (cond) { __builtin_amdgcn_s_sleep(1); \
    if ((++_sp & 255u) == 0u) { if (xb_ld(&(bar)[XB_TMO])) break; if (_sp > XB_SPIN_CAP) { atomicAdd(&(bar)[XB_TMO], 1u); break; } } } } while (0)

struct XcdBarrier {
    unsigned* bar; unsigned x;
    volatile LAS unsigned* st;
};

__device__ __forceinline__ XcdBarrier xcd_barrier_post(unsigned* bar, volatile LAS unsigned* st) {
    XcdBarrier b; b.bar = bar; b.x = xb_xcc_id(); b.st = st;
    if (threadIdx.x == 0) (void)xb_add(&bar[XB_XCNT(b.x)], 1u);
    return b;
}
__device__ __forceinline__ void xcd_barrier_complete(unsigned* bar, unsigned x, unsigned& nloc, unsigned& nx) {
    const unsigned G = gridDim.x * gridDim.y * gridDim.z;
    unsigned sum, cnt, mine, sp = 0u;
    for (;;) {
        sum = 0u; cnt = 0u; mine = 0u;
#pragma unroll
        for (unsigned j = 0; j < 16; ++j) { const unsigned c = xb_ld(&bar[XB_XCNT(j)]); sum += c; cnt += (c > 0u) ? 1u : 0u; mine = (j == x) ? c : mine; }
        if (sum == G) break;
        __builtin_amdgcn_s_sleep(1);
        if ((++sp & 255u) == 0u) { if (xb_ld(&bar[XB_TMO])) break; if (sp > XB_SPIN_CAP) { atomicAdd(&bar[XB_TMO], 1u); break; } }
    }
    nloc = mine > 0u ? mine : 1u; nx = cnt > 0u ? cnt : 1u;
}

__device__ __forceinline__ void xcd_barrier(const XcdBarrier& b) {
    asm volatile("s_waitcnt vmcnt(0)" ::: "memory");
    __syncthreads();
    if (threadIdx.x == 0) {
        unsigned* bar = b.bar;
        __builtin_amdgcn_s_waitcnt(0);
        unsigned nloc = b.st[0], nx = b.st[1];
        if (nloc == 0u) { xcd_barrier_complete(bar, b.x, nloc, nx); b.st[0] = nloc; b.st[1] = nx; }
        const unsigned old = xb_add(&bar[XB_XSUB(b.x)], 1u);
        const unsigned gen = old / nloc;
        if (old + 1u == (gen + 1u) * nloc) {
            __builtin_amdgcn_fence(__ATOMIC_RELEASE, "agent");
            asm volatile("s_waitcnt vmcnt(0)" ::: "memory");
            const unsigned og = xb_add(&bar[XB_TOP], 1u);
            const unsigned tg = og / nx;
            if (og + 1u == (tg + 1u) * nx) xb_add(&bar[XB_TOPGEN], 1u);
            else XB_SPIN(xb_ld(&bar[XB_TOPGEN]) == tg, bar);
            __builtin_amdgcn_fence(__ATOMIC_ACQUIRE, "agent");
            xb_add(&bar[XB_XGEN(b.x)], 1u);
            asm volatile("s_waitcnt vmcnt(0)" ::: "memory");
        } else {
            XB_SPIN(xb_ld(&bar[XB_XGEN(b.x)]) == gen, bar);
            __builtin_amdgcn_fence(__ATOMIC_ACQUIRE, "agent");
            asm volatile("s_waitcnt vmcnt(0)" ::: "memory");
        }
    }
    __syncthreads();
}
constexpr int CW_ZDONE = 9216;
namespace pg8 {
struct OneUnit { int pm, pn;
    __device__ __forceinline__ bool next(int i, Unit& u) const { if (i) return false; u.pm = pm; u.pn = pn; return true; }
    __device__ __forceinline__ void a_ready(const Unit&) const {}
    __device__ __forceinline__ void done(const Unit&) const {} };
}
__device__ __forceinline__ void cf_item(const Args& a, int item, LAS unsigned char* lds) {
    const int tid = threadIdx.x, lane = tid & 63, fr = lane & 15, fq = lane >> 4, wid = tid >> 6;
    const bf16* XB = (const bf16*)(a.ws + WS_XB); const bf16* W = (const bf16*)(a.ws + WS_WIN1) + (size_t)3584 * DM; const float* SS = (const float*)(a.ws + WS_SS1); float* logf2 = (float*)(a.ws + WS_LOGF);
    const int row0 = item * 64, k0 = wid * 128 + 8 * fq;
    const bf16* wp = W + (size_t)fr * DM + k0; const bf16* xp = XB + (size_t)(row0 + fr) * DM + k0;
    bf16x8 wf[4], xf[4][4];
#pragma unroll
    for (int ks = 0; ks < 4; ++ks) { wf[ks] = *(const bf16x8*)(wp + 32 * ks);
#pragma unroll
        for (int g = 0; g < 4; ++g) xf[g][ks] = *(const bf16x8*)(xp + (size_t)(16 * g) * DM + 32 * ks); }
    f32x4 acc[4];
#pragma unroll
    for (int g = 0; g < 4; ++g) { acc[g] = (f32x4){0.f, 0.f, 0.f, 0.f};
#pragma unroll
        for (int ks = 0; ks < 4; ++ks) acc[g] = __builtin_amdgcn_mfma_f32_16x16x32_bf16(wf[ks], xf[g][ks], acc[g], 0, 0, 0); }
    LAS float* part = (LAS float*)lds;
#pragma unroll
    for (int g = 0; g < 4; ++g) *(LAS f32x4*)(part + (wid * 64 + 16 * g + fr) * 16 + 4 * fq) = acc[g];
    __syncthreads();
    { const int r = tid >> 3, n0 = (tid & 7) * 2;
      float v0 = 0.f, v1 = 0.f;
#pragma unroll
      for (int w = 0; w < 8; ++w) { v0 += part[(w * 64 + r) * 16 + n0]; v1 += part[(w * 64 + r) * 16 + n0 + 1]; }
      const int row = row0 + r; float ss = 0.f;
#pragma unroll
      for (int q = 0; q < 4; ++q) { const f32x4 sp = *(const f32x4*)(SS + (size_t)row * 16 + 4 * q); ss += (sp[0] + sp[1]) + (sp[2] + sp[3]); }
      const float rstd = rsqrtf(ss * (1.f / DM) + EPS); const int b = row / SEQ, t = row % SEQ;
      if (n0 < 12) { logf2[((size_t)b * 12 + n0) * SEQ + t] = logsig2(v0 * rstd + a.in[12][n0]); logf2[((size_t)b * 12 + n0 + 1) * SEQ + t] = logsig2(v1 * rstd + a.in[12][n0 + 1]); } }
    __syncthreads();
}

#ifndef PROBE_REP
#define PROBE_REP -1
#endif
#ifndef MK_ONE_LAUNCH
#define MK_ONE_LAUNCH 1
#endif
constexpr int NPHASE = 9;
constexpr int LDS_BYTES = 147456;
constexpr int LDSCTL_OFF = 135168;
constexpr int CW_BAR = 4096;
constexpr int CW_Q0 = 64, CW_Q1 = 128, CW_Q0B = 192;
constexpr int CW_MCNT = 8192;
constexpr size_t WS_SLAB = 200 * MiB;
constexpr size_t WS_END2 = 250 * MiB;
constexpr size_t DO_MLIST = 0, DO_SLABL = 8 * MiB;
__global__ void __launch_bounds__(512, 2) mk_fwd(Args a) {
    extern __shared__ __attribute__((aligned(16))) unsigned char lds_raw[];
    LAS unsigned char* lds = (LAS unsigned char*)lds_raw;
    const int G = gridDim.x, bx = blockIdx.x; const int vcu = (G % 8 == 0) ? (bx % 8) * (G / 8) + bx / 8 : bx;
    unsigned char* ws = a.ws; unsigned* ctl = (unsigned*)(ws + WS_CTL);
    bf16* XB = (bf16*)(ws + WS_XB); bf16* P = (bf16*)(ws + WS_P); bf16* Y = (bf16*)(ws + WS_Y);
    float* kmean = (float*)(ws + WS_KMEAN); float* logf2 = (float*)(ws + WS_LOGF); float* SS0 = (float*)(ws + WS_SS0); float* SS1 = (float*)(ws + WS_SS1);
    const att::MobaBufs mb{ctl + CW_MCNT, (unsigned short*)((unsigned char*)a.out + DO_MLIST), (bf16*)(ws + WS_SLAB), (float*)((unsigned char*)a.out + DO_SLABL)};
    volatile LAS unsigned* MISC = (volatile LAS unsigned*)(lds + LDSCTL_OFF);
    if (threadIdx.x < 64) MISC[threadIdx.x] = 0u;
    __syncthreads();
    XcdBarrier bar; bar.bar = ctl + CW_BAR; bar.x = 0; bar.st = nullptr;
    if (MK_ONE_LAUNCH) bar = xcd_barrier_post(ctl + CW_BAR, MISC + 8);
#define IN(k) (a.ph_lo <= (k) && (k) < a.ph_hi)
#define SEAM(k) do { if (MK_ONE_LAUNCH && IN(k) && IN((k) + 1)) xcd_barrier(bar); } while (0)
#define PH_PRO() do { if (IN(0)) phase_prologue(a, lds, vcu, G); SEAM(0); } while (0)
#define PH_IN0() do { if (IN(1)) { pg8::Gemm g{XB, (const bf16*)(ws + WS_WIN0), T, N0, DM}; pg8::StaticOrder S; S.init(T, N0, G, bx); \
        pg8::EpiProj E{0, P, SS0, a.in[4], nullptr, kmean, logf2}; pg8::gemm_phase<pg8::EpiProj, pg8::StaticOrder, true, true>(lds, g, S, E); } SEAM(1); } while (0)
#define PH_A0A(q) do { if (IN(2)) att::attn_phase(0, a, lds, ctl + (q), mb); } while (0)
#define PH_A0B(q) do { if (MOBA_GATHER) { if (IN(3)) att::moba_kv_phase(a, mb, lds, ctl + (q)); SEAM(3); } } while (0)
#define PH_A0C() do { if (MOBA_GATHER) { if (IN(4)) att::moba_combine(a, mb, vcu, G); SEAM(4); } } while (0)
#define PH_OUT0() do { if (IN(5)) { pg8::Gemm g{Y, (const bf16*)(ws + WS_WOUT0), T, DM, DM}; pg8::StaticOrder S; S.init(T, DM, G, bx); \
        pg8::EpiOut0 E{a.in[0], XB, SS1}; pg8::gemm_phase<pg8::EpiOut0, pg8::StaticOrder, true, true>(lds, g, S, E); } SEAM(5); } while (0)
#define PH_IN1() do { if (IN(6)) { pg8::Gemm g{XB, (const bf16*)(ws + WS_WIN1), T, 3072, DM}; pg8::StaticOrder S; S.init(T, 3072, G, bx); \
        pg8::EpiProj E{1, P, SS1, a.in[11], a.in[12], kmean, logf2}; pg8::gemm_phase<pg8::EpiProj, pg8::StaticOrder, true, true>(lds, g, S, E); \
        for (int it = vcu; it < T / 64; it += G) cf_item(a, it, lds); } SEAM(6); } while (0)
#define PH_A1(q) do { if (IN(7)) { for (int zi = vcu; zi < 128; zi += G) {         \
            pg8::Gemm g{XB, (const bf16*)(ws + WS_WIN1), T, N1, DM}; pg8::OneUnit S{zi >> 1, 12 + (zi & 1)}; \
            pg8::EpiProj E{1, P, SS1, a.in[11], a.in[12], kmean, logf2}; pg8::gemm_phase<pg8::EpiProj, pg8::OneUnit, true, true>(lds, g, S, E); \
            asm volatile("s_waitcnt vmcnt(0)" ::: "memory"); __syncthreads(); \
            if (threadIdx.x == 0) { __builtin_amdgcn_fence(__ATOMIC_RELEASE, "agent"); asm volatile("s_waitcnt vmcnt(0)" ::: "memory"); __hip_atomic_fetch_add(ctl + CW_ZDONE, 1u, __ATOMIC_RELAXED, __HIP_MEMORY_SCOPE_AGENT); } } \
        att::attn_phase(1, a, lds, ctl + (q), mb); } SEAM(7); } while (0)
#define PH_OUT1() do { if (IN(8)) { pg8::Gemm g{Y, (const bf16*)(ws + WS_WOUT1), T, DM, DM}; pg8::StaticOrder S; S.init(T, DM, G, bx); \
        pg8::EpiOut1 E{XB, a.out}; pg8::gemm_phase<pg8::EpiOut1, pg8::StaticOrder, true, true>(lds, g, S, E); } } while (0)
    PH_PRO();
#if PROBE_REP == 0
    PH_PRO();
#endif
    PH_IN0();
#if PROBE_REP == 1
    PH_IN0();
#endif
    PH_A0A(CW_Q0);
    PH_A0B(CW_Q0B);
#if PROBE_REP == 3
    PH_A0B(CW_Q0B + 256);
#endif
    PH_A0C();
#if PROBE_REP == 4
    PH_A0C();
#endif
#if PROBE_REP == 5
    PH_OUT0();
#endif
    PH_OUT0();
    PH_IN1();
#if PROBE_REP == 6
    PH_IN1();
#endif
    PH_A1(CW_Q1);
#if PROBE_REP == 7
    PH_A1(CW_Q1 + 256);
#endif
    PH_OUT1();
#undef IN
#undef SEAM
}

extern "C" void kernel_launch(void* const* d_in, const int* in_sizes, int n_in, void* d_out, int out_size, void* d_ws, size_t ws_size, hipStream_t stream) {
    static int grid = 0;
    if (grid == 0) {
        if (n_in != 16 || out_size != T * DM || ws_size < WS_END2) { fprintf(stderr, "kernel_launch: unexpected shapes (n_in %d out %d ws %zu)\n", n_in, out_size, ws_size); grid = -1; return; }
        int dev = 0, cus = 0, per_cu = 0;
        (void)hipGetDevice(&dev); (void)hipDeviceGetAttribute(&cus, hipDeviceAttributeMultiprocessorCount, dev);
        (void)hipFuncSetAttribute((const void*)mk_fwd, hipFuncAttributeMaxDynamicSharedMemorySize, LDS_BYTES);
        (void)hipOccupancyMaxActiveBlocksPerMultiprocessor(&per_cu, (const void*)mk_fwd, 512, LDS_BYTES);
        (void)hipGetLastError();
        grid = cus * (per_cu >= 1 ? 1 : 0); if (grid <= 0) { fprintf(stderr, "kernel_launch: occupancy query says 0 workgroups per CU\n"); grid = -1; return; }
    }
    if (grid < 0) return;
    unsigned char* ws = (unsigned char*)d_ws;
    (void)hipMemsetAsync(ws + WS_CTL, 0, CTL_ZERO_BYTES, stream);
    Args a{}; for (int i = 0; i < 16; ++i) a.in[i] = (const float*)d_in[i];
    a.out = (float*)d_out; a.ws = ws;
#define RUN(lo, hi) do { a.ph_lo = (lo); a.ph_hi = (hi); hipLaunchKernelGGL(mk_fwd, dim3(grid), dim3(512), LDS_BYTES, stream, a); } while (0)
    if (MK_ONE_LAUNCH) RUN(0, NPHASE);
    else { for (int k = 0; k < NPHASE; ++k) RUN(k, k + 1); }
#undef RUN
}
```

```cpp
#include <hip/hip_runtime.h>
#include <cstdint>
#include <cstdio>

#define GAS __attribute__((address_space(1)))
#define LAS __attribute__((address_space(3)))
typedef unsigned short bf16;
typedef unsigned v4u __attribute__((ext_vector_type(4)));
typedef unsigned u32x4 __attribute__((ext_vector_type(4)));
typedef unsigned v2u __attribute__((ext_vector_type(2)));
typedef float f32x4 __attribute__((ext_vector_type(4)));
typedef float f32x16 __attribute__((ext_vector_type(16)));
typedef short bf16x8 __attribute__((ext_vector_type(8)));

constexpr int BATCH = 2, SEQ = 8192, T = BATCH * SEQ, DM = 1024, HD = 64, MEML = 256;
constexpr int N0 = 3072;
constexpr int N1REF = 3596;
constexpr int N1 = 3840;
constexpr int LDP = 3584;
constexpr float EPS = 1e-6f;
constexpr float LOG2E = 1.4426950408889634f;
constexpr float C2 = 0.125f * LOG2E;
constexpr int L0_AQ = 0, L0_AK = 384, L0_AV = 512, L0_BQ = 640, L0_BK = 1024, L0_BV = 1408, L0_MQ = 1792, L0_Z = 2048;
constexpr int L1_CQ = 0, L1_CK = 768, L1_CV = 1536, L1_MQ = 2304, L1_Z = 2560, L1_CF = 3584;

constexpr size_t MiB = 1u << 20;
constexpr size_t WS_CTL = 0, CTL_ZERO_BYTES = 1 * MiB;
constexpr size_t WS_KMEAN = 512 * 1024;
constexpr size_t WS_WIN0 = 2 * MiB, WS_WOUT0 = 8 * MiB, WS_WIN1 = 10 * MiB, WS_WOUT1 = 18 * MiB;
constexpr size_t WS_SS0 = 20 * MiB, WS_SS1 = 21 * MiB;
constexpr size_t WS_LOGF = 22 * MiB;
constexpr size_t WS_MKV = 23 * MiB;
constexpr size_t MKV_ONE = (size_t)BATCH * MEML * 256 * 2;
constexpr size_t WS_XB = 24 * MiB;
constexpr size_t WS_P = 56 * MiB;
constexpr size_t WS_Y = 168 * MiB;
constexpr size_t WS_END = 200 * MiB;

__device__ __forceinline__ float bf2f(bf16 v) { return __uint_as_float((unsigned)v << 16); }
__device__ __forceinline__ unsigned f2bf(float f) { unsigned u = __float_as_uint(f); return (u + 0x7fffu + ((u >> 16) & 1u)) >> 16; }
__device__ __forceinline__ unsigned pk2(float lo, float hi) { return f2bf(lo) | (f2bf(hi) << 16); }
__device__ __forceinline__ float wave_sum(float v) {
#pragma unroll
    for (int o = 1; o < 64; o <<= 1) v += __shfl_xor(v, o);
    return v;
}
__device__ __forceinline__ float fexp2(float x) { return __builtin_amdgcn_exp2f(x); }
__device__ __forceinline__ float silu_f(float z) { return z * __builtin_amdgcn_rcpf(1.f + __builtin_amdgcn_exp2f(-LOG2E * z)); }
__device__ __forceinline__ float logsig2(float f) { return LOG2E * (fminf(f, 0.f) - log1pf(__expf(-fabsf(f)))); }
__device__ __forceinline__ float alibi_slope2(int h) { return LOG2E * exp2f(-8.0f * (float)(h + 1) / 12.0f); }

struct Args {
    const float* in[16]; float* out; unsigned char* ws; int ph_lo, ph_hi;
};
enum { HK_QNORM = 0, HK_KNORM = 1, HK_PLAIN = 2, HK_SILU = 3, HK_BK = 4, HK_CF = 5, HK_NONE = 6 };
struct HeadInfo { int kind; int gidx; int dstcol; };
__device__ __forceinline__ HeadInfo head_info(int layer, int hh) {
    HeadInfo h; h.dstcol = hh * 64; h.gidx = 0;
    if (layer == 0) {
        if (hh < 6) { h.kind = HK_QNORM; h.gidx = 0; } else if (hh < 8) { h.kind = HK_KNORM; h.gidx = 1; } else if (hh < 10) h.kind = HK_PLAIN;
        else if (hh < 16) { h.kind = HK_QNORM; h.gidx = 2; } else if (hh < 22) { h.kind = HK_BK; h.gidx = 3; } else if (hh < 28) h.kind = HK_PLAIN;
        else if (hh < 32) { h.kind = HK_QNORM; h.gidx = 4; } else h.kind = HK_SILU;
    } else {
        if (hh < 12) { h.kind = HK_QNORM; h.gidx = 0; } else if (hh < 24) { h.kind = HK_KNORM; h.gidx = 1; } else if (hh < 36) h.kind = HK_PLAIN;
        else if (hh < 40) { h.kind = HK_QNORM; h.gidx = 2; } else if (hh < 56) h.kind = HK_SILU; else if (hh == 56) h.kind = HK_CF; else h.kind = HK_NONE;
    }
    return h;
}

constexpr int PRO_NW = 8;

__device__ __forceinline__ int l1_refcol(int n) {
    if (n < 2304) return n;
    if (n < 3584) return n + 12;
    if (n < 3596) return n - 3584 + 2304;
    return -1;
}
__device__ __forceinline__ void pro_transpose_item(const float* W, const float* g, int K, int Nref, int nblk, bf16* WT, bool remap, LAS float* scr, int item, int lane) {
    const int kb = item / nblk, nb = item % nblk, k0 = 64 * kb, n0 = 32 * nb;
    const int np = n0 + (lane & 31); const int rc = remap ? l1_refcol(np) : np;
    float wv[32];
#pragma unroll
    for (int i = 0; i < 32; ++i) { const int kk = 2 * i + (lane >> 5); wv[i] = (rc >= 0) ? __builtin_nontemporal_load(W + (size_t)(k0 + kk) * Nref + rc) : 0.f; }
    const float gl = g ? g[k0 + (lane & 63)] : 1.f;
#pragma unroll
    for (int i = 0; i < 32; ++i) { const int kk = 2 * i + (lane >> 5); const float gk = __shfl(gl, kk); scr[kk * 33 + (lane & 31)] = wv[i] * gk; }
    asm volatile("s_waitcnt lgkmcnt(0)" ::: "memory");
    const int c = lane & 7;
#pragma unroll
    for (int j = 0; j < 4; ++j) { const int n = (lane >> 3) + 8 * j; const LAS float* s = scr + (8 * c) * 33 + n;
        v4u o; o.x = pk2(s[0 * 33], s[1 * 33]); o.y = pk2(s[2 * 33], s[3 * 33]); o.z = pk2(s[4 * 33], s[5 * 33]); o.w = pk2(s[6 * 33], s[7 * 33]);
        *(v4u*)(WT + (size_t)(n0 + n) * K + k0 + 8 * c) = o; }
    asm volatile("s_waitcnt lgkmcnt(0)" ::: "memory");
}
__device__ __forceinline__ void pro_row(const float* xrow, bf16* orow, float* ssrow, int lane) {
    const f32x4* xr = (const f32x4*)xrow + lane; f32x4 v[4]; float s = 0.f;
#pragma unroll
    for (int j = 0; j < 4; ++j) { v[j] = xr[64 * j]; s += (v[j].x * v[j].x + v[j].y * v[j].y) + (v[j].z * v[j].z + v[j].w * v[j].w); }
    s = wave_sum(s);
    v2u* o8 = (v2u*)orow + lane;
#pragma unroll
    for (int j = 0; j < 4; ++j) { v2u w; w.x = pk2(v[j].x, v[j].y); w.y = pk2(v[j].z, v[j].w); o8[64 * j] = w; }
    if (lane < 16) ssrow[lane] = lane == 0 ? s : 0.f;
}
__device__ __forceinline__ void pro_memkv_task(const float* mem, const float* gm, const float* W, const float* kg, bf16* MK, bf16* MV, int rt, int ct, LAS unsigned char* lds) {
    const int tid = threadIdx.x, lane = tid & 63, w = tid >> 6, r32 = lane & 31, hi = lane >> 5;
    LAS float* part = (LAS float*)lds; LAS float* rs = (LAS float*)(lds + 133120);
    for (int i = 0; i < 8; ++i) { const int row = rt * 64 + 8 * w + i; const f32x4* xr = (const f32x4*)(mem + (size_t)row * DM) + lane; float s = 0.f;
#pragma unroll
        for (int j = 0; j < 4; ++j) { const f32x4 v = xr[64 * j]; s += (v.x * v.x + v.y * v.y) + (v.z * v.z + v.w * v.w); }
        s = wave_sum(s); if (lane == 0) rs[8 * w + i] = rsqrtf(s * (1.f / DM) + EPS); }
    f32x16 acc[2][2];
#pragma unroll
    for (int a = 0; a < 2; ++a)
#pragma unroll
        for (int b = 0; b < 2; ++b) acc[a][b] = f32x16{};
    for (int ks = 0; ks < 8; ++ks) { const int k0 = 128 * w + 16 * ks + 8 * hi;
        bf16x8 wf[2], hf[2];
#pragma unroll
        for (int cb = 0; cb < 2; ++cb) { const float* wp = W + (size_t)k0 * 512 + ct * 64 + 32 * cb + r32;
#pragma unroll
            for (int j = 0; j < 8; ++j) wf[cb][j] = (short)f2bf(wp[(size_t)j * 512]); }
        const f32x4 g0 = *(const f32x4*)(gm + k0), g1 = *(const f32x4*)(gm + k0 + 4);
#pragma unroll
        for (int ra = 0; ra < 2; ++ra) { const float* mp = mem + (size_t)(rt * 64 + 32 * ra + r32) * DM + k0; const f32x4 a0 = *(const f32x4*)mp, a1 = *(const f32x4*)(mp + 4);
            hf[ra][0] = (short)f2bf(a0.x * g0.x); hf[ra][1] = (short)f2bf(a0.y * g0.y); hf[ra][2] = (short)f2bf(a0.z * g0.z); hf[ra][3] = (short)f2bf(a0.w * g0.w);
            hf[ra][4] = (short)f2bf(a1.x * g1.x); hf[ra][5] = (short)f2bf(a1.y * g1.y); hf[ra][6] = (short)f2bf(a1.z * g1.z); hf[ra][7] = (short)f2bf(a1.w * g1.w); }
#pragma unroll
        for (int cb = 0; cb < 2; ++cb)
#pragma unroll
            for (int ra = 0; ra < 2; ++ra) acc[cb][ra] = __builtin_amdgcn_mfma_f32_32x32x16_bf16(wf[cb], hf[ra], acc[cb][ra], 0, 0, 0);
    }
#pragma unroll
    for (int cb = 0; cb < 2; ++cb)
#pragma unroll
        for (int ra = 0; ra < 2; ++ra)
#pragma unroll
            for (int r = 0; r < 16; ++r) { const int n = 32 * cb + (r & 3) + 8 * (r >> 2) + 4 * hi; part[(w * 64 + 32 * ra + r32) * 65 + n] = acc[cb][ra][r]; }
    __syncthreads();
    { const int tok = tid >> 3, c0 = (tid & 7) * 8; float v[8];
#pragma unroll
      for (int i = 0; i < 8; ++i) v[i] = 0.f;
      for (int ww = 0; ww < 8; ++ww) {
#pragma unroll
          for (int i = 0; i < 8; ++i) v[i] += part[(ww * 64 + tok) * 65 + c0 + i]; }
      const float r = rs[tok]; float ss = 0.f;
#pragma unroll
      for (int i = 0; i < 8; ++i) { v[i] *= r; ss += v[i] * v[i]; }
      ss += __shfl_xor(ss, 1); ss += __shfl_xor(ss, 2); ss += __shfl_xor(ss, 4);
      const int row = rt * 64 + tok;
      bf16* dst;
      if (ct < 4) { const float inv = rsqrtf(ss * (1.f / 64.f) + EPS);
#pragma unroll
          for (int i = 0; i < 8; ++i) v[i] *= inv * kg[c0 + i];
          dst = MK + (size_t)row * 256 + ct * 64 + c0; }
      else dst = MV + (size_t)row * 256 + (ct - 4) * 64 + c0;
      v4u o; o.x = pk2(v[0], v[1]); o.y = pk2(v[2], v[3]); o.z = pk2(v[4], v[5]); o.w = pk2(v[6], v[7]); *(v4u*)dst = o; }
    __syncthreads();
}

__device__ __forceinline__ void phase_prologue(const Args& a, LAS unsigned char* lds, int vcu, int G) {
    const int tid = threadIdx.x, lane = tid & 63, wave = __builtin_amdgcn_readfirstlane(tid >> 6);
    unsigned char* ws = a.ws;
    for (int wt = (G - 1 - vcu); wt < 128; wt += G) { const int layer = wt >> 6, rt = (wt >> 3) & 7, ct = wt & 7;
        const float* gm = layer ? a.in[13] : a.in[6]; const float* W = layer ? a.in[14] : a.in[7];
        const float* kg = layer ? a.in[11] + 3 * 64 : a.in[4] + 5 * 64;
        bf16* MK = (bf16*)(ws + WS_MKV + (size_t)(2 * layer) * MKV_ONE); bf16* MV = (bf16*)(ws + WS_MKV + (size_t)(2 * layer + 1) * MKV_ONE);
        pro_memkv_task(a.in[1], gm, W, kg, MK, MV, rt, ct, lds); }
    LAS float* scr = (LAS float*)(lds + wave * 16384);
    const int gw = vcu * PRO_NW + wave, NGW = G * PRO_NW;
    constexpr int I_IN0 = 16 * (N0 / 32), I_OUT = 16 * (DM / 32), I_IN1 = 16 * (N1 / 32);
    constexpr int NITEMS = I_IN0 + I_OUT + I_IN1 + I_OUT;
    for (int it = gw; it < NITEMS; it += NGW) { int r = it;
        if (r < I_IN0) { pro_transpose_item(a.in[3], a.in[2], DM, N0, N0 / 32, (bf16*)(ws + WS_WIN0), false, scr, r, lane); continue; } r -= I_IN0;
        if (r < I_OUT) { pro_transpose_item(a.in[8], nullptr, DM, DM, DM / 32, (bf16*)(ws + WS_WOUT0), false, scr, r, lane); continue; } r -= I_OUT;
        if (r < I_IN1) { pro_transpose_item(a.in[10], a.in[9], DM, N1REF, N1 / 32, (bf16*)(ws + WS_WIN1), true, scr, r, lane); continue; } r -= I_IN1;
        pro_transpose_item(a.in[15], nullptr, DM, DM, DM / 32, (bf16*)(ws + WS_WOUT1), false, scr, r, lane); }
    const float* x = a.in[0]; bf16* XB = (bf16*)(ws + WS_XB); float* SS0 = (float*)(ws + WS_SS0);
    for (int m0 = gw * 4; m0 < T; m0 += NGW * 4) {
        f32x4 v[4][4];
#pragma unroll
        for (int r = 0; r < 4; ++r) { const f32x4* xr = (const f32x4*)(x + (size_t)(m0 + r) * DM) + lane;
#pragma unroll
            for (int j = 0; j < 4; ++j) v[r][j] = __builtin_nontemporal_load(xr + 64 * j); }
#pragma unroll
        for (int r = 0; r < 4; ++r) { float sq = 0.f;
#pragma unroll
            for (int j = 0; j < 4; ++j) sq += (v[r][j].x * v[r][j].x + v[r][j].y * v[r][j].y) + (v[r][j].z * v[r][j].z + v[r][j].w * v[r][j].w);
            sq = wave_sum(sq); v2u* o8 = (v2u*)(XB + (size_t)(m0 + r) * DM) + lane;
#pragma unroll
            for (int j = 0; j < 4; ++j) { v2u w; w.x = pk2(v[r][j].x, v[r][j].y); w.y = pk2(v[r][j].z, v[r][j].w); o8[64 * j] = w; }
            if (lane < 16) SS0[(size_t)(m0 + r) * 16 + lane] = lane == 0 ? sq : 0.f; } }
}
namespace pg8 {
#define PG8_LAS __attribute__((address_space(3)))
typedef unsigned short bf16_t;
typedef short bf16x8 __attribute__((ext_vector_type(8)));
typedef float f32x4 __attribute__((ext_vector_type(4)));
typedef unsigned u32x4 __attribute__((ext_vector_type(4)));
constexpr int BM = 256, BK = 64, HALF = 128, HTB = HALF * BK * 2  , STAGE_BYTES = 8 * HTB, NXCD = 8, WGM = 8;

__host__ __device__ __forceinline__ int lds_byte(int r, int c) { const int st = (r >> 4) * 2 + (c >> 5), rr = r & 15, cc = c & 31, ob = rr * 64 + cc * 2; return st * 1024 + (ob ^ (((ob >> 9) & 1) << 5)); }
__host__ __device__ __forceinline__ void stage_rc(int b, int& R, int& C) { const int st = b / 1024, sb = b % 1024, swz = sb ^ (((sb >> 9) & 1) << 5); R = (st >> 1) * 16 + swz / 64; C = (st & 1) * 32 + (swz % 64) / 2; }
__host__ __device__ __forceinline__ int perm32(int rho) { const int n = rho >> 4, i = rho & 15; return 8 * (i >> 2) + 4 * n + (i & 3); }

struct Unit { int pm, pn; };
struct Gemm { const bf16_t* A; const bf16_t* Bt; int M, N, K; };

struct StaticOrder {
    int nM, nN, nwg, G, c;
    __host__ __device__ void init(int M, int N, int G_, int c_) { nM = M / BM; nN = N / BM; nwg = nM * nN; G = G_; c = c_; }
    __host__ __device__ bool next(int i, Unit& u) const {
        const long L = (long)i * G + c; if (L >= nwg) return false;
        int wgid = (int)L; { const int q = nwg / NXCD, r = nwg % NXCD, xcd = wgid % NXCD, off = wgid / NXCD; wgid = (xcd < r ? xcd * (q + 1) : r * (q + 1) + (xcd - r) * q) + off; }
        const int nig = WGM * nN, gid = wgid / nig, fm = gid * WGM, gsz = (nM - fm) < WGM ? (nM - fm) : WGM;
        u.pm = fm + ((wgid % nig) % gsz); u.pn = (wgid % nig) / gsz; return true;
    }
    __device__ __forceinline__ void a_ready(const Unit&) const {}
    __device__ __forceinline__ void done(const Unit&) const {}
};
template <class Epi, class Sched, bool ALIGN_EPI = false, bool SP2 = false>
__device__ __forceinline__ void gemm_phase(PG8_LAS unsigned char* lds, const Gemm g, const Sched& S, const Epi& E) {
    const int tid = threadIdx.x, wid = __builtin_amdgcn_readfirstlane(tid >> 6), lane = tid & 63, wr = wid >> 2, wc = wid & 3, fr = lane & 15, fq = lane >> 4;
    const int K = g.K, nt = K / BK;
    unsigned voffA[2], voffB[2];
#pragma unroll
    for (int i = 0; i < 2; ++i) { int R, C; stage_rc(tid * 16 + i * 8192, R, C); const int Rb = 64 * (R >> 5) + perm32(R & 31);
        voffA[i] = (unsigned)(R * K + C) * 2u; voffB[i] = (unsigned)(Rb * K + C) * 2u; }
    const size_t kstep = (size_t)(BK * 2);
    const size_t hstep = (size_t)HALF * K * 2;
    const size_t hstepB = (size_t)32 * K * 2;
    const size_t tstep = 2 * hstep;
    const unsigned ldsw = (unsigned)wid * 1024u;
    const int aoff = lds_byte(wr * 64 + fr, fq * 8), boff = lds_byte(wc * 32 + fr, fq * 8);
#define PG8_SA(b, h) (((b) * 2 + (h)) * HTB)
#define PG8_SB(b, h) ((4 + (b) * 2 + (h)) * HTB)
#define PG8_STAGE(bufoff, gbase, voff) do { _Pragma("unroll") for (int _i = 0; _i < 2; ++_i) \
        __builtin_amdgcn_global_load_lds((const unsigned*)((const char*)(gbase) + (voff)[_i]), (PG8_LAS unsigned*)(lds + (bufoff) + ldsw + _i * 8192), 16, 0, 0); } while (0)
#define PG8_LDA(dst, b, h) do { _Pragma("unroll") for (int m = 0; m < 4; ++m) _Pragma("unroll") for (int k = 0; k < 2; ++k) dst[m][k] = *(const PG8_LAS bf16x8*)(lds + PG8_SA(b, h) + aoff + m * 2048 + k * 1024); } while (0)
#define PG8_LDB(dst, b, h) do { _Pragma("unroll") for (int n = 0; n < 2; ++n) _Pragma("unroll") for (int k = 0; k < 2; ++k) dst[n][k] = *(const PG8_LAS bf16x8*)(lds + PG8_SB(b, h) + boff + n * 2048 + k * 1024); } while (0)
#define PG8_MMA(ai, bj, At, Bt) do { __builtin_amdgcn_s_setprio(1); _Pragma("unroll") for (int m = 0; m < 4; ++m) _Pragma("unroll") for (int n = 0; n < 2; ++n) _Pragma("unroll") for (int k = 0; k < 2; ++k) \
        acc[ai][bj][m][n] = __builtin_amdgcn_mfma_f32_16x16x32_bf16(Bt[n][k], At[m][k], acc[ai][bj][m][n], 0, 0, 0); __builtin_amdgcn_s_setprio(0); } while (0)
#define PG8_WAIT_V(n) asm volatile("s_waitcnt vmcnt(" #n ")" ::: "memory")
#define PG8_WAIT_L(n) asm volatile("s_waitcnt lgkmcnt(" #n ")" ::: "memory")
#define PG8_BAR __builtin_amdgcn_s_barrier()
#define PG8_SCHED __builtin_amdgcn_sched_barrier(0)
    Unit cur, nxt; int ui = 0;
    if (!S.next(0, cur)) return;
    f32x4 acc[2][2][4][2];
#pragma unroll
    for (int a = 0; a < 2; ++a)
#pragma unroll
        for (int b = 0; b < 2; ++b)
#pragma unroll
            for (int m = 0; m < 4; ++m)
#pragma unroll
                for (int n = 0; n < 2; ++n) acc[a][b][m][n] = (f32x4){0.f, 0.f, 0.f, 0.f};
    bf16x8 At[4][2], B0[2][2], B1[2][2];
    const char* cA = (const char*)g.A + (size_t)cur.pm * tstep; const char* cB = (const char*)g.Bt + (size_t)cur.pn * tstep;
    S.a_ready(cur);
    if constexpr (SP2) {
        PG8_STAGE(PG8_SB(0, 0), cB, voffB); PG8_STAGE(PG8_SB(0, 1), cB + hstepB, voffB); PG8_STAGE(PG8_SA(0, 0), cA, voffA); PG8_STAGE(PG8_SA(0, 1), cA + hstep, voffA);
        if (wr == 1) PG8_BAR;
        PG8_WAIT_V(2); PG8_BAR;
        PG8_STAGE(PG8_SB(1, 0), cB + kstep, voffB); PG8_STAGE(PG8_SA(1, 0), cA + kstep, voffA); PG8_STAGE(PG8_SB(1, 1), cB + hstepB + kstep, voffB);
        PG8_WAIT_V(6); PG8_BAR;
    } else {
        PG8_STAGE(PG8_SB(0, 0), cB, voffB); PG8_STAGE(PG8_SA(0, 0), cA, voffA); PG8_STAGE(PG8_SB(0, 1), cB + hstepB, voffB); PG8_STAGE(PG8_SA(0, 1), cA + hstep, voffA);
        if (wr == 1) PG8_BAR;
        PG8_WAIT_V(4); PG8_BAR;
        PG8_STAGE(PG8_SB(1, 0), cB + kstep, voffB); PG8_STAGE(PG8_SA(1, 0), cA + kstep, voffA); PG8_STAGE(PG8_SB(1, 1), cB + hstepB + kstep, voffB);
        PG8_WAIT_V(6); PG8_BAR;
    }
    for (;;) {
        const bool has_next = S.next(ui + 1, nxt);
        const char* nA = has_next ? (const char*)g.A + (size_t)nxt.pm * tstep : cA; const char* nB = has_next ? (const char*)g.Bt + (size_t)nxt.pn * tstep : cB;
        for (int t = 0; t < nt; t += 2) {
            const bool last = (t == nt - 2);
            const char* a1 = cA + (size_t)(t + 1) * kstep;
            const char* a2 = last ? nA : cA + (size_t)(t + 2) * kstep; const char* b2 = last ? nB : cB + (size_t)(t + 2) * kstep;
            const char* a3 = a2 + kstep; const char* b3 = b2 + kstep;
            if (last && has_next) S.a_ready(nxt);
            if constexpr (SP2) {
            PG8_LDB(B0, 0, 0); PG8_LDB(B1, 0, 1); PG8_SCHED; PG8_LDA(At, 0, 0); PG8_STAGE(PG8_SA(1, 1), a1 + hstep, voffA);
            PG8_WAIT_V(8); PG8_WAIT_L(0); PG8_BAR; PG8_MMA(0, 0, At, B0); PG8_MMA(0, 1, At, B1); PG8_BAR; PG8_SCHED;
            PG8_LDA(At, 0, 1); PG8_STAGE(PG8_SB(0, 0), b2, voffB); PG8_STAGE(PG8_SB(0, 1), b2 + hstepB, voffB); PG8_STAGE(PG8_SA(0, 0), a2, voffA);
            PG8_WAIT_V(8); PG8_WAIT_L(0); PG8_BAR; PG8_MMA(1, 0, At, B0); PG8_MMA(1, 1, At, B1); PG8_BAR; PG8_SCHED;
            PG8_LDB(B0, 1, 0); PG8_LDB(B1, 1, 1); PG8_SCHED; PG8_LDA(At, 1, 0); PG8_STAGE(PG8_SA(0, 1), a2 + hstep, voffA);
            PG8_WAIT_V(8); PG8_WAIT_L(0); PG8_BAR; PG8_MMA(0, 0, At, B0); PG8_MMA(0, 1, At, B1); PG8_BAR; PG8_SCHED;
            PG8_LDA(At, 1, 1); PG8_STAGE(PG8_SB(1, 0), b3, voffB); PG8_STAGE(PG8_SB(1, 1), b3 + hstepB, voffB); PG8_STAGE(PG8_SA(1, 0), a3, voffA);
            PG8_WAIT_V(8); PG8_WAIT_L(0); PG8_BAR; PG8_MMA(1, 0, At, B0); PG8_MMA(1, 1, At, B1); PG8_BAR; PG8_SCHED;
            } else {
            PG8_LDB(B0, 0, 0); PG8_SCHED; PG8_LDA(At, 0, 0); PG8_STAGE(PG8_SA(1, 1), a1 + hstep, voffA);
            PG8_WAIT_L(8); PG8_BAR; PG8_WAIT_L(0); PG8_MMA(0, 0, At, B0); PG8_BAR; PG8_SCHED;
            PG8_LDB(B1, 0, 1); PG8_STAGE(PG8_SB(0, 0), b2, voffB);
            PG8_BAR; PG8_WAIT_L(0); PG8_MMA(0, 1, At, B1); PG8_BAR;
            PG8_LDA(At, 0, 1); PG8_STAGE(PG8_SA(0, 0), a2, voffA);
            PG8_BAR; PG8_WAIT_L(0); PG8_MMA(1, 0, At, B0); PG8_BAR; PG8_SCHED;
            PG8_STAGE(PG8_SB(0, 1), b2 + hstepB, voffB);
            PG8_WAIT_V(6); PG8_BAR; PG8_MMA(1, 1, At, B1); PG8_BAR;
            PG8_LDB(B0, 1, 0); PG8_SCHED; PG8_LDA(At, 1, 0); PG8_STAGE(PG8_SA(0, 1), a2 + hstep, voffA);
            PG8_WAIT_L(8); PG8_BAR; PG8_WAIT_L(0); PG8_MMA(0, 0, At, B0); PG8_BAR; PG8_SCHED;
            PG8_LDB(B1, 1, 1); PG8_STAGE(PG8_SB(1, 0), b3, voffB);
            PG8_BAR; PG8_WAIT_L(0); PG8_MMA(0, 1, At, B1); PG8_BAR;
            PG8_LDA(At, 1, 1); PG8_STAGE(PG8_SA(1, 0), a3, voffA);
            PG8_BAR; PG8_WAIT_L(0); PG8_MMA(1, 0, At, B0); PG8_BAR; PG8_SCHED;
            PG8_STAGE(PG8_SB(1, 1), b3 + hstepB, voffB);
            PG8_WAIT_V(6); PG8_BAR; PG8_MMA(1, 1, At, B1); PG8_BAR;
            }
        }
        if constexpr (ALIGN_EPI) { if (wr == 0) PG8_BAR; }
        if constexpr (!Epi::AFTER_DRAIN) { E(acc, cur, wr, wc, fr, fq); S.done(cur); }
        if (!has_next) break;
#pragma unroll
        for (int a = 0; a < 2; ++a)
#pragma unroll
            for (int b = 0; b < 2; ++b)
#pragma unroll
                for (int m = 0; m < 4; ++m)
#pragma unroll
                    for (int n = 0; n < 2; ++n) acc[a][b][m][n] = (f32x4){0.f, 0.f, 0.f, 0.f};
        cur = nxt; cA = nA; cB = nB; ++ui;
        if constexpr (ALIGN_EPI) { if (wr == 1) PG8_BAR; }
    }
    PG8_WAIT_V(0);
    if constexpr (!ALIGN_EPI) { if (wr == 0) PG8_BAR; }
    PG8_BAR;
    if constexpr (Epi::AFTER_DRAIN) { E.fused(acc, cur, wr, wc, fr, fq, lds, wid, lane); S.done(cur); }
#undef PG8_SA
#undef PG8_SB
#undef PG8_STAGE
#undef PG8_LDA
#undef PG8_LDB
#undef PG8_MMA
#undef PG8_WAIT_V
#undef PG8_WAIT_L
#undef PG8_BAR
#undef PG8_SCHED
}
}
namespace pg8 {
__device__ __forceinline__ unsigned cvt_pk_bf16(float lo, float hi) { unsigned r; asm volatile("v_cvt_pk_bf16_f32 %0, %1, %2" : "=v"(r) : "v"(lo), "v"(hi)); return r; }

struct EpiProj {
    static constexpr bool AFTER_DRAIN = false;
    int layer; bf16* P; const float* SS; const float* qkg; const float* bfp; float* kmean; float* logf2;
    __device__ __forceinline__ void operator()(const f32x4 (&acc)[2][2][4][2], const Unit& u, int wr, int wc, int fr, int fq) const {
        const int hh = u.pn * 4 + wc; const HeadInfo hi = head_info(layer, hh);
        if (hi.kind == HK_NONE) return;
        const bool norm = (hi.kind == HK_QNORM || hi.kind == HK_KNORM || hi.kind == HK_BK);
        f32x4 gv[2][2];
#pragma unroll
        for (int bj = 0; bj < 2; ++bj)
#pragma unroll
            for (int n = 0; n < 2; ++n) gv[bj][n] = norm ? *(const f32x4*)(qkg + hi.gidx * 64 + 32 * bj + 8 * fq + 4 * n) : (f32x4){1.f, 1.f, 1.f, 1.f};
        const float qs = (hi.kind == HK_QNORM) ? C2 : 1.f;
        f32x4 ksum[2][2];
#pragma unroll
        for (int bj = 0; bj < 2; ++bj)
#pragma unroll
            for (int n = 0; n < 2; ++n) ksum[bj][n] = (f32x4){0.f, 0.f, 0.f, 0.f};
#pragma unroll
        for (int ai = 0; ai < 2; ++ai)
#pragma unroll
            for (int m = 0; m < 4; ++m) {
                const int row = u.pm * BM + ai * HALF + wr * 64 + m * 16 + fr;
                const f32x4 sp = *(const f32x4*)(SS + (size_t)row * 16 + 4 * fq);
                float ss = (sp[0] + sp[1]) + (sp[2] + sp[3]); ss += __shfl_xor(ss, 16); ss += __shfl_xor(ss, 32);
                const float rstd = rsqrtf(ss * (1.f / DM) + EPS);
                f32x4 v[2][2];
#pragma unroll
                for (int bj = 0; bj < 2; ++bj)
#pragma unroll
                    for (int n = 0; n < 2; ++n) v[bj][n] = acc[ai][bj][m][n] * rstd;
                if (hi.kind == HK_CF) {
                    const int b = row / SEQ, t = row % SEQ;
                    if (fq < 2) {
#pragma unroll
                        for (int n = 0; n < 2; ++n) if (fq == 0 || n == 0) {
#pragma unroll
                            for (int e = 0; e < 4; ++e) { const int c = 8 * fq + 4 * n + e; logf2[((size_t)b * 12 + c) * SEQ + t] = logsig2(v[0][n][e] + bfp[c]); } } }
                    continue;
                }
                if (norm) { float q = 0.f;
#pragma unroll
                    for (int bj = 0; bj < 2; ++bj)
#pragma unroll
                        for (int n = 0; n < 2; ++n) q += (v[bj][n][0] * v[bj][n][0] + v[bj][n][1] * v[bj][n][1]) + (v[bj][n][2] * v[bj][n][2] + v[bj][n][3] * v[bj][n][3]);
                    q += __shfl_xor(q, 16); q += __shfl_xor(q, 32);
                    const float inv = rsqrtf(q * (1.f / 64.f) + EPS) * qs;
#pragma unroll
                    for (int bj = 0; bj < 2; ++bj)
#pragma unroll
                        for (int n = 0; n < 2; ++n) v[bj][n] = v[bj][n] * gv[bj][n] * inv; }
                if (hi.kind == HK_SILU) {
#pragma unroll
                    for (int bj = 0; bj < 2; ++bj)
#pragma unroll
                        for (int n = 0; n < 2; ++n)
#pragma unroll
                            for (int e = 0; e < 4; ++e) v[bj][n][e] = silu_f(v[bj][n][e]); }
                if (hi.kind == HK_BK) {
#pragma unroll
                    for (int bj = 0; bj < 2; ++bj)
#pragma unroll
                        for (int n = 0; n < 2; ++n) ksum[bj][n] += v[bj][n]; }
                bf16* rowp = P + (size_t)row * LDP + hi.dstcol + 8 * fq;
#pragma unroll
                for (int bj = 0; bj < 2; ++bj) { u32x4 w; w.x = cvt_pk_bf16(v[bj][0][0], v[bj][0][1]); w.y = cvt_pk_bf16(v[bj][0][2], v[bj][0][3]); w.z = cvt_pk_bf16(v[bj][1][0], v[bj][1][1]); w.w = cvt_pk_bf16(v[bj][1][2], v[bj][1][3]);
                    *(u32x4*)(rowp + 32 * bj) = w; }
            }
        if (hi.kind == HK_BK) {
            const int b = u.pm / 32, blk = u.pm % 32, h = hh - 16; float* kp = kmean + (((size_t)b * 6 + h) * 32 + blk) * 64 + 8 * fq;
#pragma unroll
            for (int bj = 0; bj < 2; ++bj)
#pragma unroll
                for (int n = 0; n < 2; ++n)
#pragma unroll
                    for (int e = 0; e < 4; ++e) { float s = ksum[bj][n][e]; s += __shfl_xor(s, 1); s += __shfl_xor(s, 2); s += __shfl_xor(s, 4); s += __shfl_xor(s, 8);
                        if (fr == 0) atomicAdd(kp + 32 * bj + 4 * n + e, s); }
        }
    }
};

struct EpiOut0 {
    static constexpr bool AFTER_DRAIN = false;
    const float* xin; bf16* XB; float* SS;
    __device__ __forceinline__ void operator()(const f32x4 (&acc)[2][2][4][2], const Unit& u, int wr, int wc, int fr, int fq) const {
#pragma unroll
        for (int ai = 0; ai < 2; ++ai)
#pragma unroll
            for (int m = 0; m < 4; ++m) {
                const int row = u.pm * BM + ai * HALF + wr * 64 + m * 16 + fr; const size_t off = (size_t)row * DM + u.pn * BM + 64 * wc + 8 * fq; float ss = 0.f;
#pragma unroll
                for (int bj = 0; bj < 2; ++bj) {
                    const f32x4 x0 = __builtin_nontemporal_load((const f32x4*)(xin + off + 32 * bj)) + acc[ai][bj][m][0], x1 = __builtin_nontemporal_load((const f32x4*)(xin + off + 32 * bj + 4)) + acc[ai][bj][m][1];
                    ss += (x0[0] * x0[0] + x0[1] * x0[1]) + (x0[2] * x0[2] + x0[3] * x0[3]) + (x1[0] * x1[0] + x1[1] * x1[1]) + (x1[2] * x1[2] + x1[3] * x1[3]);
                    u32x4 w; w.x = cvt_pk_bf16(x0[0], x0[1]); w.y = cvt_pk_bf16(x0[2], x0[3]); w.z = cvt_pk_bf16(x1[0], x1[1]); w.w = cvt_pk_bf16(x1[2], x1[3]); *(u32x4*)(XB + off + 32 * bj) = w;
                }
                ss += __shfl_xor(ss, 16); ss += __shfl_xor(ss, 32); if (fq == 0) SS[(size_t)row * 16 + u.pn * 4 + wc] = ss;
            }
    }
};
struct EpiOut1 {
    static constexpr bool AFTER_DRAIN = false;
    const bf16* XB; float* xout;
    __device__ __forceinline__ void operator()(const f32x4 (&acc)[2][2][4][2], const Unit& u, int wr, int wc, int fr, int fq) const {
#pragma unroll
        for (int ai = 0; ai < 2; ++ai)
#pragma unroll
            for (int m = 0; m < 4; ++m) {
                const int row = u.pm * BM + ai * HALF + wr * 64 + m * 16 + fr; const size_t off = (size_t)row * DM + u.pn * BM + 64 * wc + 8 * fq;
#pragma unroll
                for (int bj = 0; bj < 2; ++bj) { const u32x4 w = *(const u32x4*)(XB + off + 32 * bj);
                    f32x4 x0, x1; x0[0] = __uint_as_float(w.x << 16); x0[1] = __uint_as_float(w.x & 0xffff0000u); x0[2] = __uint_as_float(w.y << 16); x0[3] = __uint_as_float(w.y & 0xffff0000u);
                    x1[0] = __uint_as_float(w.z << 16); x1[1] = __uint_as_float(w.z & 0xffff0000u); x1[2] = __uint_as_float(w.w << 16); x1[3] = __uint_as_float(w.w & 0xffff0000u);
                    __builtin_nontemporal_store(x0 + acc[ai][bj][m][0], (f32x4*)(xout + off + 32 * bj)); __builtin_nontemporal_store(x1 + acc[ai][bj][m][1], (f32x4*)(xout + off + 32 * bj + 4)); }
            }
    }
};
}
namespace att {
typedef LAS const char* lds_cptr;
typedef short s16x4 __attribute__((ext_vector_type(4)));
typedef short v4i16_t __attribute__((ext_vector_type(4)));
enum { M_SWA = 0, M_MOBA = 1, M_FOX = 2, M_MEM = 3 };
constexpr int SLOTB = 8192, LDS_K = 0, LDS_V = 3 * SLOTB, LDS_WS = 6 * SLOTB, WSB = 2048, LDS_OST = LDS_WS + 8 * WSB, LDS_END = LDS_OST + 8 * 4096;

__device__ __forceinline__ int crow(int r, int hi) { return (r & 3) + 8 * (r >> 2) + 4 * hi; }
__device__ __forceinline__ void glds16(const void* g, unsigned lds_base) {
    unsigned sv; asm volatile("s_mov_b32 %0, m0\n\ts_mov_b32 m0, %2\n\ts_nop 0\n\tglobal_load_lds_dwordx4 %1, off\n\ts_mov_b32 m0, %0" : "=&s"(sv) : "v"(g), "s"(lds_base) : "memory"); }
__device__ __forceinline__ void glds4(const void* g, unsigned lds_base) {
    unsigned sv; asm volatile("s_mov_b32 %0, m0\n\ts_mov_b32 m0, %2\n\ts_nop 0\n\tglobal_load_lds_dword %1, off\n\ts_mov_b32 m0, %0" : "=&s"(sv) : "v"(g), "s"(lds_base) : "memory"); }
__device__ __forceinline__ s16x4 vtr(lds_cptr p) { return __builtin_bit_cast(s16x4, __builtin_amdgcn_ds_read_tr16_b64_v4i16((LAS v4i16_t*)p)); }
__device__ __forceinline__ unsigned cvtpk(float lo, float hi) { typedef float f2 __attribute__((ext_vector_type(2))); typedef __bf16 b2 __attribute__((ext_vector_type(2))); f2 v = {lo, hi}; b2 b = __builtin_convertvector(v, b2); return __builtin_bit_cast(unsigned, b); }
#define ATT_MFMA(a, b, c) __builtin_amdgcn_mfma_f32_32x32x16_bf16(a, b, c, 0, 0, 0)
#define ATT_WAIT_BAR(N) asm volatile("s_waitcnt vmcnt(" #N ") lgkmcnt(0)\n\ts_barrier" ::: "memory")
#define ATT_RFL(x) ((unsigned)__builtin_amdgcn_readfirstlane((int)(x)))

struct UnitP {
    const bf16* Q;
    const bf16* K; const bf16* V; int pitch;
    const bf16* Z; bf16* Y;
    int qb, t_hi, t_lo;
    float sl2, sinkp, thr2;
    const float* lf; const float* kmean;
    unsigned* qctr; LAS unsigned* qw;
};

template <int MODE> __device__ __forceinline__ void attn_epilogue(const UnitP& u, LAS unsigned char* shm, const f32x16& o0, const f32x16& o1, float l) {
    const int tid = threadIdx.x, lane = tid & 63, r32 = lane & 31, hi = lane >> 5; const int wid = __builtin_amdgcn_readfirstlane(tid >> 6);
    LAS float* wsf = (LAS float*)(shm + LDS_WS + wid * WSB);
    unsigned nxt = 0u; if (tid == 0) nxt = __hip_atomic_fetch_add(u.qctr, 1u, __ATOMIC_RELAXED, __HIP_MEMORY_SCOPE_AGENT);
    const int orow = lane >> 1, oh = lane & 1;
    u32x4 zz[2][2];
#pragma unroll
    for (int d0 = 0; d0 < 2; ++d0) { const bf16* zp = u.Z + (size_t)(wid * 32 + orow) * LDP + 32 * d0 + 16 * oh; zz[d0][0] = *(const u32x4*)zp; zz[d0][1] = *(const u32x4*)(zp + 8); }
    l += __shfl_xor(l, 32); if (MODE == M_SWA) l += u.sinkp;
    if (hi == 0) wsf[r32] = 1.f / l;
    asm volatile("s_waitcnt lgkmcnt(0)" ::: "memory");
    float rl[16];
#pragma unroll
    for (int r = 0; r < 16; ++r) rl[r] = wsf[crow(r, hi)];
    LAS float* ost = (LAS float*)(shm + LDS_OST + wid * 4096);
#pragma unroll
    for (int d0 = 0; d0 < 2; ++d0) {
#pragma unroll
        for (int r = 0; r < 16; ++r) ost[crow(r, hi) * 32 + r32] = (d0 == 0 ? o0[r] : o1[r]) * rl[r];
        asm volatile("s_waitcnt lgkmcnt(0)" ::: "memory");
        f32x4 ov[4];
#pragma unroll
        for (int j = 0; j < 4; ++j) ov[j] = *(const LAS f32x4*)(ost + orow * 32 + 16 * oh + 4 * j);
        const u32x4 z0 = zz[d0][0], z1 = zz[d0][1];
        u32x4 y0, y1;
#pragma unroll
        for (int j = 0; j < 4; ++j) { const unsigned za = j < 2 ? z0[2 * j] : z1[2 * (j - 2)], zb = j < 2 ? z0[2 * j + 1] : z1[2 * (j - 2) + 1];
            const unsigned w0 = cvtpk(ov[j][0] * __uint_as_float(za << 16), ov[j][1] * __uint_as_float(za & 0xffff0000u)), w1 = cvtpk(ov[j][2] * __uint_as_float(zb << 16), ov[j][3] * __uint_as_float(zb & 0xffff0000u));
            if (j < 2) { y0[2 * j] = w0; y0[2 * j + 1] = w1; } else { y1[2 * (j - 2)] = w0; y1[2 * (j - 2) + 1] = w1; } }
        bf16* yp = u.Y + (size_t)(wid * 32 + orow) * DM + 32 * d0 + 16 * oh;
        *(u32x4*)yp = y0; *(u32x4*)(yp + 8) = y1;
        asm volatile("s_waitcnt lgkmcnt(0)" ::: "memory");
    }
    if (tid == 0) *u.qw = nxt;
    asm volatile("s_waitcnt vmcnt(0) lgkmcnt(0)\n\ts_barrier" ::: "memory");
}

template <int MODE> __device__ __forceinline__ void attn_unit(const UnitP& u, LAS unsigned char* shm) {
    const int tid = threadIdx.x, lane = tid & 63, r32 = lane & 31, hi = lane >> 5; const int wid = __builtin_amdgcn_readfirstlane(tid >> 6);
    const unsigned lds0 = (unsigned)(size_t)shm;
    LAS float* wsf = (LAS float*)(shm + LDS_WS + wid * WSB);
    const int pitch = u.pitch;
    const bf16* ksrc = u.K + (size_t)lane * pitch + wid * 8;
    const bf16* vsrc = u.V + (size_t)(16 * (wid & 3) + (lane >> 2)) * pitch + (wid >> 2) * 32 + (lane & 3) * 8;
    const float* fsrc = u.lf + lane + 1;
    const unsigned kdst = lds0 + LDS_K + wid * 1024, vdst = lds0 + LDS_V + wid * 1024, fdst = lds0 + LDS_WS + wid * WSB;
    const int NT = u.t_hi - u.t_lo + 1;
#define ATT_DMA(i, slot) do { const int t_ = u.t_hi - (i); glds16(ksrc + (size_t)t_ * 64 * pitch, ATT_RFL(kdst + (slot) * SLOTB)); glds16(vsrc + (size_t)t_ * 64 * pitch, ATT_RFL(vdst + (slot) * SLOTB)); \
        if (MODE == M_FOX) glds4(fsrc + t_ * 64, ATT_RFL(fdst + (slot) * 256)); } while (0)
    ATT_DMA(0, 0); if (NT > 1) ATT_DMA(1, 1);
    bf16x8 qr[4];
    { const bf16* Qw = u.Q + (size_t)(wid * 32 + r32) * LDP + hi * 8;
#pragma unroll
      for (int d0 = 0; d0 < 4; ++d0) qr[d0] = *(const bf16x8*)(Qw + d0 * 16); }
    asm volatile("" : "+v"(qr[0]), "+v"(qr[1]), "+v"(qr[2]), "+v"(qr[3]));
    const int qrel = wid * 32 + r32, qpos = u.qb * 256 + qrel;
    float Eq = 0.f, Eq0 = 0.f, carry = 0.f;
    if (MODE == M_FOX) {
        const int q0 = u.qb * 256;
#pragma unroll 1
        for (int jb = 3; jb >= 0; --jb) { float w = u.lf[q0 + 64 * jb + lane + 1]; if (jb == 3 && lane == 63) w = 0.f;
#pragma unroll
            for (int d = 1; d < 64; d <<= 1) { const float o = __shfl_down(w, d); if (lane + d < 64) w += o; }
            w += carry; wsf[256 + 64 * jb + lane] = w; carry = __builtin_bit_cast(float, __builtin_amdgcn_readfirstlane(__builtin_bit_cast(int, w))); }
        asm volatile("s_waitcnt lgkmcnt(0)" ::: "memory");
        Eq = wsf[256 + qrel]; Eq0 = carry;
    }
    unsigned selmask = 0u;
    if (MODE == M_MOBA) { if (u.qb > 0) {
        f32x16 g = f32x16{}; const float* km = u.kmean + (size_t)r32 * 64 + hi * 8;
#pragma unroll
        for (int d0 = 0; d0 < 4; ++d0) { const f32x4 a0 = *(const f32x4*)(km + 16 * d0), a1 = *(const f32x4*)(km + 16 * d0 + 4); bf16x8 kh, kl;
#pragma unroll
            for (int j = 0; j < 4; ++j) { unsigned h0 = f2bf(a0[j]), h1 = f2bf(a1[j]); kh[j] = (short)h0; kh[j + 4] = (short)h1; kl[j] = (short)f2bf(a0[j] - bf2f((bf16)h0)); kl[j + 4] = (short)f2bf(a1[j] - bf2f((bf16)h1)); }
            g = ATT_MFMA(kh, qr[d0], g); g = ATT_MFMA(kl, qr[d0], g); }
#pragma unroll
        for (int r = 0; r < 16; ++r) if (crow(r, hi) >= u.qb) g[r] = -INFINITY;
#pragma unroll 1
        for (int it = 0; it < 3; ++it) { float bv = -INFINITY; int bj = 99;
#pragma unroll
            for (int r = 0; r < 16; ++r) if (g[r] > bv) { bv = g[r]; bj = crow(r, hi); }
            const float pv = __shfl_xor(bv, 32); const int pj = __shfl_xor(bj, 32);
            if (pv > bv || (pv == bv && pj < bj)) { bv = pv; bj = pj; }
            if (bv > -INFINITY) selmask |= 1u << (bj & 31);
#pragma unroll
            for (int r = 0; r < 16; ++r) if (crow(r, hi) == bj) g[r] = -INFINITY; }
    } }
    f32x16 o0 = f32x16{}, o1 = f32x16{}; float l = 0.f;
    int sl = 0;
    const lds_cptr shc = (lds_cptr)shm;
#pragma unroll 1
    for (int i = 0; i < NT; ++i) {
        if (i + 1 < NT) { if (MODE == M_FOX) ATT_WAIT_BAR(3); else ATT_WAIT_BAR(2); } else ATT_WAIT_BAR(0);
        if (i + 2 < NT) { const int s2 = sl == 0 ? 2 : sl - 1; ATT_DMA(i + 2, s2); }
        const int t = u.t_hi - i, jb = t - 4 * u.qb;
        bool active = true; int esrc = 192;
        if (MODE == M_FOX) {
            if (jb >= 0) esrc = 256 + 64 * jb;
            else { float w = wsf[sl * 64 + lane];
#pragma unroll
                for (int d = 1; d < 64; d <<= 1) { const float o = __shfl_down(w, d); if (lane + d < 64) w += o; }
                w += carry; const float etop = __builtin_bit_cast(float, __builtin_amdgcn_readlane(__builtin_bit_cast(int, w), 63));
                if (__builtin_amdgcn_readfirstlane((int)(etop - Eq0 < -u.thr2))) break;
                wsf[192 + lane] = w; carry = __builtin_bit_cast(float, __builtin_amdgcn_readfirstlane(__builtin_bit_cast(int, w))); }
        }
        if (MODE != M_MEM) { if (jb >= 0) active = (64 * jb <= wid * 32 + 31); }
        if (MODE == M_SWA) active = active && (64 * jb >= wid * 32 - 190);
        bool rowsel = true;
        if (MODE == M_MOBA) { if (jb < 0) { rowsel = (selmask >> (t >> 2)) & 1u; active = (__ballot(rowsel) != 0ull); } }
        if (active) {
            const lds_cptr kp = shc + LDS_K + sl * SLOTB + hi * 1024 + r32 * 16;
            bf16x8 kf[8];
#pragma unroll
            for (int d0 = 0; d0 < 4; ++d0) { kf[2 * d0] = *(const LAS bf16x8*)(kp + d0 * 2048); kf[2 * d0 + 1] = *(const LAS bf16x8*)(kp + d0 * 2048 + 512); }
            f32x16 p0, p1;
            if (MODE == M_MEM) { p0 = f32x16{}; p1 = f32x16{}; }
            else if (MODE == M_FOX) { asm volatile("s_waitcnt lgkmcnt(0)" ::: "memory");
#pragma unroll
                for (int g = 0; g < 4; ++g) { const f32x4 e0 = *(const LAS f32x4*)(wsf + esrc + 8 * g + 4 * hi), e1 = *(const LAS f32x4*)(wsf + esrc + 32 + 8 * g + 4 * hi);
#pragma unroll
                    for (int e = 0; e < 4; ++e) { p0[4 * g + e] = e0[e] - Eq; p1[4 * g + e] = e1[e] - Eq; } } }
            else { float base = u.sl2 * (float)(64 * t + 4 * hi - qpos); if (MODE == M_MOBA) { if (!rowsel) base = -INFINITY; }
#pragma unroll
                for (int r = 0; r < 16; ++r) { p0[r] = __builtin_fmaf(u.sl2, (float)((r & 3) + 8 * (r >> 2)), base); p1[r] = p0[r] + 32.f * u.sl2; } }
            p0 = ATT_MFMA(kf[0], qr[0], p0); p1 = ATT_MFMA(kf[1], qr[0], p1); p0 = ATT_MFMA(kf[2], qr[1], p0); p1 = ATT_MFMA(kf[3], qr[1], p1);
            p0 = ATT_MFMA(kf[4], qr[2], p0); p1 = ATT_MFMA(kf[5], qr[2], p1); p0 = ATT_MFMA(kf[6], qr[3], p0); p1 = ATT_MFMA(kf[7], qr[3], p1);
            if (MODE != M_MEM) { if (jb >= 0) { const int kb = 64 * jb + 4 * hi;
#pragma unroll
                for (int r = 0; r < 16; ++r) { const int kv = kb + (r & 3) + 8 * (r >> 2); if (kv > qrel) p0[r] = -INFINITY; if (kv + 32 > qrel) p1[r] = -INFINITY; } } }
            if (MODE == M_SWA) { const int kb = 64 * jb + 4 * hi;
#pragma unroll
                for (int r = 0; r < 16; ++r) { const int kv = kb + (r & 3) + 8 * (r >> 2); if (qrel - kv >= 128) p0[r] = -INFINITY; if (qrel - kv - 32 >= 128) p1[r] = -INFINITY; } }
#pragma unroll
            for (int r = 0; r < 16; ++r) { p0[r] = fexp2(p0[r]); p1[r] = fexp2(p1[r]); }
            float s = 0.f;
#pragma unroll
            for (int r = 0; r < 16; ++r) s += p0[r] + p1[r];
            l += s;
            u32x4 pw[4];
#pragma unroll
            for (int j = 0; j < 4; ++j) { pw[0][j] = cvtpk(p0[2 * j], p0[2 * j + 1]); pw[1][j] = cvtpk(p0[8 + 2 * j], p0[9 + 2 * j]); pw[2][j] = cvtpk(p1[2 * j], p1[2 * j + 1]); pw[3][j] = cvtpk(p1[8 + 2 * j], p1[9 + 2 * j]); }
            const lds_cptr vp = shc + LDS_V + sl * SLOTB + ((lane >> 4) & 1) * 32 + (lane & 3) * 8 + (4 * hi + ((lane & 15) >> 2)) * 64;
#pragma unroll
            for (int ks = 0; ks < 4; ++ks) { const s16x4 a = vtr(vp + ks * 1024), b = vtr(vp + ks * 1024 + 512), c = vtr(vp + 4096 + ks * 1024), d = vtr(vp + 4096 + ks * 1024 + 512);
                const bf16x8 v0 = (bf16x8){a[0], a[1], a[2], a[3], b[0], b[1], b[2], b[3]}, v1 = (bf16x8){c[0], c[1], c[2], c[3], d[0], d[1], d[2], d[3]};
                o0 = ATT_MFMA(__builtin_bit_cast(bf16x8, pw[ks]), v0, o0); o1 = ATT_MFMA(__builtin_bit_cast(bf16x8, pw[ks]), v1, o1); }
        }
        sl = (sl == 2) ? 0 : sl + 1;
    }
    asm volatile("s_waitcnt vmcnt(0) lgkmcnt(0)" ::: "memory");
    attn_epilogue<MODE>(u, shm, o0, o1, l);
#undef ATT_DMA
}
}
namespace att {
#define AP_PIN(x) asm volatile("" : "+v"(x))
#define AP_SBAR() __builtin_amdgcn_sched_barrier(0)
#define AP_PKW(P, i) cvtpk(P[i], P[i + 1])
#define AP_PAF(w) __builtin_bit_cast(bf16x8, w)
#define AP_VF(a, b) (bf16x8){a[0], a[1], a[2], a[3], b[0], b[1], b[2], b[3]}

__device__ __forceinline__ float dpp_prefix_sum64(float v) {
    int x = __builtin_bit_cast(int, v);
#define AP_DPP_ADD(ctrl, rmask) { const int t_ = __builtin_amdgcn_update_dpp(0, x, ctrl, rmask, 0xf, false); x = __builtin_bit_cast(int, __builtin_bit_cast(float, x) + __builtin_bit_cast(float, t_)); }
    AP_DPP_ADD(0x111, 0xf) AP_DPP_ADD(0x112, 0xf) AP_DPP_ADD(0x114, 0xf) AP_DPP_ADD(0x118, 0xf)
    AP_DPP_ADD(0x142, 0xa)
    AP_DPP_ADD(0x143, 0xc)
#undef AP_DPP_ADD
    return __builtin_bit_cast(float, x);
}

template <int MODE> __device__ __forceinline__ void attn_unit_pipe(const UnitP& u, LAS unsigned char* shm) {
    static_assert(MODE == M_FOX, "pipelined body: FoX units");
    const int tid = threadIdx.x, lane = tid & 63, r32 = lane & 31, hi = lane >> 5; const int wid = __builtin_amdgcn_readfirstlane(tid >> 6);
    const unsigned lds0 = (unsigned)(size_t)shm;
    LAS float* wsf = (LAS float*)(shm + LDS_WS + wid * WSB);
    const bf16* ksrc = u.K + (size_t)lane * LDP + wid * 8;
    const bf16* vsrc = u.V + (size_t)(16 * (wid & 3) + (lane >> 2)) * LDP + (wid >> 2) * 32 + (lane & 3) * 8;
    const float* fsrc = u.lf + lane + 1;
    const unsigned kdst = lds0 + LDS_K + wid * 1024, vdst = lds0 + LDS_V + wid * 1024, fdst = lds0 + LDS_WS + wid * WSB;
    const int NT = u.t_hi + 1;
#define AP_TILE(i) ((i) < NT ? u.t_hi - (i) : 0)
#define AP_DMA_K(i, so) glds16(ksrc + (size_t)AP_TILE(i) * 64 * LDP, ATT_RFL(kdst + (so)))
#define AP_DMA_V(i, so) glds16(vsrc + (size_t)AP_TILE(i) * 64 * LDP, ATT_RFL(vdst + (so)))
#define AP_DMA_F(i, so) do { if (MODE == M_FOX) glds4(fsrc + AP_TILE(i) * 64, ATT_RFL(fdst + ((so) >> 5))); } while (0)
    AP_DMA_K(0, 0); AP_DMA_V(0, 0); AP_DMA_F(0, 0); AP_DMA_K(1, SLOTB); AP_DMA_F(1, SLOTB); AP_DMA_K(2, 2 * SLOTB); AP_DMA_F(2, 2 * SLOTB);
    bf16x8 qr[4];
    { const bf16* Qw = u.Q + (size_t)(wid * 32 + r32) * LDP + hi * 8;
#pragma unroll
      for (int d0 = 0; d0 < 4; ++d0) qr[d0] = *(const bf16x8*)(Qw + d0 * 16); }
    float w4[4];
#pragma unroll
    for (int jb = 0; jb < 4; ++jb) w4[jb] = u.lf[u.qb * 256 + 64 * jb + (63 - lane) + 1];
    asm volatile("" : "+v"(qr[0]), "+v"(qr[1]), "+v"(qr[2]), "+v"(qr[3]), "+v"(w4[0]), "+v"(w4[1]), "+v"(w4[2]), "+v"(w4[3]));
    const int qrel = wid * 32 + r32, qpos = u.qb * 256 + qrel;
    float Eq = 0.f, Eq0 = 0.f, carry = 0.f;
    if (MODE == M_FOX) {
        if (lane == 0) w4[3] = 0.f;
#pragma unroll
        for (int jb = 3; jb >= 0; --jb) { float w = dpp_prefix_sum64(w4[jb]) + carry; wsf[256 + 64 * jb + (63 - lane)] = w; carry = __builtin_bit_cast(float, __builtin_amdgcn_readlane(__builtin_bit_cast(int, w), 63)); }
        asm volatile("s_waitcnt lgkmcnt(0)" ::: "memory");
        Eq = wsf[256 + qrel]; Eq0 = carry;
    }
    const unsigned limb = (unsigned)__builtin_amdgcn_readfirstlane(__builtin_bit_cast(int, Eq0 - u.thr2));
#define AP_SPLIT3(x, hb, mb, lb) do { hb = __float_as_uint(x); const float r1_ = (x) - __uint_as_float(hb & 0xffff0000u); mb = __float_as_uint(r1_); lb = __float_as_uint(r1_ - __uint_as_float(mb & 0xffff0000u)); } while (0)
#define AP_EB(e, AB) do { unsigned hb_, mb_, lb_; AP_SPLIT3(e, hb_, mb_, lb_); AB[0] = (hb_ >> 16) | (mb_ & 0xffff0000u); AB[1] = (lb_ >> 16) | 0x3f800000u; } while (0)
#define AP_EREAD(I, e0, e1) do { const int jb2_ = u.t_hi - (I) - 4 * u.qb; const LAS float* ep_ = wsf + (jb2_ >= 0 ? 256 + 64 * jb2_ : 192) + r32; e0 = ep_[0]; e1 = ep_[32]; } while (0)
    u32x4 ab0 = (u32x4){0u, 0u, 0x3f803f80u, 0u}, ab1 = (u32x4){0u, 0u, 0x3f803f80u, 0u}; bf16x8 bb;
    { unsigned hb_, mb_, lb_; const float ne_ = -Eq; AP_SPLIT3(ne_, hb_, mb_, lb_); u32x4 w_ = (u32x4){0x3f803f80u, 0x00003f80u | (hb_ & 0xffff0000u), (mb_ >> 16) | (lb_ & 0xffff0000u), 0u};
      if (hi) w_ = (u32x4){0u, 0u, 0u, 0u}; bb = AP_PAF(w_); }
    unsigned selmask = 0u;
    if (MODE == M_MOBA) { if (u.qb > 0) {
        f32x16 g = f32x16{}; const float* km = u.kmean + (size_t)r32 * 64 + hi * 8;
#pragma unroll
        for (int d0 = 0; d0 < 4; ++d0) { const f32x4 a0 = *(const f32x4*)(km + 16 * d0), a1 = *(const f32x4*)(km + 16 * d0 + 4); bf16x8 kh, kl;
#pragma unroll
            for (int j = 0; j < 4; ++j) { unsigned h0 = f2bf(a0[j]), h1 = f2bf(a1[j]); kh[j] = (short)h0; kh[j + 4] = (short)h1; kl[j] = (short)f2bf(a0[j] - bf2f((bf16)h0)); kl[j + 4] = (short)f2bf(a1[j] - bf2f((bf16)h1)); }
            g = ATT_MFMA(kh, qr[d0], g); g = ATT_MFMA(kl, qr[d0], g); }
#pragma unroll
        for (int r = 0; r < 16; ++r) if (crow(r, hi) >= u.qb) g[r] = -INFINITY;
#pragma unroll 1
        for (int it = 0; it < 3; ++it) { float bv = -INFINITY; int bj = 99;
#pragma unroll
            for (int r = 0; r < 16; ++r) if (g[r] > bv) { bv = g[r]; bj = crow(r, hi); }
            const float pv = __shfl_xor(bv, 32); const int pj = __shfl_xor(bj, 32);
            if (pv > bv || (pv == bv && pj < bj)) { bv = pv; bj = pj; }
            if (bv > -INFINITY) selmask |= 1u << (bj & 31);
#pragma unroll
            for (int r = 0; r < 16; ++r) if (crow(r, hi) == bj) g[r] = -INFINITY; }
    } }
    const lds_cptr shc = (lds_cptr)shm;
    const lds_cptr kp0 = shc + LDS_K + hi * 1024 + r32 * 16;
    const lds_cptr vp0 = shc + LDS_V + ((lane >> 4) & 1) * 32 + (lane & 3) * 8 + (4 * hi + ((lane & 15) >> 2)) * 64;
#define AP_CINIT4(X, b, p1, I) do { const int ti_ = u.t_hi - (I); \
        if (MODE == M_FOX) { const int jb2_ = ti_ - 4 * u.qb; const int es_ = jb2_ >= 0 ? 256 + 64 * jb2_ : 192; const f32x4 e_ = *(const LAS f32x4*)(wsf + es_ + ((p1) ? 32 : 0) + 2 * (b) + 4 * hi); \
            X[(b)] = e_[0] - Eq; X[(b) + 1] = e_[1] - Eq; X[(b) + 2] = e_[2] - Eq; X[(b) + 3] = e_[3] - Eq; } \
        else { float base_ = u.sl2 * (float)(64 * ti_ + 4 * hi - qpos + ((p1) ? 32 : 0)); if (ti_ < 4 * u.qb) { if (!((selmask >> (ti_ >> 2)) & 1u)) base_ = -INFINITY; } \
            X[(b)] = __builtin_fmaf(u.sl2, (float)(2 * (b)), base_); X[(b) + 1] = __builtin_fmaf(u.sl2, (float)(2 * (b) + 1), base_); X[(b) + 2] = __builtin_fmaf(u.sl2, (float)(2 * (b) + 2), base_); X[(b) + 3] = __builtin_fmaf(u.sl2, (float)(2 * (b) + 3), base_); } } while (0)
#define AP_CMASK(C0, C1, I) do { const int jbm_ = u.t_hi - (I) - 4 * u.qb; if (jbm_ >= 0) { const int kb_ = 64 * jbm_ + 4 * hi; \
        _Pragma("unroll") for (int r = 0; r < 16; ++r) { const int kv_ = kb_ + (r & 3) + 8 * (r >> 2); if (kv_ > qrel) C0[r] = -INFINITY; if (kv_ + 32 > qrel) C1[r] = -INFINITY; } } } while (0)
    f32x16 pA0, pA1, pB0, pB1, o0 = f32x16{}, o1 = f32x16{}; float l = 0.f;
    bf16x8 kf[8]; u32x4 pw0, pw1, pw2, pw3;
    int so_prev = 0, so_cur = 0, so_n1 = SLOTB, so_n2 = 2 * SLOTB;
#define AP_ROT() do { so_prev = so_cur; so_cur = so_n1; so_n1 = so_n2; so_n2 = so_prev; } while (0)
    bool last = false;
    asm volatile("s_waitcnt vmcnt(0) lgkmcnt(0)\n\ts_barrier" ::: "memory");
    { float e0_, e1_; AP_EREAD(0, e0_, e1_); AP_EB(e0_, ab0); AP_EB(e1_, ab1); }
    pA0 = ATT_MFMA(AP_PAF(ab0), bb, f32x16{}); pA1 = ATT_MFMA(AP_PAF(ab1), bb, f32x16{});
#pragma unroll
    for (int d0 = 0; d0 < 4; ++d0) { kf[2 * d0] = *(const LAS bf16x8*)(kp0 + d0 * 2048); kf[2 * d0 + 1] = *(const LAS bf16x8*)(kp0 + d0 * 2048 + 512); }
    pA0 = ATT_MFMA(kf[0], qr[0], pA0); pA1 = ATT_MFMA(kf[1], qr[0], pA1); pA0 = ATT_MFMA(kf[2], qr[1], pA0); pA1 = ATT_MFMA(kf[3], qr[1], pA1);
    pA0 = ATT_MFMA(kf[4], qr[2], pA0); pA1 = ATT_MFMA(kf[5], qr[2], pA1); pA0 = ATT_MFMA(kf[6], qr[3], pA0); pA1 = ATT_MFMA(kf[7], qr[3], pA1);
    AP_CMASK(pA0, pA1, 0);
#pragma unroll
    for (int r = 0; r < 16; ++r) { pA0[r] = fexp2(pA0[r]); pA1[r] = fexp2(pA1[r]); }
    asm volatile("s_waitcnt vmcnt(0) lgkmcnt(0)\n\ts_barrier" ::: "memory");
    AP_DMA_K(3, 0); AP_DMA_V(1, SLOTB); AP_DMA_F(3, 0);
#pragma unroll
    for (int d0 = 0; d0 < 4; ++d0) { kf[2 * d0] = *(const LAS bf16x8*)(kp0 + SLOTB + d0 * 2048); kf[2 * d0 + 1] = *(const LAS bf16x8*)(kp0 + SLOTB + d0 * 2048 + 512); }
    { float e0_, e1_; AP_EREAD(1, e0_, e1_); AP_EB(e0_, ab0); AP_EB(e1_, ab1); }
    if (MODE == M_FOX) ATT_WAIT_BAR(3); else ATT_WAIT_BAR(2);
    AP_ROT();
#define AP_GA(C, g, a0, a1, a2, a3, W0, W1, PW, SC) do { C = ATT_MFMA(kf[g], qr[(g) >> 1], C); kf[g] = *(const LAS bf16x8*)(kn_ + ((g) >> 1) * 2048 + ((g) & 1) * 512); \
        sacc += a0; sacc += a1; sacc += a2; sacc += a3; W0; W1; SC; AP_PIN(PW); AP_PIN(sacc); AP_SBAR(); } while (0)
#define AP_SCD(ctrl, rmask) do { if (MODE == M_FOX) { const int t_ = __builtin_amdgcn_update_dpp(0, sx_, ctrl, rmask, 0xf, false); sx_ = __builtin_bit_cast(int, __builtin_bit_cast(float, sx_) + __builtin_bit_cast(float, t_)); AP_PIN(sx_); } } while (0)
#define AP_GB(O, PW, VA, VB, NA, NB, noff, X, xb, BS) do { if ((noff) >= 0) { NA = vtr(vp_ + (noff)); NB = vtr(vp_ + (noff) + 512); } \
        O = ATT_MFMA(AP_PAF(PW), AP_VF(VA, VB), O); X[xb] = fexp2(X[xb]); X[(xb) + 1] = fexp2(X[(xb) + 1]); X[(xb) + 2] = fexp2(X[(xb) + 2]); X[(xb) + 3] = fexp2(X[(xb) + 3]); \
        BS; AP_PIN(X); AP_SBAR(); } while (0)
#define AP_VOFF(i) (((i) >> 2) * 4096 + ((i) & 3) * 1024)
#define AP_STEP(C0, C1, P0, P1, I) do { const int i_ = (I); const lds_cptr kn_ = kp0 + so_n1; AP_SBAR(); \
        int sx_ = 0; if (MODE == M_FOX) sx_ = __builtin_bit_cast(int, wsf[(so_n1 >> 5) / 4 + (63 - lane)]);                   \
        C0 = ATT_MFMA(AP_PAF(ab0), bb, f32x16{}); AP_SBAR(); C1 = ATT_MFMA(AP_PAF(ab1), bb, f32x16{}); AP_SBAR();              \
        float sacc = P0[0] + P0[1]; \
        AP_GA(C0, 0, P0[2], P0[3], P0[4], P0[5], pw0[0] = AP_PKW(P0, 0), pw0[1] = AP_PKW(P0, 2), pw0, (void)0); \
        AP_GA(C1, 1, P0[6], P0[7], P0[8], P0[9], pw0[2] = AP_PKW(P0, 4), pw0[3] = AP_PKW(P0, 6), pw0, AP_SCD(0x111, 0xf)); \
        AP_GA(C0, 2, P0[10], P0[11], P0[12], P0[13], pw1[0] = AP_PKW(P0, 8), pw1[1] = AP_PKW(P0, 10), pw1, AP_SCD(0x112, 0xf)); \
        AP_GA(C1, 3, P0[14], P0[15], P1[0], P1[1], pw1[2] = AP_PKW(P0, 12), pw1[3] = AP_PKW(P0, 14), pw1, AP_SCD(0x114, 0xf)); \
        AP_GA(C0, 4, P1[2], P1[3], P1[4], P1[5], pw2[0] = AP_PKW(P1, 0), pw2[1] = AP_PKW(P1, 2), pw2, AP_SCD(0x118, 0xf)); \
        AP_GA(C1, 5, P1[6], P1[7], P1[8], P1[9], pw2[2] = AP_PKW(P1, 4), pw2[3] = AP_PKW(P1, 6), pw2, AP_SCD(0x142, 0xa)); \
        AP_GA(C0, 6, P1[10], P1[11], P1[12], P1[13], pw3[0] = AP_PKW(P1, 8), pw3[1] = AP_PKW(P1, 10), pw3, AP_SCD(0x143, 0xc)); \
        AP_GA(C1, 7, P1[14], P1[15], 0.f, 0.f, pw3[2] = AP_PKW(P1, 12), pw3[3] = AP_PKW(P1, 14), pw3, (void)0); \
        l += sacc; \
        last = (i_ + 1 >= NT); \
        if (MODE == M_FOX) { if (!last) { if (u.t_hi - (i_ + 1) < 4 * u.qb) {                                   \
            const float w_ = __builtin_bit_cast(float, sx_) + carry; \
            const unsigned etopb_ = (unsigned)__builtin_amdgcn_readfirstlane(__builtin_bit_cast(int, w_));                      \
            if (etopb_ > limb) last = true;                                                                                   \
            else { wsf[192 + (63 - lane)] = w_; carry = __builtin_bit_cast(float, __builtin_amdgcn_readlane(__builtin_bit_cast(int, w_), 63)); } } } } \
        const lds_cptr vp_ = vp0 + so_prev; s16x4 va0_, vb0_, va1_, vb1_; va0_ = vtr(vp_ + AP_VOFF(0)); vb0_ = vtr(vp_ + AP_VOFF(0) + 512); \
        float e0_, e1_; AP_EREAD(i_ + 1, e0_, e1_);                                                                        \
        AP_SBAR(); \
        AP_DMA_K(i_ + 3, so_cur); AP_DMA_V(i_ + 1, so_n1); AP_DMA_F(i_ + 3, so_cur); \
        AP_CMASK(C0, C1, i_); \
        AP_SBAR(); \
        AP_GB(o0, pw0, va0_, vb0_, va1_, vb1_, AP_VOFF(4), C0, 0, (void)0); \
        AP_GB(o1, pw0, va1_, vb1_, va0_, vb0_, AP_VOFF(1), C0, 4, (void)0); \
        AP_GB(o0, pw1, va0_, vb0_, va1_, vb1_, AP_VOFF(5), C0, 8, AP_EB(e0_, ab0); AP_PIN(ab0)); \
        AP_GB(o1, pw1, va1_, vb1_, va0_, vb0_, AP_VOFF(2), C0, 12, (void)0); \
        AP_GB(o0, pw2, va0_, vb0_, va1_, vb1_, AP_VOFF(6), C1, 0, AP_EB(e1_, ab1); AP_PIN(ab1)); \
        AP_GB(o1, pw2, va1_, vb1_, va0_, vb0_, AP_VOFF(3), C1, 4, (void)0); \
        AP_GB(o0, pw3, va0_, vb0_, va1_, vb1_, AP_VOFF(7), C1, 8, (void)0); \
        AP_GB(o1, pw3, va1_, vb1_, va0_, vb0_, -1, C1, 12, (void)0); \
        if (MODE == M_FOX) ATT_WAIT_BAR(3); else ATT_WAIT_BAR(2); \
        AP_ROT(); } while (0)
#define AP_DRAIN(P0, P1) do { float sacc = 0.f; _Pragma("unroll") for (int r = 0; r < 16; ++r) sacc += P0[r] + P1[r]; l += sacc; \
        pw0 = (u32x4){AP_PKW(P0, 0), AP_PKW(P0, 2), AP_PKW(P0, 4), AP_PKW(P0, 6)}; pw1 = (u32x4){AP_PKW(P0, 8), AP_PKW(P0, 10), AP_PKW(P0, 12), AP_PKW(P0, 14)}; \
        pw2 = (u32x4){AP_PKW(P1, 0), AP_PKW(P1, 2), AP_PKW(P1, 4), AP_PKW(P1, 6)}; pw3 = (u32x4){AP_PKW(P1, 8), AP_PKW(P1, 10), AP_PKW(P1, 12), AP_PKW(P1, 14)}; \
        const lds_cptr vp_ = vp0 + so_prev; \
        _Pragma("unroll") for (int ks = 0; ks < 4; ++ks) { const s16x4 a = vtr(vp_ + ks * 1024), b = vtr(vp_ + ks * 1024 + 512), c = vtr(vp_ + 4096 + ks * 1024), d = vtr(vp_ + 4096 + ks * 1024 + 512); \
            const u32x4 pw_ = ks == 0 ? pw0 : ks == 1 ? pw1 : ks == 2 ? pw2 : pw3; o0 = ATT_MFMA(AP_PAF(pw_), AP_VF(a, b), o0); o1 = ATT_MFMA(AP_PAF(pw_), AP_VF(c, d), o1); } } while (0)
    {
        int i = 1; bool inA = true;
#pragma unroll 1
        for (;;) {
            AP_STEP(pB0, pB1, pA0, pA1, i); inA = false; if (last) break;
            AP_STEP(pA0, pA1, pB0, pB1, i + 1); inA = true; if (last) break;
            i += 2;
        }
        if (inA) AP_DRAIN(pA0, pA1); else AP_DRAIN(pB0, pB1);
    }
    asm volatile("s_waitcnt vmcnt(0) lgkmcnt(0)" ::: "memory");
    attn_epilogue<MODE>(u, shm, o0, o1, l);
#undef AP_TILE
#undef AP_DMA_K
#undef AP_DMA_V
#undef AP_DMA_F
#undef AP_CINIT4
#undef AP_SPLIT3
#undef AP_EB
#undef AP_EREAD
#undef AP_CMASK
#undef AP_ROT
#undef AP_GA
#undef AP_SCD
#undef AP_GB
#undef AP_VOFF
#undef AP_STEP
#undef AP_DRAIN
}
}
namespace att {
constexpr int G_K = 0, G_V = 32768, G_WS = 65536, G_OST = G_WS + 8 * WSB, G_END = G_OST + 8 * 4096;
constexpr int G_QW = G_END, G_PARTS = G_END + 64, G_PRE = G_PARTS + 384 * 4, G_SEL = G_PRE + 385 * 4;
constexpr int MLIST_CAP = 8192;

struct MobaBufs { unsigned* mcnt; unsigned short* mlist; bf16* slab_o; float* slab_l; };

__device__ __forceinline__ void moba_gate_item(const bf16* P, const float* kmean_all, const MobaBufs& mb, int b, int hb, int i) {
    const int tid = threadIdx.x, lane = tid & 63, r32 = lane & 31, hi = lane >> 5; const int wid = __builtin_amdgcn_readfirstlane(tid >> 6);
    const size_t row0 = (size_t)b * SEQ + i * 256;
    bf16x8 qr[4];
    { const bf16* Qw = P + (row0 + wid * 32 + r32) * LDP + L0_BQ + hb * 64 + hi * 8;
#pragma unroll
      for (int d0 = 0; d0 < 4; ++d0) qr[d0] = *(const bf16x8*)(Qw + d0 * 16); }
    f32x16 g = f32x16{}; const float* km = kmean_all + ((size_t)b * 6 + hb) * 32 * 64 + (size_t)r32 * 64 + hi * 8;
#pragma unroll
    for (int d0 = 0; d0 < 4; ++d0) { const f32x4 a0 = *(const f32x4*)(km + 16 * d0), a1 = *(const f32x4*)(km + 16 * d0 + 4); bf16x8 kh, kl;
#pragma unroll
        for (int j = 0; j < 4; ++j) { unsigned h0 = f2bf(a0[j]), h1 = f2bf(a1[j]); kh[j] = (short)h0; kh[j + 4] = (short)h1; kl[j] = (short)f2bf(a0[j] - bf2f((bf16)h0)); kl[j + 4] = (short)f2bf(a1[j] - bf2f((bf16)h1)); }
        g = ATT_MFMA(kh, qr[d0], g); g = ATT_MFMA(kl, qr[d0], g); }
#pragma unroll
    for (int r = 0; r < 16; ++r) if (crow(r, hi) >= i) g[r] = -INFINITY;
    unsigned selmask = 0u;
#pragma unroll 1
    for (int it = 0; it < 3; ++it) { float bv = -INFINITY; int bj = 99;
#pragma unroll
        for (int r = 0; r < 16; ++r) if (g[r] > bv) { bv = g[r]; bj = crow(r, hi); }
        const float pv = __shfl_xor(bv, 32); const int pj = __shfl_xor(bj, 32);
        if (pv > bv || (pv == bv && pj < bj)) { bv = pv; bj = pj; }
        if (bv > -INFINITY) selmask |= 1u << (bj & 31);
#pragma unroll
        for (int r = 0; r < 16; ++r) if (crow(r, hi) == bj) g[r] = -INFINITY; }
    const bool rep = (hi == 0);
    unsigned mycnt = 0u;
#pragma unroll 1
    for (int j = 0; j < i; ++j) { const unsigned long long m = __ballot(rep && ((selmask >> j) & 1u)); if (lane == j) mycnt = (unsigned)__popcll(m); }
    unsigned base = 0u; unsigned* cnt = mb.mcnt + ((size_t)b * 6 + hb) * 32;
    if (lane < i && mycnt) base = __hip_atomic_fetch_add(cnt + lane, mycnt, __ATOMIC_RELAXED, __HIP_MEMORY_SCOPE_AGENT);
    unsigned short* lst = mb.mlist + (((size_t)b * 6 + hb) * 32) * MLIST_CAP;
    const unsigned long long lt = (1ull << lane) - 1ull;
#pragma unroll 1
    for (int j = 0; j < i; ++j) { const bool sj = rep && ((selmask >> j) & 1u); const unsigned long long m = __ballot(sj);
        const unsigned bj = (unsigned)__builtin_amdgcn_readlane((int)base, j);
        if (sj) { const unsigned pos = bj + (unsigned)__popcll(m & lt), slot = (unsigned)__popc(selmask & ((1u << j) - 1u));
            lst[(size_t)j * MLIST_CAP + pos] = (unsigned short)((i * 256 + wid * 32 + r32) | (slot << 13)); } }
}

#ifndef KV_SUB
#define KV_SUB 2
#endif
struct SubChunk { int row, slot, S; bool valid, act; };
__device__ __forceinline__ void moba_subchunk(const SubChunk& sc, const bf16x8 (&qr)[4], int b, int hb, int j, float sl2, const MobaBufs& mb, LAS unsigned char* shm) {
    const int tid = threadIdx.x, lane = tid & 63, r32 = lane & 31, hi = lane >> 5; const int wid = __builtin_amdgcn_readfirstlane(tid >> 6);
    LAS float* wsf = (LAS float*)(shm + G_WS + wid * WSB);
    LAS float* ost = (LAS float*)(shm + G_OST + wid * 4096);
    const lds_cptr shc = (lds_cptr)shm;
    const int orow = lane >> 1, oh = lane & 1;
    const int S = sc.S; const bool own = (S < 8); const int k = 32 * S + r32; const int row = sc.row; const bool valid = sc.valid;
    f32x16 o0 = f32x16{}, o1 = f32x16{}; float l = 0.f;
#pragma unroll 1
    for (int tt = 3; tt >= 0; --tt) {
        if (own) { if (64 * tt > 32 * S + 31) continue; }
        const lds_cptr kp = shc + G_K + tt * 8192 + hi * 1024 + r32 * 16;
        bf16x8 kf[8];
#pragma unroll
        for (int d0 = 0; d0 < 4; ++d0) { kf[2 * d0] = *(const LAS bf16x8*)(kp + d0 * 2048); kf[2 * d0 + 1] = *(const LAS bf16x8*)(kp + d0 * 2048 + 512); }
        float base = sl2 * (float)(64 * (4 * j + tt) + 4 * hi - row); if (!valid) base = -INFINITY;
        f32x16 p0, p1;
#pragma unroll
        for (int r = 0; r < 16; ++r) { p0[r] = __builtin_fmaf(sl2, (float)((r & 3) + 8 * (r >> 2)), base); p1[r] = p0[r] + 32.f * sl2; }
        p0 = ATT_MFMA(kf[0], qr[0], p0); p1 = ATT_MFMA(kf[1], qr[0], p1); p0 = ATT_MFMA(kf[2], qr[1], p0); p1 = ATT_MFMA(kf[3], qr[1], p1);
        p0 = ATT_MFMA(kf[4], qr[2], p0); p1 = ATT_MFMA(kf[5], qr[2], p1); p0 = ATT_MFMA(kf[6], qr[3], p0); p1 = ATT_MFMA(kf[7], qr[3], p1);
        if (own) { const int kb = 64 * tt + 4 * hi;
#pragma unroll
            for (int r = 0; r < 16; ++r) { const int kv = kb + (r & 3) + 8 * (r >> 2); if (kv > k) p0[r] = -INFINITY; if (kv + 32 > k) p1[r] = -INFINITY; } }
#pragma unroll
        for (int r = 0; r < 16; ++r) { p0[r] = fexp2(p0[r]); p1[r] = fexp2(p1[r]); }
        float sm = 0.f;
#pragma unroll
        for (int r = 0; r < 16; ++r) sm += p0[r] + p1[r];
        l += sm;
        u32x4 pw[4];
#pragma unroll
        for (int q = 0; q < 4; ++q) { pw[0][q] = cvtpk(p0[2 * q], p0[2 * q + 1]); pw[1][q] = cvtpk(p0[8 + 2 * q], p0[9 + 2 * q]); pw[2][q] = cvtpk(p1[2 * q], p1[2 * q + 1]); pw[3][q] = cvtpk(p1[8 + 2 * q], p1[9 + 2 * q]); }
        const lds_cptr vp = shc + G_V + tt * 8192 + ((lane >> 4) & 1) * 32 + (lane & 3) * 8 + (4 * hi + ((lane & 15) >> 2)) * 64;
#pragma unroll
        for (int ks = 0; ks < 4; ++ks) { const s16x4 va = vtr(vp + ks * 1024), vb = vtr(vp + ks * 1024 + 512), vc = vtr(vp + 4096 + ks * 1024), vd = vtr(vp + 4096 + ks * 1024 + 512);
            const bf16x8 v0 = (bf16x8){va[0], va[1], va[2], va[3], vb[0], vb[1], vb[2], vb[3]}, v1 = (bf16x8){vc[0], vc[1], vc[2], vc[3], vd[0], vd[1], vd[2], vd[3]};
            o0 = ATT_MFMA(__builtin_bit_cast(bf16x8, pw[ks]), v0, o0); o1 = ATT_MFMA(__builtin_bit_cast(bf16x8, pw[ks]), v1, o1); }
    }
    l += __shfl_xor(l, 32);
    const size_t brow = (size_t)b * SEQ + row;
    if (hi == 0) { wsf[r32] = l > 0.f ? 1.f / l : 0.f; if (valid) mb.slab_l[((size_t)sc.slot * T + brow) * 6 + hb] = l; }
    asm volatile("s_waitcnt lgkmcnt(0)" ::: "memory");
    float rl[16];
#pragma unroll
    for (int r = 0; r < 16; ++r) rl[r] = wsf[crow(r, hi)];
    const int row_o = __shfl(row, orow), slot_o = __shfl(sc.slot, orow); const bool valid_o = __shfl((int)valid, orow) != 0;
    bf16* dst = mb.slab_o + (((size_t)slot_o * T + (size_t)b * SEQ + row_o) * 6 + hb) * 64 + 16 * oh;
#pragma unroll
    for (int d0 = 0; d0 < 2; ++d0) {
#pragma unroll
        for (int r = 0; r < 16; ++r) ost[crow(r, hi) * 32 + r32] = (d0 == 0 ? o0[r] : o1[r]) * rl[r];
        asm volatile("s_waitcnt lgkmcnt(0)" ::: "memory");
        f32x4 ov[4];
#pragma unroll
        for (int q = 0; q < 4; ++q) ov[q] = *(const LAS f32x4*)(ost + orow * 32 + 16 * oh + 4 * q);
        u32x4 y0, y1; y0[0] = cvtpk(ov[0][0], ov[0][1]); y0[1] = cvtpk(ov[0][2], ov[0][3]); y0[2] = cvtpk(ov[1][0], ov[1][1]); y0[3] = cvtpk(ov[1][2], ov[1][3]);
        y1[0] = cvtpk(ov[2][0], ov[2][1]); y1[1] = cvtpk(ov[2][2], ov[2][3]); y1[2] = cvtpk(ov[3][0], ov[3][1]); y1[3] = cvtpk(ov[3][2], ov[3][3]);
        if (valid_o) { *(u32x4*)(dst + 32 * d0) = y0; *(u32x4*)(dst + 32 * d0 + 8) = y1; }
        asm volatile("s_waitcnt lgkmcnt(0)" ::: "memory");
    }
}
__device__ __forceinline__ void moba_kv_unit(const bf16* P, const MobaBufs& mb, int b, int hb, int j, int part, unsigned* qctr, LAS unsigned char* shm) {
    const int tid = threadIdx.x, lane = tid & 63, r32 = lane & 31, hi = lane >> 5; const int wid = __builtin_amdgcn_readfirstlane(tid >> 6);
    const unsigned lds0 = (unsigned)(size_t)shm;
    const bf16* Pb = P + (size_t)b * SEQ * LDP;
    { const bf16* ksrc = Pb + L0_BK + hb * 64 + (size_t)(256 * j + lane) * LDP + wid * 8;
      const bf16* vsrc = Pb + L0_BV + hb * 64 + (size_t)(256 * j + 16 * (wid & 3) + (lane >> 2)) * LDP + (wid >> 2) * 32 + (lane & 3) * 8;
#pragma unroll
      for (int tt = 0; tt < 4; ++tt) { glds16(ksrc + (size_t)tt * 64 * LDP, ATT_RFL(lds0 + G_K + tt * 8192 + wid * 1024)); glds16(vsrc + (size_t)tt * 64 * LDP, ATT_RFL(lds0 + G_V + tt * 8192 + wid * 1024)); } }
    const int list = (b * 6 + hb) * 32 + j;
    const int cnt = (int)mb.mcnt[list]; const int rows_total = 256 + cnt;
    const unsigned short* lst = mb.mlist + (size_t)list * MLIST_CAP;
    const float sl2 = alibi_slope2(6 + hb);
    unsigned nxt = 0u; if (tid == 0) nxt = __hip_atomic_fetch_add(qctr, 1u, __ATOMIC_RELAXED, __HIP_MEMORY_SCOPE_AGENT);
    SubChunk cur, nx; bf16x8 qc[4], qn[4];
#define KV_DESC(D, s_) do { const int S_ = 8 * KV_SUB * part + wid + 8 * (s_); D.S = S_; D.act = ((s_) < KV_SUB) && (32 * S_ < rows_total); const int k_ = 32 * S_ + r32; \
        if (S_ < 8) { D.row = 256 * j + k_; D.slot = 3; D.valid = true; } \
        else { const int idx_ = k_ - 256; const bool v_ = D.act && idx_ < cnt; const unsigned e_ = v_ ? (unsigned)lst[idx_] : 0u; D.row = (int)(e_ & 8191u); D.slot = (int)(e_ >> 13); D.valid = v_; } } while (0)
    KV_DESC(cur, 0);
    { const bf16* Q0 = Pb + (size_t)cur.row * LDP + L0_BQ + hb * 64 + hi * 8;
#pragma unroll
      for (int d0 = 0; d0 < 4; ++d0) qc[d0] = *(const bf16x8*)(Q0 + d0 * 16); }
    asm volatile("" : "+v"(qc[0]), "+v"(qc[1]), "+v"(qc[2]), "+v"(qc[3]));
    asm volatile("s_waitcnt vmcnt(0) lgkmcnt(0)\n\ts_barrier" ::: "memory");
#pragma unroll 1
    for (int s = 0; s < KV_SUB; ++s) {
        if (!cur.act) break;
        KV_DESC(nx, s + 1);
        { const bf16* Q1 = Pb + (size_t)nx.row * LDP + L0_BQ + hb * 64 + hi * 8;
#pragma unroll
          for (int d0 = 0; d0 < 4; ++d0) qn[d0] = *(const bf16x8*)(Q1 + d0 * 16); }
        moba_subchunk(cur, qc, b, hb, j, sl2, mb, shm);
        cur = nx;
#pragma unroll
        for (int d0 = 0; d0 < 4; ++d0) qc[d0] = qn[d0];
    }
#undef KV_DESC
    if (tid == 0) *(LAS unsigned*)(shm + G_QW) = nxt;
    asm volatile("s_waitcnt vmcnt(0) lgkmcnt(0)\n\ts_barrier" ::: "memory");
}

__device__ __forceinline__ void moba_kv_phase(const Args& a, const MobaBufs& mb, LAS unsigned char* lds, unsigned* qctr) {
    const bf16* P = (const bf16*)(a.ws + WS_P);
    const int tid = threadIdx.x;
    LAS unsigned* qw = (LAS unsigned*)(lds + G_QW); LAS int* parts = (LAS int*)(lds + G_PARTS); LAS int* pre = (LAS int*)(lds + G_PRE); LAS int* sel = (LAS int*)(lds + G_SEL);
    if (tid == 0) {
        unsigned sp = 0u; while (__hip_atomic_load(mb.mcnt + 512, __ATOMIC_RELAXED, __HIP_MEMORY_SCOPE_AGENT) < 372u) { __builtin_amdgcn_s_sleep(2); if (++sp > (1u << 22)) break; }
        __builtin_amdgcn_fence(__ATOMIC_ACQUIRE, "agent"); asm volatile("s_waitcnt vmcnt(0)" ::: "memory"); }
    __syncthreads();
    if (tid < 384) parts[tid] = (256 + (int)__hip_atomic_load(mb.mcnt + tid, __ATOMIC_RELAXED, __HIP_MEMORY_SCOPE_AGENT) + 256 * KV_SUB - 1) / (256 * KV_SUB);
    if (tid == 0) *qw = __hip_atomic_fetch_add(qctr, 1u, __ATOMIC_RELAXED, __HIP_MEMORY_SCOPE_AGENT);
    __syncthreads();
    if (tid < 385) { int s = 0; for (int k = 0; k < tid; ++k) s += parts[k] - 1; pre[tid] = s; }
    __syncthreads();
    const int nfull = pre[384], total = nfull + 384;
    for (;;) {
        const int idx = __builtin_amdgcn_readfirstlane((int)*qw);
        if (idx >= total) break;
        if (tid < 384) { if (idx < nfull) { if (pre[tid] <= idx && idx < pre[tid + 1]) { sel[0] = tid; sel[1] = idx - pre[tid]; } }
                         else if (tid == idx - nfull) { sel[0] = tid; sel[1] = parts[tid] - 1; } }
        __syncthreads();
        const int list = __builtin_amdgcn_readfirstlane(sel[0]), part = __builtin_amdgcn_readfirstlane(sel[1]);
        const int bh = list >> 5, j = list & 31;
        moba_kv_unit(P, mb, bh / 6, bh % 6, j, part, qctr, lds);
    }
}

__device__ __forceinline__ void moba_combine(const Args& a, const MobaBufs& mb, int vcu, int G) {
    const bf16* P = (const bf16*)(a.ws + WS_P); bf16* Y = (bf16*)(a.ws + WS_Y);
    const int NIT = T * 6 * 8;
    for (int it = vcu * 512 + threadIdx.x; it < NIT; it += G * 512) {
        const int dg = it & 7, rh = it >> 3, hb = rh % 6, brow = rh / 6, blk = (brow & (SEQ - 1)) >> 8, nv = blk < 3 ? blk : 3;
        float O[8], L = 0.f;
#pragma unroll
        for (int e = 0; e < 8; ++e) O[e] = 0.f;
#pragma unroll
        for (int s = 0; s < 4; ++s) { if (s == 3 || s < nv) { const size_t si = ((size_t)s * T + brow) * 6 + hb; const float l = mb.slab_l[si]; const u32x4 w = *(const u32x4*)(mb.slab_o + si * 64 + 8 * dg);
#pragma unroll
            for (int e = 0; e < 4; ++e) { O[2 * e] += l * __uint_as_float(w[e] << 16); O[2 * e + 1] += l * __uint_as_float(w[e] & 0xffff0000u); } L += l; } }
        const float il = 1.f / L;
        const u32x4 z = *(const u32x4*)(P + (size_t)brow * LDP + L0_Z + (6 + hb) * 64 + 8 * dg); u32x4 y;
#pragma unroll
        for (int e = 0; e < 4; ++e) y[e] = cvtpk(O[2 * e] * il * __uint_as_float(z[e] << 16), O[2 * e + 1] * il * __uint_as_float(z[e] & 0xffff0000u));
        *(u32x4*)(Y + (size_t)brow * DM + (6 + hb) * 64 + 8 * dg) = y;
    }
}
}
#ifndef ATT_PIPE
#define ATT_PIPE 1
#endif
#ifndef MOBA_GATHER
#define MOBA_GATHER 1
#endif
namespace att {
constexpr int R_K = 0, R_V = 49152, R_WS = 98304, R_OST = R_WS + 8 * 256, R_END = R_OST + 8 * 4096;
__device__ __forceinline__ void swa_res_unit(const bf16* P, bf16* Y, const float* sinks, int b, int kvh, int qb, unsigned* qctr, LAS unsigned* qw, LAS unsigned char* shm) {
    const int tid = threadIdx.x, lane = tid & 63, r32 = lane & 31, hi = lane >> 5; const int wid = __builtin_amdgcn_readfirstlane(tid >> 6);
    const unsigned lds0 = (unsigned)(size_t)shm;
    const bf16* Pb = P + (size_t)b * SEQ * LDP;
    const int t0 = 4 * qb - 2 < 0 ? 0 : 4 * qb - 2, ntl = 4 * qb + 4 - t0;
    { const bf16* ksrc = Pb + L0_AK + kvh * 64 + (size_t)(64 * t0 + lane) * LDP + wid * 8;
      const bf16* vsrc = Pb + L0_AV + kvh * 64 + (size_t)(64 * t0 + 16 * (wid & 3) + (lane >> 2)) * LDP + (wid >> 2) * 32 + (lane & 3) * 8;
#pragma unroll 1
      for (int tt = 0; tt < ntl; ++tt) { glds16(ksrc + (size_t)tt * 64 * LDP, ATT_RFL(lds0 + R_K + tt * 8192 + wid * 1024)); glds16(vsrc + (size_t)tt * 64 * LDP, ATT_RFL(lds0 + R_V + tt * 8192 + wid * 1024)); } }
    unsigned nxt = 0u; if (tid == 0) nxt = __hip_atomic_fetch_add(qctr, 1u, __ATOMIC_RELAXED, __HIP_MEMORY_SCOPE_AGENT);
    const int qmin = 256 * qb + 32 * wid, qpos = qmin + r32; const size_t brow = (size_t)b * SEQ + qpos;
    asm volatile("s_waitcnt vmcnt(0) lgkmcnt(0)\n\ts_barrier" ::: "memory");
    LAS float* wsf = (LAS float*)(shm + R_WS + wid * 256); LAS float* ost = (LAS float*)(shm + R_OST + wid * 4096);
    const lds_cptr shc = (lds_cptr)shm;
    const int orow = lane >> 1, oh = lane & 1;
    const int t_hi = (qmin + 31) >> 6, t_lo = (qmin - 127) < 0 ? 0 : (qmin - 127) >> 6;
#pragma unroll 1
    for (int g = 0; g < 3; ++g) { const int h = 3 * kvh + g; float sl2v = alibi_slope2(h); asm volatile("" : "+v"(sl2v)); const float sl8v = sl2v * 4.f * 2.f, sl16v = sl8v * 2.f, sl24v = sl8v + sl16v, sl32v = sl16v * 2.f;
        bf16x8 qr[4];
        { const bf16* Qw = P + brow * LDP + L0_AQ + h * 64 + hi * 8;
#pragma unroll
          for (int d0 = 0; d0 < 4; ++d0) qr[d0] = *(const bf16x8*)(Qw + d0 * 16); }
        const size_t srow = (size_t)b * SEQ + qmin + orow;
        u32x4 zz[2][2];
#pragma unroll
        for (int d0 = 0; d0 < 2; ++d0) { const bf16* zp = P + srow * LDP + L0_Z + h * 64 + 32 * d0 + 16 * oh; zz[d0][0] = *(const u32x4*)zp; zz[d0][1] = *(const u32x4*)(zp + 8); }
        f32x16 o0 = f32x16{}, o1 = f32x16{}; float l = 0.f;
#pragma unroll 1
        for (int t = t_hi; t >= t_lo; --t) {
            const lds_cptr kp = shc + R_K + (t - t0) * 8192 + hi * 1024 + r32 * 16;
            bf16x8 kf[8];
#pragma unroll
            for (int d0 = 0; d0 < 4; ++d0) { kf[2 * d0] = *(const LAS bf16x8*)(kp + d0 * 2048); kf[2 * d0 + 1] = *(const LAS bf16x8*)(kp + d0 * 2048 + 512); }
            const float base = sl2v * (float)(64 * t + 4 * hi - qpos);
            f32x16 p0, p1;
#pragma unroll
            for (int g4 = 0; g4 < 4; ++g4) { const float a0 = g4 == 0 ? base : g4 == 1 ? base + sl8v : g4 == 2 ? base + sl16v : base + sl24v;
                p0[4 * g4] = a0; p0[4 * g4 + 1] = a0 + sl2v; p0[4 * g4 + 2] = p0[4 * g4 + 1] + sl2v; p0[4 * g4 + 3] = p0[4 * g4 + 2] + sl2v; }
#pragma unroll
            for (int r = 0; r < 16; ++r) p1[r] = p0[r] + sl32v;
            p0 = ATT_MFMA(kf[0], qr[0], p0); p1 = ATT_MFMA(kf[1], qr[0], p1); p0 = ATT_MFMA(kf[2], qr[1], p0); p1 = ATT_MFMA(kf[3], qr[1], p1);
            p0 = ATT_MFMA(kf[4], qr[2], p0); p1 = ATT_MFMA(kf[5], qr[2], p1); p0 = ATT_MFMA(kf[6], qr[3], p0); p1 = ATT_MFMA(kf[7], qr[3], p1);
            { int d = qpos - (64 * t + 4 * hi); asm volatile("" : "+v"(d));
              if (64 * t + 63 > qmin) {
#pragma unroll
                  for (int r = 0; r < 16; ++r) { const int c = (r & 3) + 8 * (r >> 2); if (c > d) p0[r] = -INFINITY; if (c + 32 > d) p1[r] = -INFINITY; } }
              if (64 * t < qmin + 31 - 127) {
#pragma unroll
                  for (int r = 0; r < 16; ++r) { const int c = (r & 3) + 8 * (r >> 2); if (d - c >= 128) p0[r] = -INFINITY; if (d - c - 32 >= 128) p1[r] = -INFINITY; } } }
#pragma unroll
            for (int r = 0; r < 16; ++r) { p0[r] = fexp2(p0[r]); p1[r] = fexp2(p1[r]); }
            float sm = 0.f;
#pragma unroll
            for (int r = 0; r < 16; ++r) sm += p0[r] + p1[r];
            l += sm;
            u32x4 pw[4];
#pragma unroll
            for (int q = 0; q < 4; ++q) { pw[0][q] = cvtpk(p0[2 * q], p0[2 * q + 1]); pw[1][q] = cvtpk(p0[8 + 2 * q], p0[9 + 2 * q]); pw[2][q] = cvtpk(p1[2 * q], p1[2 * q + 1]); pw[3][q] = cvtpk(p1[8 + 2 * q], p1[9 + 2 * q]); }
            const lds_cptr vp = shc + R_V + (t - t0) * 8192 + ((lane >> 4) & 1) * 32 + (lane & 3) * 8 + (4 * hi + ((lane & 15) >> 2)) * 64;
#pragma unroll
            for (int ks = 0; ks < 4; ++ks) { const s16x4 va = vtr(vp + ks * 1024), vb = vtr(vp + ks * 1024 + 512), vc = vtr(vp + 4096 + ks * 1024), vd = vtr(vp + 4096 + ks * 1024 + 512);
                const bf16x8 v0 = (bf16x8){va[0], va[1], va[2], va[3], vb[0], vb[1], vb[2], vb[3]}, v1 = (bf16x8){vc[0], vc[1], vc[2], vc[3], vd[0], vd[1], vd[2], vd[3]};
                o0 = ATT_MFMA(__builtin_bit_cast(bf16x8, pw[ks]), v0, o0); o1 = ATT_MFMA(__builtin_bit_cast(bf16x8, pw[ks]), v1, o1); }
        }
        l += __shfl_xor(l, 32); l += fexp2(LOG2E * sinks[h]);
        if (hi == 0) wsf[r32] = 1.f / l;
        asm volatile("s_waitcnt lgkmcnt(0)" ::: "memory");
        float rl[16];
#pragma unroll
        for (int r = 0; r < 16; ++r) rl[r] = wsf[crow(r, hi)];
#pragma unroll
        for (int d0 = 0; d0 < 2; ++d0) {
#pragma unroll
            for (int r = 0; r < 16; ++r) ost[crow(r, hi) * 32 + r32] = (d0 == 0 ? o0[r] : o1[r]) * rl[r];
            asm volatile("s_waitcnt lgkmcnt(0)" ::: "memory");
            f32x4 ov[4];
#pragma unroll
            for (int j = 0; j < 4; ++j) ov[j] = *(const LAS f32x4*)(ost + orow * 32 + 16 * oh + 4 * j);
            const u32x4 z0 = zz[d0][0], z1 = zz[d0][1]; u32x4 y0, y1;
#pragma unroll
            for (int j = 0; j < 4; ++j) { const unsigned za = j < 2 ? z0[2 * j] : z1[2 * (j - 2)], zb = j < 2 ? z0[2 * j + 1] : z1[2 * (j - 2) + 1];
                const unsigned w0 = cvtpk(ov[j][0] * __uint_as_float(za << 16), ov[j][1] * __uint_as_float(za & 0xffff0000u)), w1 = cvtpk(ov[j][2] * __uint_as_float(zb << 16), ov[j][3] * __uint_as_float(zb & 0xffff0000u));
                if (j < 2) { y0[2 * j] = w0; y0[2 * j + 1] = w1; } else { y1[2 * (j - 2)] = w0; y1[2 * (j - 2) + 1] = w1; } }
            bf16* yp = Y + srow * DM + h * 64 + 32 * d0 + 16 * oh;
            *(u32x4*)yp = y0; *(u32x4*)(yp + 8) = y1;
            asm volatile("s_waitcnt lgkmcnt(0)" ::: "memory");
        }
    }
    if (tid == 0) *qw = nxt;
    asm volatile("s_waitcnt vmcnt(0) lgkmcnt(0)\n\ts_barrier" ::: "memory");
}

constexpr int NUNITS = 1024;
__device__ __forceinline__ void attn_phase(int layer, const Args& a, LAS unsigned char* lds, unsigned* qctr, const MobaBufs& mb) {
    unsigned char* ws = a.ws; const bf16* P = (const bf16*)(ws + WS_P); bf16* Y = (bf16*)(ws + WS_Y);
    LAS unsigned* qw = (LAS unsigned*)(lds + R_END);
    const int tid = threadIdx.x, lane = tid & 63;
    float thr2 = 0.f; bool zok = false;
    if (layer == 1) { const float* g = a.in[11]; float mq = fabsf(g[lane]), mk = fabsf(g[64 + lane]);
#pragma unroll
        for (int o = 1; o < 64; o <<= 1) { mq = fmaxf(mq, __shfl_xor(mq, o)); mk = fmaxf(mk, __shfl_xor(mk, o)); }
        thr2 = LOG2E * (104.f + 2.f * 8.f * mq * mk); thr2 = __builtin_bit_cast(float, __builtin_amdgcn_readfirstlane(__builtin_bit_cast(int, thr2))); }
    if (tid == 0) *qw = __hip_atomic_fetch_add(qctr, 1u, __ATOMIC_RELAXED, __HIP_MEMORY_SCOPE_AGENT);
    __syncthreads();
    for (;;) {
        int idx = __builtin_amdgcn_readfirstlane((int)*qw);
        if (MOBA_GATHER && layer == 0) {
            if (idx >= 372 + 128 + 256) break;
            if (idx < 372) { moba_gate_item(P, (const float*)(ws + WS_KMEAN), mb, (idx % 12) / 6, (idx % 12) % 6, 1 + idx / 12);
                asm volatile("s_waitcnt vmcnt(0)" ::: "memory");
                __syncthreads();
                if (tid == 0) { __builtin_amdgcn_fence(__ATOMIC_RELEASE, "agent"); asm volatile("s_waitcnt vmcnt(0)" ::: "memory");
                    __hip_atomic_fetch_add(mb.mcnt + 512, 1u, __ATOMIC_RELAXED, __HIP_MEMORY_SCOPE_AGENT);
                    *qw = __hip_atomic_fetch_add(qctr, 1u, __ATOMIC_RELAXED, __HIP_MEMORY_SCOPE_AGENT); }
                __syncthreads(); continue; }
            if (idx < 500) { const int k = idx - 372; swa_res_unit(P, Y, a.in[5], (k & 3) >> 1, k & 1, 31 - (k >> 2), qctr, qw, lds); continue; }
            idx += 768 - 500;
        }
        if (idx >= NUNITS) break;
        if (layer == 1 && idx >= 512 && !zok) {
            if (tid == 0) { unsigned sp = 0u; while (__hip_atomic_load(mb.mcnt + 1024, __ATOMIC_RELAXED, __HIP_MEMORY_SCOPE_AGENT) < 128u) { __builtin_amdgcn_s_sleep(2); if (++sp > (1u << 22)) break; }
                __builtin_amdgcn_fence(__ATOMIC_ACQUIRE, "agent"); asm volatile("s_waitcnt vmcnt(0)" ::: "memory"); }
            __syncthreads(); zok = true; }
        UnitP u; u.qctr = qctr; u.qw = qw; u.sl2 = 0.f; u.sinkp = 0.f; u.thr2 = thr2; u.lf = nullptr; u.kmean = nullptr; u.pitch = LDP;
        int mode;
        if (idx >= 768) { const int k = idx - 768, qb = k >> 3, bh = k & 7, b = bh >> 2, hm = bh & 3; mode = M_MEM;
            const size_t row0 = (size_t)b * SEQ + qb * 256; const int mq = layer == 0 ? L0_MQ : L1_MQ, zc = (layer == 0 ? L0_Z : L1_Z) + (12 + hm) * 64;
            const bf16* MK = (const bf16*)(ws + WS_MKV + (size_t)(2 * layer) * MKV_ONE) + (size_t)b * MEML * 256 + hm * 64; const bf16* MV = (const bf16*)(ws + WS_MKV + (size_t)(2 * layer + 1) * MKV_ONE) + (size_t)b * MEML * 256 + hm * 64;
            u.Q = P + row0 * LDP + mq + hm * 64; u.K = MK; u.V = MV; u.pitch = 256; u.Z = P + row0 * LDP + zc; u.Y = Y + row0 * DM + (12 + hm) * 64; u.qb = qb; u.t_hi = 3; u.t_lo = 0;
        } else if (layer == 1) { int qb, b, h;
            if (idx < 512) { qb = 31 - idx / 16; b = (idx % 16) / 8; h = idx % 8; } else { const int k = idx - 512; qb = 31 - k / 8; b = (k % 8) / 4; h = 8 + k % 4; }
            mode = M_FOX;
            const size_t row0 = (size_t)b * SEQ + qb * 256; const bf16* Pb = P + (size_t)b * SEQ * LDP;
            u.Q = P + row0 * LDP + L1_CQ + h * 64; u.K = Pb + L1_CK + h * 64; u.V = Pb + L1_CV + h * 64; u.Z = P + row0 * LDP + L1_Z + h * 64; u.Y = Y + row0 * DM + h * 64;
            u.qb = qb; u.t_hi = 4 * qb + 3; u.t_lo = 0; u.lf = (const float*)(ws + WS_LOGF) + ((size_t)b * 12 + h) * SEQ;
        } else if (idx < 384) { const int qb = 31 - idx / 12, bh = idx % 12, b = bh / 6, hb = bh % 6; mode = M_MOBA;
            const size_t row0 = (size_t)b * SEQ + qb * 256; const bf16* Pb = P + (size_t)b * SEQ * LDP;
            u.Q = P + row0 * LDP + L0_BQ + hb * 64; u.K = Pb + L0_BK + hb * 64; u.V = Pb + L0_BV + hb * 64; u.Z = P + row0 * LDP + L0_Z + (6 + hb) * 64; u.Y = Y + row0 * DM + (6 + hb) * 64;
            u.qb = qb; u.t_hi = 4 * qb + 3; u.t_lo = 0; u.sl2 = alibi_slope2(6 + hb); u.kmean = (const float*)(ws + WS_KMEAN) + ((size_t)b * 6 + hb) * 32 * 64;
        } else { const int k = idx - 384, qb = k / 12, bh = k % 12, b = bh / 6, h = bh % 6, kvh = h / 3; mode = M_SWA;
            const size_t row0 = (size_t)b * SEQ + qb * 256; const bf16* Pb = P + (size_t)b * SEQ * LDP;
            u.Q = P + row0 * LDP + L0_AQ + h * 64; u.K = Pb + L0_AK + kvh * 64; u.V = Pb + L0_AV + kvh * 64; u.Z = P + row0 * LDP + L0_Z + h * 64; u.Y = Y + row0 * DM + h * 64;
            u.qb = qb; u.t_hi = 4 * qb + 3; u.t_lo = 4 * qb - 2 < 0 ? 0 : 4 * qb - 2; u.sl2 = alibi_slope2(h); u.sinkp = fexp2(LOG2E * a.in[5][h]);
        }
        if (mode == M_MEM) attn_unit<M_MEM>(u, lds); else if (mode == M_FOX) { if (ATT_PIPE) attn_unit_pipe<M_FOX>(u, lds); else attn_unit<M_FOX>(u, lds); } else if (mode == M_MOBA) attn_unit<M_MOBA>(u, lds); else attn_unit<M_SWA>(u, lds);
    }
}
}
typedef GAS unsigned gu32;
#define RLX_AGENT __ATOMIC_RELAXED, __HIP_MEMORY_SCOPE_AGENT
#define XB_TMO      128
#define XB_XCNT(j)  (256  + 64 * (j))
#define XB_XSUB(j)  (1280 + 64 * (j))
#define XB_XGEN(j)  (2304 + 64 * (j))
#define XB_TOP      3328
#define XB_TOPGEN   3392
#define XCD_BAR_WORDS 3456
#define XB_SPIN_CAP (1u << 18)

__device__ __forceinline__ unsigned xb_ld(unsigned* p)              { return __hip_atomic_load(p, __ATOMIC_RELAXED, __HIP_MEMORY_SCOPE_AGENT); }
__device__ __forceinline__ unsigned xb_add(unsigned* p, unsigned v) { return __hip_atomic_fetch_add(p, v, __ATOMIC_RELAXED, __HIP_MEMORY_SCOPE_AGENT); }
__device__ __forceinline__ unsigned xb_xcc_id() { return (unsigned)__builtin_amdgcn_s_getreg((3 << 11) | 20) & 0xFu; }
#define XB_SPIN(cond, bar) do { unsigned _sp = 0; while (cond) { __builtin_amdgcn_s_sleep(1); \
    if ((++_sp & 255u) == 0u) { if (xb_ld(&(bar)[XB_TMO])) break; if (_sp > XB_SPIN_CAP) { atomicAdd(&(bar)[XB_TMO], 1u); break; } } } } while (0)

struct XcdBarrier {
    unsigned* bar; unsigned x;
    volatile LAS unsigned* st;
};

__device__ __forceinline__ XcdBarrier xcd_barrier_post(unsigned* bar, volatile LAS unsigned* st) {
    XcdBarrier b; b.bar = bar; b.x = xb_xcc_id(); b.st = st;
    if (threadIdx.x == 0) (void)xb_add(&bar[XB_XCNT(b.x)], 1u);
    return b;
}
__device__ __forceinline__ void xcd_barrier_complete(unsigned* bar, unsigned x, unsigned& nloc, unsigned& nx) {
    const unsigned G = gridDim.x * gridDim.y * gridDim.z;
    unsigned sum, cnt, mine, sp = 0u;
    for (;;) {
        sum = 0u; cnt = 0u; mine = 0u;
#pragma unroll
        for (unsigned j = 0; j < 16; ++j) { const unsigned c = xb_ld(&bar[XB_XCNT(j)]); sum += c; cnt += (c > 0u) ? 1u : 0u; mine = (j == x) ? c : mine; }
        if (sum == G) break;
        __builtin_amdgcn_s_sleep(1);
        if ((++sp & 255u) == 0u) { if (xb_ld(&bar[XB_TMO])) break; if (sp > XB_SPIN_CAP) { atomicAdd(&bar[XB_TMO], 1u); break; } }
    }
    nloc = mine > 0u ? mine : 1u; nx = cnt > 0u ? cnt : 1u;
}

__device__ __forceinline__ void xcd_barrier(const XcdBarrier& b) {
    asm volatile("s_waitcnt vmcnt(0)" ::: "memory");
    __syncthreads();
    if (threadIdx.x == 0) {
        unsigned* bar = b.bar;
        __builtin_amdgcn_s_waitcnt(0);
        unsigned nloc = b.st[0], nx = b.st[1];
        if (nloc == 0u) { xcd_barrier_complete(bar, b.x, nloc, nx); b.st[0] = nloc; b.st[1] = nx; }
        const unsigned old = xb_add(&bar[XB_XSUB(b.x)], 1u);
        const unsigned gen = old / nloc;
        if (old + 1u == (gen + 1u) * nloc) {
            __builtin_amdgcn_fence(__ATOMIC_RELEASE, "agent");
            asm volatile("s_waitcnt vmcnt(0)" ::: "memory");
            const unsigned og = xb_add(&bar[XB_TOP], 1u);
            const unsigned tg = og / nx;
            if (og + 1u == (tg + 1u) * nx) xb_add(&bar[XB_TOPGEN], 1u);
            else XB_SPIN(xb_ld(&bar[XB_TOPGEN]) == tg, bar);
            __builtin_amdgcn_fence(__ATOMIC_ACQUIRE, "agent");
            xb_add(&bar[XB_XGEN(b.x)], 1u);
            asm volatile("s_waitcnt vmcnt(0)" ::: "memory");
        } else {
            XB_SPIN(xb_ld(&bar[XB_XGEN(b.x)]) == gen, bar);
            __builtin_amdgcn_fence(__ATOMIC_ACQUIRE, "agent");
            asm volatile("s_waitcnt vmcnt(0)" ::: "memory");
        }
    }
    __syncthreads();
}
constexpr int CW_ZDONE = 9216;
namespace pg8 {
struct OneUnit { int pm, pn;
    __device__ __forceinline__ bool next(int i, Unit& u) const { if (i) return false; u.pm = pm; u.pn = pn; return true; }
    __device__ __forceinline__ void a_ready(const Unit&) const {}
    __device__ __forceinline__ void done(const Unit&) const {} };
}
__device__ __forceinline__ void cf_item(const Args& a, int item, LAS unsigned char* lds) {
    const int tid = threadIdx.x, lane = tid & 63, fr = lane & 15, fq = lane >> 4, wid = tid >> 6;
    const bf16* XB = (const bf16*)(a.ws + WS_XB); const bf16* W = (const bf16*)(a.ws + WS_WIN1) + (size_t)3584 * DM; const float* SS = (const float*)(a.ws + WS_SS1); float* logf2 = (float*)(a.ws + WS_LOGF);
    const int row0 = item * 64, k0 = wid * 128 + 8 * fq;
    const bf16* wp = W + (size_t)fr * DM + k0; const bf16* xp = XB + (size_t)(row0 + fr) * DM + k0;
    bf16x8 wf[4], xf[4][4];
#pragma unroll
    for (int ks = 0; ks < 4; ++ks) { wf[ks] = *(const bf16x8*)(wp + 32 * ks);
#pragma unroll
        for (int g = 0; g < 4; ++g) xf[g][ks] = *(const bf16x8*)(xp + (size_t)(16 * g) * DM + 32 * ks); }
    f32x4 acc[4];
#pragma unroll
    for (int g = 0; g < 4; ++g) { acc[g] = (f32x4){0.f, 0.f, 0.f, 0.f};
#pragma unroll
        for (int ks = 0; ks < 4; ++ks) acc[g] = __builtin_amdgcn_mfma_f32_16x16x32_bf16(wf[ks], xf[g][ks], acc[g], 0, 0, 0); }
    LAS float* part = (LAS float*)lds;
#pragma unroll
    for (int g = 0; g < 4; ++g) *(LAS f32x4*)(part + (wid * 64 + 16 * g + fr) * 16 + 4 * fq) = acc[g];
    __syncthreads();
    { const int r = tid >> 3, n0 = (tid & 7) * 2;
      float v0 = 0.f, v1 = 0.f;
#pragma unroll
      for (int w = 0; w < 8; ++w) { v0 += part[(w * 64 + r) * 16 + n0]; v1 += part[(w * 64 + r) * 16 + n0 + 1]; }
      const int row = row0 + r; float ss = 0.f;
#pragma unroll
      for (int q = 0; q < 4; ++q) { const f32x4 sp = *(const f32x4*)(SS + (size_t)row * 16 + 4 * q); ss += (sp[0] + sp[1]) + (sp[2] + sp[3]); }
      const float rstd = rsqrtf(ss * (1.f / DM) + EPS); const int b = row / SEQ, t = row % SEQ;
      if (n0 < 12) { logf2[((size_t)b * 12 + n0) * SEQ + t] = logsig2(v0 * rstd + a.in[12][n0]); logf2[((size_t)b * 12 + n0 + 1) * SEQ + t] = logsig2(v1 * rstd + a.in[12][n0 + 1]); } }
    __syncthreads();
}

#ifndef PROBE_REP
#define PROBE_REP -1
#endif
#ifndef MK_ONE_LAUNCH
#define MK_ONE_LAUNCH 1
#endif
constexpr int NPHASE = 9;
constexpr int LDS_BYTES = 147456;
constexpr int LDSCTL_OFF = 135168;
constexpr int CW_BAR = 4096;
constexpr int CW_Q0 = 64, CW_Q1 = 128, CW_Q0B = 192;
constexpr int CW_MCNT = 8192;
constexpr size_t WS_SLAB = 200 * MiB;
constexpr size_t WS_END2 = 250 * MiB;
constexpr size_t DO_MLIST = 0, DO_SLABL = 8 * MiB;
__global__ void __launch_bounds__(512, 2) mk_fwd(Args a) {
    extern __shared__ __attribute__((aligned(16))) unsigned char lds_raw[];
    LAS unsigned char* lds = (LAS unsigned char*)lds_raw;
    const int G = gridDim.x, bx = blockIdx.x; const int vcu = (G % 8 == 0) ? (bx % 8) * (G / 8) + bx / 8 : bx;
    unsigned char* ws = a.ws; unsigned* ctl = (unsigned*)(ws + WS_CTL);
    bf16* XB = (bf16*)(ws + WS_XB); bf16* P = (bf16*)(ws + WS_P); bf16* Y = (bf16*)(ws + WS_Y);
    float* kmean = (float*)(ws + WS_KMEAN); float* logf2 = (float*)(ws + WS_LOGF); float* SS0 = (float*)(ws + WS_SS0); float* SS1 = (float*)(ws + WS_SS1);
    const att::MobaBufs mb{ctl + CW_MCNT, (unsigned short*)((unsigned char*)a.out + DO_MLIST), (bf16*)(ws + WS_SLAB), (float*)((unsigned char*)a.out + DO_SLABL)};
    volatile LAS unsigned* MISC = (volatile LAS unsigned*)(lds + LDSCTL_OFF);
    if (threadIdx.x < 64) MISC[threadIdx.x] = 0u;
    __syncthreads();
    XcdBarrier bar; bar.bar = ctl + CW_BAR; bar.x = 0; bar.st = nullptr;
    if (MK_ONE_LAUNCH) bar = xcd_barrier_post(ctl + CW_BAR, MISC + 8);
#define IN(k) (a.ph_lo <= (k) && (k) < a.ph_hi)
#define SEAM(k) do { if (MK_ONE_LAUNCH && IN(k) && IN((k) + 1)) xcd_barrier(bar); } while (0)
#define PH_PRO() do { if (IN(0)) phase_prologue(a, lds, vcu, G); SEAM(0); } while (0)
#define PH_IN0() do { if (IN(1)) { pg8::Gemm g{XB, (const bf16*)(ws + WS_WIN0), T, N0, DM}; pg8::StaticOrder S; S.init(T, N0, G, bx); \
        pg8::EpiProj E{0, P, SS0, a.in[4], nullptr, kmean, logf2}; pg8::gemm_phase<pg8::EpiProj, pg8::StaticOrder, true, true>(lds, g, S, E); } SEAM(1); } while (0)
#define PH_A0A(q) do { if (IN(2)) att::attn_phase(0, a, lds, ctl + (q), mb); } while (0)
#define PH_A0B(q) do { if (MOBA_GATHER) { if (IN(3)) att::moba_kv_phase(a, mb, lds, ctl + (q)); SEAM(3); } } while (0)
#define PH_A0C() do { if (MOBA_GATHER) { if (IN(4)) att::moba_combine(a, mb, vcu, G); SEAM(4); } } while (0)
#define PH_OUT0() do { if (IN(5)) { pg8::Gemm g{Y, (const bf16*)(ws + WS_WOUT0), T, DM, DM}; pg8::StaticOrder S; S.init(T, DM, G, bx); \
        pg8::EpiOut0 E{a.in[0], XB, SS1}; pg8::gemm_phase<pg8::EpiOut0, pg8::StaticOrder, true, true>(lds, g, S, E); } SEAM(5); } while (0)
#define PH_IN1() do { if (IN(6)) { pg8::Gemm g{XB, (const bf16*)(ws + WS_WIN1), T, 3072, DM}; pg8::StaticOrder S; S.init(T, 3072, G, bx); \
        pg8::EpiProj E{1, P, SS1, a.in[11], a.in[12], kmean, logf2}; pg8::gemm_phase<pg8::EpiProj, pg8::StaticOrder, true, true>(lds, g, S, E); \
        for (int it = vcu; it < T / 64; it += G) cf_item(a, it, lds); } SEAM(6); } while (0)
#define PH_A1(q) do { if (IN(7)) { for (int zi = vcu; zi < 128; zi += G) {         \
            pg8::Gemm g{XB, (const bf16*)(ws + WS_WIN1), T, N1, DM}; pg8::OneUnit S{zi >> 1, 12 + (zi & 1)}; \
            pg8::EpiProj E{1, P, SS1, a.in[11], a.in[12], kmean, logf2}; pg8::gemm_phase<pg8::EpiProj, pg8::OneUnit, true, true>(lds, g, S, E); \
            asm volatile("s_waitcnt vmcnt(0)" ::: "memory"); __syncthreads(); \
            if (threadIdx.x == 0) { __builtin_amdgcn_fence(__ATOMIC_RELEASE, "agent"); asm volatile("s_waitcnt vmcnt(0)" ::: "memory"); __hip_atomic_fetch_add(ctl + CW_ZDONE, 1u, __ATOMIC_RELAXED, __HIP_MEMORY_SCOPE_AGENT); } } \
        att::attn_phase(1, a, lds, ctl + (q), mb); } SEAM(7); } while (0)
#define PH_OUT1() do { if (IN(8)) { pg8::Gemm g{Y, (const bf16*)(ws + WS_WOUT1), T, DM, DM}; pg8::StaticOrder S; S.init(T, DM, G, bx); \
        pg8::EpiOut1 E{XB, a.out}; pg8::gemm_phase<pg8::EpiOut1, pg8::StaticOrder, true, true>(lds, g, S, E); } } while (0)
    PH_PRO();
#if PROBE_REP == 0
    PH_PRO();
#endif
    PH_IN0();
#if PROBE_REP == 1
    PH_IN0();
#endif
    PH_A0A(CW_Q0);
    PH_A0B(CW_Q0B);
#if PROBE_REP == 3
    PH_A0B(CW_Q0B + 256);
#endif
    PH_A0C();
#if PROBE_REP == 4
    PH_A0C();
#endif
#if PROBE_REP == 5
    PH_OUT0();
#endif
    PH_OUT0();
    PH_IN1();
#if PROBE_REP == 6
    PH_IN1();
#endif
    PH_A1(CW_Q1);
#if PROBE_REP == 7
    PH_A1(CW_Q1 + 256);
#endif
    PH_OUT1();
#undef IN
#undef SEAM
}

extern "C" void kernel_launch(void* const* d_in, const int* in_sizes, int n_in, void* d_out, int out_size, void* d_ws, size_t ws_size, hipStream_t stream) {
    static int grid = 0;
    if (grid == 0) {
        if (n_in != 16 || out_size != T * DM || ws_size < WS_END2) { fprintf(stderr, "kernel_launch: unexpected shapes (n_in %d out %d ws %zu)\n", n_in, out_size, ws_size); grid = -1; return; }
        int dev = 0, cus = 0, per_cu = 0;
        (void)hipGetDevice(&dev); (void)hipDeviceGetAttribute(&cus, hipDeviceAttributeMultiprocessorCount, dev);
        (void)hipFuncSetAttribute((const void*)mk_fwd, hipFuncAttributeMaxDynamicSharedMemorySize, LDS_BYTES);
        (void)hipOccupancyMaxActiveBlocksPerMultiprocessor(&per_cu, (const void*)mk_fwd, 512, LDS_BYTES);
        (void)hipGetLastError();
        grid = cus * (per_cu >= 1 ? 1 : 0); if (grid <= 0) { fprintf(stderr, "kernel_launch: occupancy query says 0 workgroups per CU\n"); grid = -1; return; }
    }
    if (grid < 0) return;
    unsigned char* ws = (unsigned char*)d_ws;
    (void)hipMemsetAsync(ws + WS_CTL, 0, CTL_ZERO_BYTES, stream);
    Args a{}; for (int i = 0; i < 16; ++i) a.in[i] = (const float*)d_in[i];
    a.out = (float*)d_out; a.ws = ws;
#define RUN(lo, hi) do { a.ph_lo = (lo); a.ph_hi = (hi); hipLaunchKernelGGL(mk_fwd, dim3(grid), dim3(512), LDS_BYTES, stream, a); } while (0)
    if (MK_ONE_LAUNCH) RUN(0, NPHASE);
    else { for (int k = 0; k < NPHASE; ++k) RUN(k, k + 1); }
#undef RUN
}
```

```cpp
#include <hip/hip_runtime.h>
#include <cstdint>
#include <cstdio>

#define GAS __attribute__((address_space(1)))
#define LAS __attribute__((address_space(3)))
typedef unsigned short bf16;
typedef unsigned v4u __attribute__((ext_vector_type(4)));
typedef unsigned u32x4 __attribute__((ext_vector_type(4)));
typedef unsigned v2u __attribute__((ext_vector_type(2)));
typedef float f32x4 __attribute__((ext_vector_type(4)));
typedef float f32x16 __attribute__((ext_vector_type(16)));
typedef short bf16x8 __attribute__((ext_vector_type(8)));

constexpr int BATCH = 2, SEQ = 8192, T = BATCH * SEQ, DM = 1024, HD = 64, MEML = 256;
constexpr int N0 = 3072;
constexpr int N1REF = 3596;
constexpr int N1 = 3840;
constexpr int LDP = 3584;
constexpr float EPS = 1e-6f;
constexpr float LOG2E = 1.4426950408889634f;
constexpr float C2 = 0.125f * LOG2E;
constexpr int L0_AQ = 0, L0_AK = 384, L0_AV = 512, L0_BQ = 640, L0_BK = 1024, L0_BV = 1408, L0_MQ = 1792, L0_Z = 2048;
constexpr int L1_CQ = 0, L1_CK = 768, L1_CV = 1536, L1_MQ = 2304, L1_Z = 2560, L1_CF = 3584;

constexpr size_t MiB = 1u << 20;
constexpr size_t WS_CTL = 0, CTL_ZERO_BYTES = 1 * MiB;
constexpr size_t WS_KMEAN = 512 * 1024;
constexpr size_t WS_WIN0 = 2 * MiB, WS_WOUT0 = 8 * MiB, WS_WIN1 = 10 * MiB, WS_WOUT1 = 18 * MiB;
constexpr size_t WS_SS0 = 20 * MiB, WS_SS1 = 21 * MiB;
constexpr size_t WS_LOGF = 22 * MiB;
constexpr size_t WS_MKV = 23 * MiB;
constexpr size_t MKV_ONE = (size_t)BATCH * MEML * 256 * 2;
constexpr size_t WS_XB = 24 * MiB;
constexpr size_t WS_P = 56 * MiB;
constexpr size_t WS_Y = 168 * MiB;
constexpr size_t WS_END = 200 * MiB;

__device__ __forceinline__ float bf2f(bf16 v) { return __uint_as_float((unsigned)v << 16); }
__device__ __forceinline__ unsigned f2bf(float f) { unsigned u = __float_as_uint(f); return (u + 0x7fffu + ((u >> 16) & 1u)) >> 16; }
__device__ __forceinline__ unsigned pk2(float lo, float hi) { return f2bf(lo) | (f2bf(hi) << 16); }
__device__ __forceinline__ float wave_sum(float v) {
#pragma unroll
    for (int o = 1; o < 64; o <<= 1) v += __shfl_xor(v, o);
    return v;
}
__device__ __forceinline__ float fexp2(float x) { return __builtin_amdgcn_exp2f(x); }
__device__ __forceinline__ float silu_f(float z) { return z * __builtin_amdgcn_rcpf(1.f + __builtin_amdgcn_exp2f(-LOG2E * z)); }
__device__ __forceinline__ float logsig2(float f) { return LOG2E * (fminf(f, 0.f) - log1pf(__expf(-fabsf(f)))); }
__device__ __forceinline__ float alibi_slope2(int h) { return LOG2E * exp2f(-8.0f * (float)(h + 1) / 12.0f); }

struct Args {
    const float* in[16]; float* out; unsigned char* ws; int ph_lo, ph_hi;
};
enum { HK_QNORM = 0, HK_KNORM = 1, HK_PLAIN = 2, HK_SILU = 3, HK_BK = 4, HK_CF = 5, HK_NONE = 6 };
struct HeadInfo { int kind; int gidx; int dstcol; };
__device__ __forceinline__ HeadInfo head_info(int layer, int hh) {
    HeadInfo h; h.dstcol = hh * 64; h.gidx = 0;
    if (layer == 0) {
        if (hh < 6) { h.kind = HK_QNORM; h.gidx = 0; } else if (hh < 8) { h.kind = HK_KNORM; h.gidx = 1; } else if (hh < 10) h.kind = HK_PLAIN;
        else if (hh < 16) { h.kind = HK_QNORM; h.gidx = 2; } else if (hh < 22) { h.kind = HK_BK; h.gidx = 3; } else if (hh < 28) h.kind = HK_PLAIN;
        else if (hh < 32) { h.kind = HK_QNORM; h.gidx = 4; } else h.kind = HK_SILU;
    } else {
        if (hh < 12) { h.kind = HK_QNORM; h.gidx = 0; } else if (hh < 24) { h.kind = HK_KNORM; h.gidx = 1; } else if (hh < 36) h.kind = HK_PLAIN;
        else if (hh < 40) { h.kind = HK_QNORM; h.gidx = 2; } else if (hh < 56) h.kind = HK_SILU; else if (hh == 56) h.kind = HK_CF; else h.kind = HK_NONE;
    }
    return h;
}

constexpr int PRO_NW = 8;

__device__ __forceinline__ int l1_refcol(int n) {
    if (n < 2304) return n;
    if (n < 3584) return n + 12;
    if (n < 3596) return n - 3584 + 2304;
    return -1;
}
__device__ __forceinline__ void pro_transpose_item(const float* W, const float* g, int K, int Nref, int nblk, bf16* WT, bool remap, LAS float* scr, int item, int lane) {
    const int kb = item / nblk, nb = item % nblk, k0 = 64 * kb, n0 = 32 * nb;
    const int np = n0 + (lane & 31); const int rc = remap ? l1_refcol(np) : np;
    float wv[32];
#pragma unroll
    for (int i = 0; i < 32; ++i) { const int kk = 2 * i + (lane >> 5); wv[i] = (rc >= 0) ? __builtin_nontemporal_load(W + (size_t)(k0 + kk) * Nref + rc) : 0.f; }
    const float gl = g ? g[k0 + (lane & 63)] : 1.f;
#pragma unroll
    for (int i = 0; i < 32; ++i) { const int kk = 2 * i + (lane >> 5); const float gk = __shfl(gl, kk); scr[kk * 33 + (lane & 31)] = wv[i] * gk; }
    asm volatile("s_waitcnt lgkmcnt(0)" ::: "memory");
    const int c = lane & 7;
#pragma unroll
    for (int j = 0; j < 4; ++j) { const int n = (lane >> 3) + 8 * j; const LAS float* s = scr + (8 * c) * 33 + n;
        v4u o; o.x = pk2(s[0 * 33], s[1 * 33]); o.y = pk2(s[2 * 33], s[3 * 33]); o.z = pk2(s[4 * 33], s[5 * 33]); o.w = pk2(s[6 * 33], s[7 * 33]);
        *(v4u*)(WT + (size_t)(n0 + n) * K + k0 + 8 * c) = o; }
    asm volatile("s_waitcnt lgkmcnt(0)" ::: "memory");
}
__device__ __forceinline__ void pro_row(const float* xrow, bf16* orow, float* ssrow, int lane) {
    const f32x4* xr = (const f32x4*)xrow + lane; f32x4 v[4]; float s = 0.f;
#pragma unroll
    for (int j = 0; j < 4; ++j) { v[j] = xr[64 * j]; s += (v[j].x * v[j].x + v[j].y * v[j].y) + (v[j].z * v[j].z + v[j].w * v[j].w); }
    s = wave_sum(s);
    v2u* o8 = (v2u*)orow + lane;
#pragma unroll
    for (int j = 0; j < 4; ++j) { v2u w; w.x = pk2(v[j].x, v[j].y); w.y = pk2(v[j].z, v[j].w); o8[64 * j] = w; }
    if (lane < 16) ssrow[lane] = lane == 0 ? s : 0.f;
}
__device__ __forceinline__ void pro_memkv_task(const float* mem, const float* gm, const float* W, const float* kg, bf16* MK, bf16* MV, int rt, int ct, LAS unsigned char* lds) {
    const int tid = threadIdx.x, lane = tid & 63, w = tid >> 6, r32 = lane & 31, hi = lane >> 5;
    LAS float* part = (LAS float*)lds; LAS float* rs = (LAS float*)(lds + 133120);
    { f32x4 rv[8][4];
#pragma unroll
      for (int i = 0; i < 8; ++i) { const f32x4* xr = (const f32x4*)(mem + (size_t)(rt * 64 + 8 * w + i) * DM) + lane;
#pragma unroll
          for (int j = 0; j < 4; ++j) rv[i][j] = xr[64 * j]; }
#pragma unroll
      for (int i = 0; i < 8; ++i) { float s = 0.f;
#pragma unroll
          for (int j = 0; j < 4; ++j) { const f32x4 v = rv[i][j]; s += (v.x * v.x + v.y * v.y) + (v.z * v.z + v.w * v.w); }
          s = wave_sum(s); if (lane == 0) rs[8 * w + i] = rsqrtf(s * (1.f / DM) + EPS); } }
    f32x16 acc[2][2];
#pragma unroll
    for (int a = 0; a < 2; ++a)
#pragma unroll
        for (int b = 0; b < 2; ++b) acc[a][b] = f32x16{};
#pragma unroll 2
    for (int ks = 0; ks < 8; ++ks) { const int k0 = 128 * w + 16 * ks + 8 * hi;
        bf16x8 wf[2], hf[2];
#pragma unroll
        for (int cb = 0; cb < 2; ++cb) { const float* wp = W + (size_t)k0 * 512 + ct * 64 + 32 * cb + r32;
#pragma unroll
            for (int j = 0; j < 8; ++j) wf[cb][j] = (short)f2bf(wp[(size_t)j * 512]); }
        const f32x4 g0 = *(const f32x4*)(gm + k0), g1 = *(const f32x4*)(gm + k0 + 4);
#pragma unroll
        for (int ra = 0; ra < 2; ++ra) { const float* mp = mem + (size_t)(rt * 64 + 32 * ra + r32) * DM + k0; const f32x4 a0 = *(const f32x4*)mp, a1 = *(const f32x4*)(mp + 4);
            hf[ra][0] = (short)f2bf(a0.x * g0.x); hf[ra][1] = (short)f2bf(a0.y * g0.y); hf[ra][2] = (short)f2bf(a0.z * g0.z); hf[ra][3] = (short)f2bf(a0.w * g0.w);
            hf[ra][4] = (short)f2bf(a1.x * g1.x); hf[ra][5] = (short)f2bf(a1.y * g1.y); hf[ra][6] = (short)f2bf(a1.z * g1.z); hf[ra][7] = (short)f2bf(a1.w * g1.w); }
#pragma unroll
        for (int cb = 0; cb < 2; ++cb)
#pragma unroll
            for (int ra = 0; ra < 2; ++ra) acc[cb][ra] = __builtin_amdgcn_mfma_f32_32x32x16_bf16(wf[cb], hf[ra], acc[cb][ra], 0, 0, 0);
    }
#pragma unroll
    for (int cb = 0; cb < 2; ++cb)
#pragma unroll
        for (int ra = 0; ra < 2; ++ra)
#pragma unroll
            for (int r = 0; r < 16; ++r) { const int n = 32 * cb + (r & 3) + 8 * (r >> 2) + 4 * hi; part[(w * 64 + 32 * ra + r32) * 65 + n] = acc[cb][ra][r]; }
    __syncthreads();
    { const int tok = tid >> 3, c0 = (tid & 7) * 8; float v[8];
#pragma unroll
      for (int i = 0; i < 8; ++i) v[i] = 0.f;
      for (int ww = 0; ww < 8; ++ww) {
#pragma unroll
          for (int i = 0; i < 8; ++i) v[i] += part[(ww * 64 + tok) * 65 + c0 + i]; }
      const float r = rs[tok]; float ss = 0.f;
#pragma unroll
      for (int i = 0; i < 8; ++i) { v[i] *= r; ss += v[i] * v[i]; }
      ss += __shfl_xor(ss, 1); ss += __shfl_xor(ss, 2); ss += __shfl_xor(ss, 4);
      const int row = rt * 64 + tok;
      bf16* dst;
      if (ct < 4) { const float inv = rsqrtf(ss * (1.f / 64.f) + EPS);
#pragma unroll
          for (int i = 0; i < 8; ++i) v[i] *= inv * kg[c0 + i];
          dst = MK + (size_t)row * 256 + ct * 64 + c0; }
      else dst = MV + (size_t)row * 256 + (ct - 4) * 64 + c0;
      v4u o; o.x = pk2(v[0], v[1]); o.y = pk2(v[2], v[3]); o.z = pk2(v[4], v[5]); o.w = pk2(v[6], v[7]); *(v4u*)dst = o; }
    __syncthreads();
}

__device__ __forceinline__ void phase_prologue(const Args& a, LAS unsigned char* lds, int vcu, int G) {
    const int tid = threadIdx.x, lane = tid & 63, wave = __builtin_amdgcn_readfirstlane(tid >> 6);
    unsigned char* ws = a.ws;
    for (int wt = (G - 1 - vcu); wt < 128; wt += G) { const int layer = wt >> 6, rt = (wt >> 3) & 7, ct = wt & 7;
        const float* gm = layer ? a.in[13] : a.in[6]; const float* W = layer ? a.in[14] : a.in[7];
        const float* kg = layer ? a.in[11] + 3 * 64 : a.in[4] + 5 * 64;
        bf16* MK = (bf16*)(ws + WS_MKV + (size_t)(2 * layer) * MKV_ONE); bf16* MV = (bf16*)(ws + WS_MKV + (size_t)(2 * layer + 1) * MKV_ONE);
        pro_memkv_task(a.in[1], gm, W, kg, MK, MV, rt, ct, lds); }
    LAS float* scr = (LAS float*)(lds + wave * 16384);
    const int gw = vcu * PRO_NW + wave, NGW = G * PRO_NW;
    constexpr int I_IN0 = 16 * (N0 / 32), I_OUT = 16 * (DM / 32), I_IN1 = 16 * (N1 / 32);
    constexpr int NITEMS = I_IN0 + I_OUT + I_IN1 + I_OUT;
    for (int it = gw; it < NITEMS; it += NGW) { int r = it;
        if (r < I_IN0) { pro_transpose_item(a.in[3], a.in[2], DM, N0, N0 / 32, (bf16*)(ws + WS_WIN0), false, scr, r, lane); continue; } r -= I_IN0;
        if (r < I_OUT) { pro_transpose_item(a.in[8], nullptr, DM, DM, DM / 32, (bf16*)(ws + WS_WOUT0), false, scr, r, lane); continue; } r -= I_OUT;
        if (r < I_IN1) { pro_transpose_item(a.in[10], a.in[9], DM, N1REF, N1 / 32, (bf16*)(ws + WS_WIN1), true, scr, r, lane); continue; } r -= I_IN1;
        pro_transpose_item(a.in[15], nullptr, DM, DM, DM / 32, (bf16*)(ws + WS_WOUT1), false, scr, r, lane); }
    const float* x = a.in[0]; bf16* XB = (bf16*)(ws + WS_XB); float* SS0 = (float*)(ws + WS_SS0);
    for (int m0 = gw * 4; m0 < T; m0 += NGW * 4) {
        f32x4 v[4][4];
#pragma unroll
        for (int r = 0; r < 4; ++r) { const f32x4* xr = (const f32x4*)(x + (size_t)(m0 + r) * DM) + lane;
#pragma unroll
            for (int j = 0; j < 4; ++j) v[r][j] = __builtin_nontemporal_load(xr + 64 * j); }
#pragma unroll
        for (int r = 0; r < 4; ++r) { float sq = 0.f;
#pragma unroll
            for (int j = 0; j < 4; ++j) sq += (v[r][j].x * v[r][j].x + v[r][j].y * v[r][j].y) + (v[r][j].z * v[r][j].z + v[r][j].w * v[r][j].w);
            sq = wave_sum(sq); v2u* o8 = (v2u*)(XB + (size_t)(m0 + r) * DM) + lane;
#pragma unroll
            for (int j = 0; j < 4; ++j) { v2u w; w.x = pk2(v[r][j].x, v[r][j].y); w.y = pk2(v[r][j].z, v[r][j].w); o8[64 * j] = w; }
            if (lane < 16) SS0[(size_t)(m0 + r) * 16 + lane] = lane == 0 ? sq : 0.f; } }
}
namespace pg8 {
#define PG8_LAS __attribute__((address_space(3)))
typedef unsigned short bf16_t;
typedef short bf16x8 __attribute__((ext_vector_type(8)));
typedef float f32x4 __attribute__((ext_vector_type(4)));
typedef unsigned u32x4 __attribute__((ext_vector_type(4)));
constexpr int BM = 256, BK = 64, HALF = 128, HTB = HALF * BK * 2  , STAGE_BYTES = 8 * HTB, NXCD = 8, WGM = 8;

__host__ __device__ __forceinline__ int lds_byte(int r, int c) { const int st = (r >> 4) * 2 + (c >> 5), rr = r & 15, cc = c & 31, ob = rr * 64 + cc * 2; return st * 1024 + (ob ^ (((ob >> 9) & 1) << 5)); }
__host__ __device__ __forceinline__ void stage_rc(int b, int& R, int& C) { const int st = b / 1024, sb = b % 1024, swz = sb ^ (((sb >> 9) & 1) << 5); R = (st >> 1) * 16 + swz / 64; C = (st & 1) * 32 + (swz % 64) / 2; }
__host__ __device__ __forceinline__ int perm32(int rho) { const int n = rho >> 4, i = rho & 15; return 8 * (i >> 2) + 4 * n + (i & 3); }

struct Unit { int pm, pn; };
struct Gemm { const bf16_t* A; const bf16_t* Bt; int M, N, K; };

struct StaticOrder {
    int nM, nN, nwg, G, c;
    __host__ __device__ void init(int M, int N, int G_, int c_) { nM = M / BM; nN = N / BM; nwg = nM * nN; G = G_; c = c_; }
    __host__ __device__ bool next(int i, Unit& u) const {
        const long L = (long)i * G + c; if (L >= nwg) return false;
        int wgid = (int)L; { const int q = nwg / NXCD, r = nwg % NXCD, xcd = wgid % NXCD, off = wgid / NXCD; wgid = (xcd < r ? xcd * (q + 1) : r * (q + 1) + (xcd - r) * q) + off; }
        const int nig = WGM * nN, gid = wgid / nig, fm = gid * WGM, gsz = (nM - fm) < WGM ? (nM - fm) : WGM;
        u.pm = fm + ((wgid % nig) % gsz); u.pn = (wgid % nig) / gsz; return true;
    }
    __device__ __forceinline__ void a_ready(const Unit&) const {}
    __device__ __forceinline__ void done(const Unit&) const {}
};
template <class Epi, class Sched, bool ALIGN_EPI = false, bool SP2 = false>
__device__ __forceinline__ void gemm_phase(PG8_LAS unsigned char* lds, const Gemm g, const Sched& S, const Epi& E) {
    const int tid = threadIdx.x, wid = __builtin_amdgcn_readfirstlane(tid >> 6), lane = tid & 63, wr = wid >> 2, wc = wid & 3, fr = lane & 15, fq = lane >> 4;
    const int K = g.K, nt = K / BK;
    unsigned voffA[2], voffB[2];
#pragma unroll
    for (int i = 0; i < 2; ++i) { int R, C; stage_rc(tid * 16 + i * 8192, R, C); const int Rb = 64 * (R >> 5) + perm32(R & 31);
        voffA[i] = (unsigned)(R * K + C) * 2u; voffB[i] = (unsigned)(Rb * K + C) * 2u; }
    const size_t kstep = (size_t)(BK * 2);
    const size_t hstep = (size_t)HALF * K * 2;
    const size_t hstepB = (size_t)32 * K * 2;
    const size_t tstep = 2 * hstep;
    const unsigned ldsw = (unsigned)wid * 1024u;
    const int aoff = lds_byte(wr * 64 + fr, fq * 8), boff = lds_byte(wc * 32 + fr, fq * 8);
#define PG8_SA(b, h) (((b) * 2 + (h)) * HTB)
#define PG8_SB(b, h) ((4 + (b) * 2 + (h)) * HTB)
#define PG8_STAGE(bufoff, gbase, voff) do { _Pragma("unroll") for (int _i = 0; _i < 2; ++_i) \
        __builtin_amdgcn_global_load_lds((const unsigned*)((const char*)(gbase) + (voff)[_i]), (PG8_LAS unsigned*)(lds + (bufoff) + ldsw + _i * 8192), 16, 0, 0); } while (0)
#define PG8_LDA(dst, b, h) do { _Pragma("unroll") for (int m = 0; m < 4; ++m) _Pragma("unroll") for (int k = 0; k < 2; ++k) dst[m][k] = *(const PG8_LAS bf16x8*)(lds + PG8_SA(b, h) + aoff + m * 2048 + k * 1024); } while (0)
#define PG8_LDB(dst, b, h) do { _Pragma("unroll") for (int n = 0; n < 2; ++n) _Pragma("unroll") for (int k = 0; k < 2; ++k) dst[n][k] = *(const PG8_LAS bf16x8*)(lds + PG8_SB(b, h) + boff + n * 2048 + k * 1024); } while (0)
#define PG8_MMA(ai, bj, At, Bt) do { __builtin_amdgcn_s_setprio(1); _Pragma("unroll") for (int m = 0; m < 4; ++m) _Pragma("unroll") for (int n = 0; n < 2; ++n) _Pragma("unroll") for (int k = 0; k < 2; ++k) \
        acc[ai][bj][m][n] = __builtin_amdgcn_mfma_f32_16x16x32_bf16(Bt[n][k], At[m][k], acc[ai][bj][m][n], 0, 0, 0); __builtin_amdgcn_s_setprio(0); } while (0)
#define PG8_WAIT_V(n) asm volatile("s_waitcnt vmcnt(" #n ")" ::: "memory")
#define PG8_WAIT_L(n) asm volatile("s_waitcnt lgkmcnt(" #n ")" ::: "memory")
#define PG8_BAR __builtin_amdgcn_s_barrier()
#define PG8_SCHED __builtin_amdgcn_sched_barrier(0)
    Unit cur, nxt; int ui = 0;
    if (!S.next(0, cur)) return;
    f32x4 acc[2][2][4][2];
#pragma unroll
    for (int a = 0; a < 2; ++a)
#pragma unroll
        for (int b = 0; b < 2; ++b)
#pragma unroll
            for (int m = 0; m < 4; ++m)
#pragma unroll
                for (int n = 0; n < 2; ++n) acc[a][b][m][n] = (f32x4){0.f, 0.f, 0.f, 0.f};
    bf16x8 At[4][2], B0[2][2], B1[2][2];
    const char* cA = (const char*)g.A + (size_t)cur.pm * tstep; const char* cB = (const char*)g.Bt + (size_t)cur.pn * tstep;
    S.a_ready(cur);
    if constexpr (SP2) {
        PG8_STAGE(PG8_SB(0, 0), cB, voffB); PG8_STAGE(PG8_SB(0, 1), cB + hstepB, voffB); PG8_STAGE(PG8_SA(0, 0), cA, voffA); PG8_STAGE(PG8_SA(0, 1), cA + hstep, voffA);
        if (wr == 1) PG8_BAR;
        PG8_WAIT_V(2); PG8_BAR;
        PG8_STAGE(PG8_SB(1, 0), cB + kstep, voffB); PG8_STAGE(PG8_SA(1, 0), cA + kstep, voffA); PG8_STAGE(PG8_SB(1, 1), cB + hstepB + kstep, voffB);
        PG8_WAIT_V(6); PG8_BAR;
    } else {
        PG8_STAGE(PG8_SB(0, 0), cB, voffB); PG8_STAGE(PG8_SA(0, 0), cA, voffA); PG8_STAGE(PG8_SB(0, 1), cB + hstepB, voffB); PG8_STAGE(PG8_SA(0, 1), cA + hstep, voffA);
        if (wr == 1) PG8_BAR;
        PG8_WAIT_V(4); PG8_BAR;
        PG8_STAGE(PG8_SB(1, 0), cB + kstep, voffB); PG8_STAGE(PG8_SA(1, 0), cA + kstep, voffA); PG8_STAGE(PG8_SB(1, 1), cB + hstepB + kstep, voffB);
        PG8_WAIT_V(6); PG8_BAR;
    }
    for (;;) {
        const bool has_next = S.next(ui + 1, nxt);
        const char* nA = has_next ? (const char*)g.A + (size_t)nxt.pm * tstep : cA; const char* nB = has_next ? (const char*)g.Bt + (size_t)nxt.pn * tstep : cB;
        for (int t = 0; t < nt; t += 2) {
            const bool last = (t == nt - 2);
            const char* a1 = cA + (size_t)(t + 1) * kstep;
            const char* a2 = last ? nA : cA + (size_t)(t + 2) * kstep; const char* b2 = last ? nB : cB + (size_t)(t + 2) * kstep;
            const char* a3 = a2 + kstep; const char* b3 = b2 + kstep;
            if (last && has_next) S.a_ready(nxt);
            if constexpr (SP2) {
            PG8_LDB(B0, 0, 0); PG8_LDB(B1, 0, 1); PG8_SCHED; PG8_LDA(At, 0, 0); PG8_STAGE(PG8_SA(1, 1), a1 + hstep, voffA);
            PG8_WAIT_V(8); PG8_WAIT_L(0); PG8_BAR; PG8_MMA(0, 0, At, B0); PG8_MMA(0, 1, At, B1); PG8_BAR; PG8_SCHED;
            PG8_LDA(At, 0, 1); PG8_STAGE(PG8_SB(0, 0), b2, voffB); PG8_STAGE(PG8_SB(0, 1), b2 + hstepB, voffB); PG8_STAGE(PG8_SA(0, 0), a2, voffA);
            PG8_WAIT_V(8); PG8_WAIT_L(0); PG8_BAR; PG8_MMA(1, 0, At, B0); PG8_MMA(1, 1, At, B1); PG8_BAR; PG8_SCHED;
            PG8_LDB(B0, 1, 0); PG8_LDB(B1, 1, 1); PG8_SCHED; PG8_LDA(At, 1, 0); PG8_STAGE(PG8_SA(0, 1), a2 + hstep, voffA);
            PG8_WAIT_V(8); PG8_WAIT_L(0); PG8_BAR; PG8_MMA(0, 0, At, B0); PG8_MMA(0, 1, At, B1); PG8_BAR; PG8_SCHED;
            PG8_LDA(At, 1, 1); PG8_STAGE(PG8_SB(1, 0), b3, voffB); PG8_STAGE(PG8_SB(1, 1), b3 + hstepB, voffB); PG8_STAGE(PG8_SA(1, 0), a3, voffA);
            PG8_WAIT_V(8); PG8_WAIT_L(0); PG8_BAR; PG8_MMA(1, 0, At, B0); PG8_MMA(1, 1, At, B1); PG8_BAR; PG8_SCHED;
            } else {
            PG8_LDB(B0, 0, 0); PG8_SCHED; PG8_LDA(At, 0, 0); PG8_STAGE(PG8_SA(1, 1), a1 + hstep, voffA);
            PG8_WAIT_L(8); PG8_BAR; PG8_WAIT_L(0); PG8_MMA(0, 0, At, B0); PG8_BAR; PG8_SCHED;
            PG8_LDB(B1, 0, 1); PG8_STAGE(PG8_SB(0, 0), b2, voffB);
            PG8_BAR; PG8_WAIT_L(0); PG8_MMA(0, 1, At, B1); PG8_BAR;
            PG8_LDA(At, 0, 1); PG8_STAGE(PG8_SA(0, 0), a2, voffA);
            PG8_BAR; PG8_WAIT_L(0); PG8_MMA(1, 0, At, B0); PG8_BAR; PG8_SCHED;
            PG8_STAGE(PG8_SB(0, 1), b2 + hstepB, voffB);
            PG8_WAIT_V(6); PG8_BAR; PG8_MMA(1, 1, At, B1); PG8_BAR;
            PG8_LDB(B0, 1, 0); PG8_SCHED; PG8_LDA(At, 1, 0); PG8_STAGE(PG8_SA(0, 1), a2 + hstep, voffA);
            PG8_WAIT_L(8); PG8_BAR; PG8_WAIT_L(0); PG8_MMA(0, 0, At, B0); PG8_BAR; PG8_SCHED;
            PG8_LDB(B1, 1, 1); PG8_STAGE(PG8_SB(1, 0), b3, voffB);
            PG8_BAR; PG8_WAIT_L(0); PG8_MMA(0, 1, At, B1); PG8_BAR;
            PG8_LDA(At, 1, 1); PG8_STAGE(PG8_SA(1, 0), a3, voffA);
            PG8_BAR; PG8_WAIT_L(0); PG8_MMA(1, 0, At, B0); PG8_BAR; PG8_SCHED;
            PG8_STAGE(PG8_SB(1, 1), b3 + hstepB, voffB);
            PG8_WAIT_V(6); PG8_BAR; PG8_MMA(1, 1, At, B1); PG8_BAR;
            }
        }
        if constexpr (ALIGN_EPI) { if (wr == 0) PG8_BAR; }
        if constexpr (!Epi::AFTER_DRAIN) { E(acc, cur, wr, wc, fr, fq); S.done(cur); }
        if (!has_next) break;
#pragma unroll
        for (int a = 0; a < 2; ++a)
#pragma unroll
            for (int b = 0; b < 2; ++b)
#pragma unroll
                for (int m = 0; m < 4; ++m)
#pragma unroll
                    for (int n = 0; n < 2; ++n) acc[a][b][m][n] = (f32x4){0.f, 0.f, 0.f, 0.f};
        cur = nxt; cA = nA; cB = nB; ++ui;
        if constexpr (ALIGN_EPI) { if (wr == 1) PG8_BAR; }
    }
    PG8_WAIT_V(0);
    if constexpr (!ALIGN_EPI) { if (wr == 0) PG8_BAR; }
    PG8_BAR;
    if constexpr (Epi::AFTER_DRAIN) { E.fused(acc, cur, wr, wc, fr, fq, lds, wid, lane); S.done(cur); }
#undef PG8_SA
#undef PG8_SB
#undef PG8_STAGE
#undef PG8_LDA
#undef PG8_LDB
#undef PG8_MMA
#undef PG8_WAIT_V
#undef PG8_WAIT_L
#undef PG8_BAR
#undef PG8_SCHED
}
}
namespace pg8 {
__device__ __forceinline__ unsigned cvt_pk_bf16(float lo, float hi) { unsigned r; asm volatile("v_cvt_pk_bf16_f32 %0, %1, %2" : "=v"(r) : "v"(lo), "v"(hi)); return r; }

struct EpiProj {
    static constexpr bool AFTER_DRAIN = false;
    int layer; bf16* P; const float* SS; const float* qkg; const float* bfp; float* kmean; float* logf2;
    __device__ __forceinline__ void operator()(const f32x4 (&acc)[2][2][4][2], const Unit& u, int wr, int wc, int fr, int fq) const {
        const int hh = u.pn * 4 + wc; const HeadInfo hi = head_info(layer, hh);
        if (hi.kind == HK_NONE) return;
        const bool norm = (hi.kind == HK_QNORM || hi.kind == HK_KNORM || hi.kind == HK_BK);
        f32x4 gv[2][2];
#pragma unroll
        for (int bj = 0; bj < 2; ++bj)
#pragma unroll
            for (int n = 0; n < 2; ++n) gv[bj][n] = norm ? *(const f32x4*)(qkg + hi.gidx * 64 + 32 * bj + 8 * fq + 4 * n) : (f32x4){1.f, 1.f, 1.f, 1.f};
        const float qs = (hi.kind == HK_QNORM) ? C2 : 1.f;
        f32x4 ksum[2][2];
#pragma unroll
        for (int bj = 0; bj < 2; ++bj)
#pragma unroll
            for (int n = 0; n < 2; ++n) ksum[bj][n] = (f32x4){0.f, 0.f, 0.f, 0.f};
#pragma unroll
        for (int ai = 0; ai < 2; ++ai)
#pragma unroll
            for (int m = 0; m < 4; ++m) {
                const int row = u.pm * BM + ai * HALF + wr * 64 + m * 16 + fr;
                const f32x4 sp = *(const f32x4*)(SS + (size_t)row * 16 + 4 * fq);
                float ss = (sp[0] + sp[1]) + (sp[2] + sp[3]); ss += __shfl_xor(ss, 16); ss += __shfl_xor(ss, 32);
                const float rstd = rsqrtf(ss * (1.f / DM) + EPS);
                f32x4 v[2][2];
#pragma unroll
                for (int bj = 0; bj < 2; ++bj)
#pragma unroll
                    for (int n = 0; n < 2; ++n) v[bj][n] = acc[ai][bj][m][n] * rstd;
                if (hi.kind == HK_CF) {
                    const int b = row / SEQ, t = row % SEQ;
                    if (fq < 2) {
#pragma unroll
                        for (int n = 0; n < 2; ++n) if (fq == 0 || n == 0) {
#pragma unroll
                            for (int e = 0; e < 4; ++e) { const int c = 8 * fq + 4 * n + e; logf2[((size_t)b * 12 + c) * SEQ + t] = logsig2(v[0][n][e] + bfp[c]); } } }
                    continue;
                }
                if (norm) { float q = 0.f;
#pragma unroll
                    for (int bj = 0; bj < 2; ++bj)
#pragma unroll
                        for (int n = 0; n < 2; ++n) q += (v[bj][n][0] * v[bj][n][0] + v[bj][n][1] * v[bj][n][1]) + (v[bj][n][2] * v[bj][n][2] + v[bj][n][3] * v[bj][n][3]);
                    q += __shfl_xor(q, 16); q += __shfl_xor(q, 32);
                    const float inv = rsqrtf(q * (1.f / 64.f) + EPS) * qs;
#pragma unroll
                    for (int bj = 0; bj < 2; ++bj)
#pragma unroll
                        for (int n = 0; n < 2; ++n) v[bj][n] = v[bj][n] * gv[bj][n] * inv; }
                if (hi.kind == HK_SILU) {
#pragma unroll
                    for (int bj = 0; bj < 2; ++bj)
#pragma unroll
                        for (int n = 0; n < 2; ++n)
#pragma unroll
                            for (int e = 0; e < 4; ++e) v[bj][n][e] = silu_f(v[bj][n][e]); }
                if (hi.kind == HK_BK) {
#pragma unroll
                    for (int bj = 0; bj < 2; ++bj)
#pragma unroll
                        for (int n = 0; n < 2; ++n) ksum[bj][n] += v[bj][n]; }
                bf16* rowp = P + (size_t)row * LDP + hi.dstcol + 8 * fq;
#pragma unroll
                for (int bj = 0; bj < 2; ++bj) { u32x4 w; w.x = cvt_pk_bf16(v[bj][0][0], v[bj][0][1]); w.y = cvt_pk_bf16(v[bj][0][2], v[bj][0][3]); w.z = cvt_pk_bf16(v[bj][1][0], v[bj][1][1]); w.w = cvt_pk_bf16(v[bj][1][2], v[bj][1][3]);
                    *(u32x4*)(rowp + 32 * bj) = w; }
            }
        if (hi.kind == HK_BK) {
            const int b = u.pm / 32, blk = u.pm % 32, h = hh - 16; float* kp = kmean + (((size_t)b * 6 + h) * 32 + blk) * 64 + 8 * fq;
#pragma unroll
            for (int bj = 0; bj < 2; ++bj)
#pragma unroll
                for (int n = 0; n < 2; ++n)
#pragma unroll
                    for (int e = 0; e < 4; ++e) { float s = ksum[bj][n][e]; s += __shfl_xor(s, 1); s += __shfl_xor(s, 2); s += __shfl_xor(s, 4); s += __shfl_xor(s, 8);
                        if (fr == 0) atomicAdd(kp + 32 * bj + 4 * n + e, s); }
        }
    }
};

struct EpiOut0 {
    static constexpr bool AFTER_DRAIN = false;
    const float* xin; bf16* XB; float* SS;
    __device__ __forceinline__ void operator()(const f32x4 (&acc)[2][2][4][2], const Unit& u, int wr, int wc, int fr, int fq) const {
#pragma unroll
        for (int ai = 0; ai < 2; ++ai)
#pragma unroll
            for (int m = 0; m < 4; ++m) {
                const int row = u.pm * BM + ai * HALF + wr * 64 + m * 16 + fr; const size_t off = (size_t)row * DM + u.pn * BM + 64 * wc + 8 * fq; float ss = 0.f;
#pragma unroll
                for (int bj = 0; bj < 2; ++bj) {
                    const f32x4 x0 = __builtin_nontemporal_load((const f32x4*)(xin + off + 32 * bj)) + acc[ai][bj][m][0], x1 = __builtin_nontemporal_load((const f32x4*)(xin + off + 32 * bj + 4)) + acc[ai][bj][m][1];
                    ss += (x0[0] * x0[0] + x0[1] * x0[1]) + (x0[2] * x0[2] + x0[3] * x0[3]) + (x1[0] * x1[0] + x1[1] * x1[1]) + (x1[2] * x1[2] + x1[3] * x1[3]);
                    u32x4 w; w.x = cvt_pk_bf16(x0[0], x0[1]); w.y = cvt_pk_bf16(x0[2], x0[3]); w.z = cvt_pk_bf16(x1[0], x1[1]); w.w = cvt_pk_bf16(x1[2], x1[3]); *(u32x4*)(XB + off + 32 * bj) = w;
                }
                ss += __shfl_xor(ss, 16); ss += __shfl_xor(ss, 32); if (fq == 0) SS[(size_t)row * 16 + u.pn * 4 + wc] = ss;
            }
    }
};
struct EpiOut1 {
    static constexpr bool AFTER_DRAIN = false;
    const bf16* XB; float* xout;
    __device__ __forceinline__ void operator()(const f32x4 (&acc)[2][2][4][2], const Unit& u, int wr, int wc, int fr, int fq) const {
#pragma unroll
        for (int ai = 0; ai < 2; ++ai)
#pragma unroll
            for (int m = 0; m < 4; ++m) {
                const int row = u.pm * BM + ai * HALF + wr * 64 + m * 16 + fr; const size_t off = (size_t)row * DM + u.pn * BM + 64 * wc + 8 * fq;
#pragma unroll
                for (int bj = 0; bj < 2; ++bj) { const u32x4 w = *(const u32x4*)(XB + off + 32 * bj);
                    f32x4 x0, x1; x0[0] = __uint_as_float(w.x << 16); x0[1] = __uint_as_float(w.x & 0xffff0000u); x0[2] = __uint_as_float(w.y << 16); x0[3] = __uint_as_float(w.y & 0xffff0000u);
                    x1[0] = __uint_as_float(w.z << 16); x1[1] = __uint_as_float(w.z & 0xffff0000u); x1[2] = __uint_as_float(w.w << 16); x1[3] = __uint_as_float(w.w & 0xffff0000u);
                    __builtin_nontemporal_store(x0 + acc[ai][bj][m][0], (f32x4*)(xout + off + 32 * bj)); __builtin_nontemporal_store(x1 + acc[ai][bj][m][1], (f32x4*)(xout + off + 32 * bj + 4)); }
            }
    }
};
}
namespace att {
typedef LAS const char* lds_cptr;
typedef short s16x4 __attribute__((ext_vector_type(4)));
typedef short v4i16_t __attribute__((ext_vector_type(4)));
enum { M_SWA = 0, M_MOBA = 1, M_FOX = 2, M_MEM = 3 };
constexpr int SLOTB = 8192, LDS_K = 0, LDS_V = 3 * SLOTB, LDS_WS = 6 * SLOTB, WSB = 2048, LDS_OST = LDS_WS + 8 * WSB, LDS_END = LDS_OST + 8 * 4096;

__device__ __forceinline__ int crow(int r, int hi) { return (r & 3) + 8 * (r >> 2) + 4 * hi; }
__device__ __forceinline__ void glds16(const void* g, unsigned lds_base) {
    unsigned sv; asm volatile("s_mov_b32 %0, m0\n\ts_mov_b32 m0, %2\n\ts_nop 0\n\tglobal_load_lds_dwordx4 %1, off\n\ts_mov_b32 m0, %0" : "=&s"(sv) : "v"(g), "s"(lds_base) : "memory"); }
__device__ __forceinline__ void glds4(const void* g, unsigned lds_base) {
    unsigned sv; asm volatile("s_mov_b32 %0, m0\n\ts_mov_b32 m0, %2\n\ts_nop 0\n\tglobal_load_lds_dword %1, off\n\ts_mov_b32 m0, %0" : "=&s"(sv) : "v"(g), "s"(lds_base) : "memory"); }
__device__ __forceinline__ s16x4 vtr(lds_cptr p) { return __builtin_bit_cast(s16x4, __builtin_amdgcn_ds_read_tr16_b64_v4i16((LAS v4i16_t*)p)); }
__device__ __forceinline__ unsigned cvtpk(float lo, float hi) { typedef float f2 __attribute__((ext_vector_type(2))); typedef __bf16 b2 __attribute__((ext_vector_type(2))); f2 v = {lo, hi}; b2 b = __builtin_convertvector(v, b2); return __builtin_bit_cast(unsigned, b); }
#define ATT_MFMA(a, b, c) __builtin_amdgcn_mfma_f32_32x32x16_bf16(a, b, c, 0, 0, 0)
#define ATT_WAIT_BAR(N) asm volatile("s_waitcnt vmcnt(" #N ") lgkmcnt(0)\n\ts_barrier" ::: "memory")
#define ATT_RFL(x) ((unsigned)__builtin_amdgcn_readfirstlane((int)(x)))

struct UnitP {
    const bf16* Q;
    const bf16* K; const bf16* V; int pitch;
    const bf16* Z; bf16* Y;
    int qb, t_hi, t_lo;
    float sl2, sinkp, thr2;
    const float* lf; const float* kmean;
    unsigned* qctr; LAS unsigned* qw;
};

template <int MODE> __device__ __forceinline__ void attn_epilogue(const UnitP& u, LAS unsigned char* shm, const f32x16& o0, const f32x16& o1, float l) {
    const int tid = threadIdx.x, lane = tid & 63, r32 = lane & 31, hi = lane >> 5; const int wid = __builtin_amdgcn_readfirstlane(tid >> 6);
    LAS float* wsf = (LAS float*)(shm + LDS_WS + wid * WSB);
    unsigned nxt = 0u; if (tid == 0) nxt = __hip_atomic_fetch_add(u.qctr, 1u, __ATOMIC_RELAXED, __HIP_MEMORY_SCOPE_AGENT);
    const int orow = lane >> 1, oh = lane & 1;
    u32x4 zz[2][2];
#pragma unroll
    for (int d0 = 0; d0 < 2; ++d0) { const bf16* zp = u.Z + (size_t)(wid * 32 + orow) * LDP + 32 * d0 + 16 * oh; zz[d0][0] = *(const u32x4*)zp; zz[d0][1] = *(const u32x4*)(zp + 8); }
    l += __shfl_xor(l, 32); if (MODE == M_SWA) l += u.sinkp;
    if (hi == 0) wsf[r32] = 1.f / l;
    asm volatile("s_waitcnt lgkmcnt(0)" ::: "memory");
    float rl[16];
#pragma unroll
    for (int r = 0; r < 16; ++r) rl[r] = wsf[crow(r, hi)];
    LAS float* ost = (LAS float*)(shm + LDS_OST + wid * 4096);
#pragma unroll
    for (int d0 = 0; d0 < 2; ++d0) {
#pragma unroll
        for (int r = 0; r < 16; ++r) ost[crow(r, hi) * 32 + r32] = (d0 == 0 ? o0[r] : o1[r]) * rl[r];
        asm volatile("s_waitcnt lgkmcnt(0)" ::: "memory");
        f32x4 ov[4];
#pragma unroll
        for (int j = 0; j < 4; ++j) ov[j] = *(const LAS f32x4*)(ost + orow * 32 + 16 * oh + 4 * j);
        const u32x4 z0 = zz[d0][0], z1 = zz[d0][1];
        u32x4 y0, y1;
#pragma unroll
        for (int j = 0; j < 4; ++j) { const unsigned za = j < 2 ? z0[2 * j] : z1[2 * (j - 2)], zb = j < 2 ? z0[2 * j + 1] : z1[2 * (j - 2) + 1];
            const unsigned w0 = cvtpk(ov[j][0] * __uint_as_float(za << 16), ov[j][1] * __uint_as_float(za & 0xffff0000u)), w1 = cvtpk(ov[j][2] * __uint_as_float(zb << 16), ov[j][3] * __uint_as_float(zb & 0xffff0000u));
            if (j < 2) { y0[2 * j] = w0; y0[2 * j + 1] = w1; } else { y1[2 * (j - 2)] = w0; y1[2 * (j - 2) + 1] = w1; } }
        bf16* yp = u.Y + (size_t)(wid * 32 + orow) * DM + 32 * d0 + 16 * oh;
        *(u32x4*)yp = y0; *(u32x4*)(yp + 8) = y1;
        asm volatile("s_waitcnt lgkmcnt(0)" ::: "memory");
    }
    if (tid == 0) *u.qw = nxt;
    asm volatile("s_waitcnt vmcnt(0) lgkmcnt(0)\n\ts_barrier" ::: "memory");
}

template <int MODE> __device__ __forceinline__ void attn_unit(const UnitP& u, LAS unsigned char* shm) {
    const int tid = threadIdx.x, lane = tid & 63, r32 = lane & 31, hi = lane >> 5; const int wid = __builtin_amdgcn_readfirstlane(tid >> 6);
    const unsigned lds0 = (unsigned)(size_t)shm;
    LAS float* wsf = (LAS float*)(shm + LDS_WS + wid * WSB);
    const int pitch = u.pitch;
    const bf16* ksrc = u.K + (size_t)lane * pitch + wid * 8;
    const bf16* vsrc = u.V + (size_t)(16 * (wid & 3) + (lane >> 2)) * pitch + (wid >> 2) * 32 + (lane & 3) * 8;
    const float* fsrc = u.lf + lane + 1;
    const unsigned kdst = lds0 + LDS_K + wid * 1024, vdst = lds0 + LDS_V + wid * 1024, fdst = lds0 + LDS_WS + wid * WSB;
    const int NT = u.t_hi - u.t_lo + 1;
#define ATT_DMA(i, slot) do { const int t_ = u.t_hi - (i); glds16(ksrc + (size_t)t_ * 64 * pitch, ATT_RFL(kdst + (slot) * SLOTB)); glds16(vsrc + (size_t)t_ * 64 * pitch, ATT_RFL(vdst + (slot) * SLOTB)); \
        if (MODE == M_FOX) glds4(fsrc + t_ * 64, ATT_RFL(fdst + (slot) * 256)); } while (0)
    ATT_DMA(0, 0); if (NT > 1) ATT_DMA(1, 1);
    bf16x8 qr[4];
    { const bf16* Qw = u.Q + (size_t)(wid * 32 + r32) * LDP + hi * 8;
#pragma unroll
      for (int d0 = 0; d0 < 4; ++d0) qr[d0] = *(const bf16x8*)(Qw + d0 * 16); }
    asm volatile("" : "+v"(qr[0]), "+v"(qr[1]), "+v"(qr[2]), "+v"(qr[3]));
    const int qrel = wid * 32 + r32, qpos = u.qb * 256 + qrel;
    float Eq = 0.f, Eq0 = 0.f, carry = 0.f;
    if (MODE == M_FOX) {
        const int q0 = u.qb * 256;
#pragma unroll 1
        for (int jb = 3; jb >= 0; --jb) { float w = u.lf[q0 + 64 * jb + lane + 1]; if (jb == 3 && lane == 63) w = 0.f;
#pragma unroll
            for (int d = 1; d < 64; d <<= 1) { const float o = __shfl_down(w, d); if (lane + d < 64) w += o; }
            w += carry; wsf[256 + 64 * jb + lane] = w; carry = __builtin_bit_cast(float, __builtin_amdgcn_readfirstlane(__builtin_bit_cast(int, w))); }
        asm volatile("s_waitcnt lgkmcnt(0)" ::: "memory");
        Eq = wsf[256 + qrel]; Eq0 = carry;
    }
    unsigned selmask = 0u;
    if (MODE == M_MOBA) { if (u.qb > 0) {
        f32x16 g = f32x16{}; const float* km = u.kmean + (size_t)r32 * 64 + hi * 8;
#pragma unroll
        for (int d0 = 0; d0 < 4; ++d0) { const f32x4 a0 = *(const f32x4*)(km + 16 * d0), a1 = *(const f32x4*)(km + 16 * d0 + 4); bf16x8 kh, kl;
#pragma unroll
            for (int j = 0; j < 4; ++j) { unsigned h0 = f2bf(a0[j]), h1 = f2bf(a1[j]); kh[j] = (short)h0; kh[j + 4] = (short)h1; kl[j] = (short)f2bf(a0[j] - bf2f((bf16)h0)); kl[j + 4] = (short)f2bf(a1[j] - bf2f((bf16)h1)); }
            g = ATT_MFMA(kh, qr[d0], g); g = ATT_MFMA(kl, qr[d0], g); }
#pragma unroll
        for (int r = 0; r < 16; ++r) if (crow(r, hi) >= u.qb) g[r] = -INFINITY;
#pragma unroll 1
        for (int it = 0; it < 3; ++it) { float bv = -INFINITY; int bj = 99;
#pragma unroll
            for (int r = 0; r < 16; ++r) if (g[r] > bv) { bv = g[r]; bj = crow(r, hi); }
            const float pv = __shfl_xor(bv, 32); const int pj = __shfl_xor(bj, 32);
            if (pv > bv || (pv == bv && pj < bj)) { bv = pv; bj = pj; }
            if (bv > -INFINITY) selmask |= 1u << (bj & 31);
#pragma unroll
            for (int r = 0; r < 16; ++r) if (crow(r, hi) == bj) g[r] = -INFINITY; }
    } }
    f32x16 o0 = f32x16{}, o1 = f32x16{}; float l = 0.f;
    int sl = 0;
    const lds_cptr shc = (lds_cptr)shm;
#pragma unroll 1
    for (int i = 0; i < NT; ++i) {
        if (i + 1 < NT) { if (MODE == M_FOX) ATT_WAIT_BAR(3); else ATT_WAIT_BAR(2); } else ATT_WAIT_BAR(0);
        if (i + 2 < NT) { const int s2 = sl == 0 ? 2 : sl - 1; ATT_DMA(i + 2, s2); }
        const int t = u.t_hi - i, jb = t - 4 * u.qb;
        bool active = true; int esrc = 192;
        if (MODE == M_FOX) {
            if (jb >= 0) esrc = 256 + 64 * jb;
            else { float w = wsf[sl * 64 + lane];
#pragma unroll
                for (int d = 1; d < 64; d <<= 1) { const float o = __shfl_down(w, d); if (lane + d < 64) w += o; }
                w += carry; const float etop = __builtin_bit_cast(float, __builtin_amdgcn_readlane(__builtin_bit_cast(int, w), 63));
                if (__builtin_amdgcn_readfirstlane((int)(etop - Eq0 < -u.thr2))) break;
                wsf[192 + lane] = w; carry = __builtin_bit_cast(float, __builtin_amdgcn_readfirstlane(__builtin_bit_cast(int, w))); }
        }
        if (MODE != M_MEM) { if (jb >= 0) active = (64 * jb <= wid * 32 + 31); }
        if (MODE == M_SWA) active = active && (64 * jb >= wid * 32 - 190);
        bool rowsel = true;
        if (MODE == M_MOBA) { if (jb < 0) { rowsel = (selmask >> (t >> 2)) & 1u; active = (__ballot(rowsel) != 0ull); } }
        if (active) {
            const lds_cptr kp = shc + LDS_K + sl * SLOTB + hi * 1024 + r32 * 16;
            bf16x8 kf[8];
#pragma unroll
            for (int d0 = 0; d0 < 4; ++d0) { kf[2 * d0] = *(const LAS bf16x8*)(kp + d0 * 2048); kf[2 * d0 + 1] = *(const LAS bf16x8*)(kp + d0 * 2048 + 512); }
            f32x16 p0, p1;
            if (MODE == M_MEM) { p0 = f32x16{}; p1 = f32x16{}; }
            else if (MODE == M_FOX) { asm volatile("s_waitcnt lgkmcnt(0)" ::: "memory");
#pragma unroll
                for (int g = 0; g < 4; ++g) { const f32x4 e0 = *(const LAS f32x4*)(wsf + esrc + 8 * g + 4 * hi), e1 = *(const LAS f32x4*)(wsf + esrc + 32 + 8 * g + 4 * hi);
#pragma unroll
                    for (int e = 0; e < 4; ++e) { p0[4 * g + e] = e0[e] - Eq; p1[4 * g + e] = e1[e] - Eq; } } }
            else { float base = u.sl2 * (float)(64 * t + 4 * hi - qpos); if (MODE == M_MOBA) { if (!rowsel) base = -INFINITY; }
#pragma unroll
                for (int r = 0; r < 16; ++r) { p0[r] = __builtin_fmaf(u.sl2, (float)((r & 3) + 8 * (r >> 2)), base); p1[r] = p0[r] + 32.f * u.sl2; } }
            p0 = ATT_MFMA(kf[0], qr[0], p0); p1 = ATT_MFMA(kf[1], qr[0], p1); p0 = ATT_MFMA(kf[2], qr[1], p0); p1 = ATT_MFMA(kf[3], qr[1], p1);
            p0 = ATT_MFMA(kf[4], qr[2], p0); p1 = ATT_MFMA(kf[5], qr[2], p1); p0 = ATT_MFMA(kf[6], qr[3], p0); p1 = ATT_MFMA(kf[7], qr[3], p1);
            if (MODE != M_MEM) { if (jb >= 0) { const int kb = 64 * jb + 4 * hi;
#pragma unroll
                for (int r = 0; r < 16; ++r) { const int kv = kb + (r & 3) + 8 * (r >> 2); if (kv > qrel) p0[r] = -INFINITY; if (kv + 32 > qrel) p1[r] = -INFINITY; } } }
            if (MODE == M_SWA) { const int kb = 64 * jb + 4 * hi;
#pragma unroll
                for (int r = 0; r < 16; ++r) { const int kv = kb + (r & 3) + 8 * (r >> 2); if (qrel - kv >= 128) p0[r] = -INFINITY; if (qrel - kv - 32 >= 128) p1[r] = -INFINITY; } }
#pragma unroll
            for (int r = 0; r < 16; ++r) { p0[r] = fexp2(p0[r]); p1[r] = fexp2(p1[r]); }
            float s = 0.f;
#pragma unroll
            for (int r = 0; r < 16; ++r) s += p0[r] + p1[r];
            l += s;
            u32x4 pw[4];
#pragma unroll
            for (int j = 0; j < 4; ++j) { pw[0][j] = cvtpk(p0[2 * j], p0[2 * j + 1]); pw[1][j] = cvtpk(p0[8 + 2 * j], p0[9 + 2 * j]); pw[2][j] = cvtpk(p1[2 * j], p1[2 * j + 1]); pw[3][j] = cvtpk(p1[8 + 2 * j], p1[9 + 2 * j]); }
            const lds_cptr vp = shc + LDS_V + sl * SLOTB + ((lane >> 4) & 1) * 32 + (lane & 3) * 8 + (4 * hi + ((lane & 15) >> 2)) * 64;
#pragma unroll
            for (int ks = 0; ks < 4; ++ks) { const s16x4 a = vtr(vp + ks * 1024), b = vtr(vp + ks * 1024 + 512), c = vtr(vp + 4096 + ks * 1024), d = vtr(vp + 4096 + ks * 1024 + 512);
                const bf16x8 v0 = (bf16x8){a[0], a[1], a[2], a[3], b[0], b[1], b[2], b[3]}, v1 = (bf16x8){c[0], c[1], c[2], c[3], d[0], d[1], d[2], d[3]};
                o0 = ATT_MFMA(__builtin_bit_cast(bf16x8, pw[ks]), v0, o0); o1 = ATT_MFMA(__builtin_bit_cast(bf16x8, pw[ks]), v1, o1); }
        }
        sl = (sl == 2) ? 0 : sl + 1;
    }
    asm volatile("s_waitcnt vmcnt(0) lgkmcnt(0)" ::: "memory");
    attn_epilogue<MODE>(u, shm, o0, o1, l);
#undef ATT_DMA
}
}
namespace att {
#define AP_PIN(x) asm volatile("" : "+v"(x))
#define AP_SBAR() __builtin_amdgcn_sched_barrier(0)
#define AP_PKW(P, i) cvtpk(P[i], P[i + 1])
#define AP_PAF(w) __builtin_bit_cast(bf16x8, w)
#define AP_VF(a, b) (bf16x8){a[0], a[1], a[2], a[3], b[0], b[1], b[2], b[3]}

__device__ __forceinline__ float dpp_prefix_sum64(float v) {
    int x = __builtin_bit_cast(int, v);
#define AP_DPP_ADD(ctrl, rmask) { const int t_ = __builtin_amdgcn_update_dpp(0, x, ctrl, rmask, 0xf, false); x = __builtin_bit_cast(int, __builtin_bit_cast(float, x) + __builtin_bit_cast(float, t_)); }
    AP_DPP_ADD(0x111, 0xf) AP_DPP_ADD(0x112, 0xf) AP_DPP_ADD(0x114, 0xf) AP_DPP_ADD(0x118, 0xf)
    AP_DPP_ADD(0x142, 0xa)
    AP_DPP_ADD(0x143, 0xc)
#undef AP_DPP_ADD
    return __builtin_bit_cast(float, x);
}

template <int MODE> __device__ __forceinline__ void attn_unit_pipe(const UnitP& u, LAS unsigned char* shm) {
    static_assert(MODE == M_FOX, "pipelined body: FoX units");
    const int tid = threadIdx.x, lane = tid & 63, r32 = lane & 31, hi = lane >> 5; const int wid = __builtin_amdgcn_readfirstlane(tid >> 6);
    const unsigned lds0 = (unsigned)(size_t)shm;
    LAS float* wsf = (LAS float*)(shm + LDS_WS + wid * WSB);
    const bf16* ksrc = u.K + (size_t)lane * LDP + wid * 8;
    const bf16* vsrc = u.V + (size_t)(16 * (wid & 3) + (lane >> 2)) * LDP + (wid >> 2) * 32 + (lane & 3) * 8;
    const float* fsrc = u.lf + lane + 1;
    const unsigned kdst = lds0 + LDS_K + wid * 1024, vdst = lds0 + LDS_V + wid * 1024, fdst = lds0 + LDS_WS + wid * WSB;
    const int NT = u.t_hi + 1;
#define AP_TILE(i) ((i) < NT ? u.t_hi - (i) : 0)
#define AP_DMA_K(i, so) glds16(ksrc + (size_t)AP_TILE(i) * 64 * LDP, ATT_RFL(kdst + (so)))
#define AP_DMA_V(i, so) glds16(vsrc + (size_t)AP_TILE(i) * 64 * LDP, ATT_RFL(vdst + (so)))
#define AP_DMA_F(i, so) do { if (MODE == M_FOX) glds4(fsrc + AP_TILE(i) * 64, ATT_RFL(fdst + ((so) >> 5))); } while (0)
    AP_DMA_K(0, 0); AP_DMA_V(0, 0); AP_DMA_F(0, 0); AP_DMA_K(1, SLOTB); AP_DMA_F(1, SLOTB); AP_DMA_K(2, 2 * SLOTB); AP_DMA_F(2, 2 * SLOTB);
    bf16x8 qr[4];
    { const bf16* Qw = u.Q + (size_t)(wid * 32 + r32) * LDP + hi * 8;
#pragma unroll
      for (int d0 = 0; d0 < 4; ++d0) qr[d0] = *(const bf16x8*)(Qw + d0 * 16); }
    float w4[4];
#pragma unroll
    for (int jb = 0; jb < 4; ++jb) w4[jb] = u.lf[u.qb * 256 + 64 * jb + (63 - lane) + 1];
    asm volatile("" : "+v"(qr[0]), "+v"(qr[1]), "+v"(qr[2]), "+v"(qr[3]), "+v"(w4[0]), "+v"(w4[1]), "+v"(w4[2]), "+v"(w4[3]));
    const int qrel = wid * 32 + r32, qpos = u.qb * 256 + qrel;
    float Eq = 0.f, Eq0 = 0.f, carry = 0.f;
    if (MODE == M_FOX) {
        if (lane == 0) w4[3] = 0.f;
#pragma unroll
        for (int jb = 3; jb >= 0; --jb) { float w = dpp_prefix_sum64(w4[jb]) + carry; wsf[256 + 64 * jb + (63 - lane)] = w; carry = __builtin_bit_cast(float, __builtin_amdgcn_readlane(__builtin_bit_cast(int, w), 63)); }
        asm volatile("s_waitcnt lgkmcnt(0)" ::: "memory");
        Eq = wsf[256 + qrel]; Eq0 = carry;
    }
    const unsigned limb = (unsigned)__builtin_amdgcn_readfirstlane(__builtin_bit_cast(int, Eq0 - u.thr2));
#define AP_SPLIT3(x, hb, mb, lb) do { hb = __float_as_uint(x); const float r1_ = (x) - __uint_as_float(hb & 0xffff0000u); mb = __float_as_uint(r1_); lb = __float_as_uint(r1_ - __uint_as_float(mb & 0xffff0000u)); } while (0)
#define AP_EB(e, AB) do { unsigned hb_, mb_, lb_; AP_SPLIT3(e, hb_, mb_, lb_); AB[0] = (hb_ >> 16) | (mb_ & 0xffff0000u); AB[1] = (lb_ >> 16) | 0x3f800000u; } while (0)
#define AP_EREAD(I, e0, e1) do { const int jb2_ = u.t_hi - (I) - 4 * u.qb; const LAS float* ep_ = wsf + (jb2_ >= 0 ? 256 + 64 * jb2_ : 192) + r32; e0 = ep_[0]; e1 = ep_[32]; } while (0)
    u32x4 ab0 = (u32x4){0u, 0u, 0x3f803f80u, 0u}, ab1 = (u32x4){0u, 0u, 0x3f803f80u, 0u}; bf16x8 bb;
    { unsigned hb_, mb_, lb_; const float ne_ = -Eq; AP_SPLIT3(ne_, hb_, mb_, lb_); u32x4 w_ = (u32x4){0x3f803f80u, 0x00003f80u | (hb_ & 0xffff0000u), (mb_ >> 16) | (lb_ & 0xffff0000u), 0u};
      if (hi) w_ = (u32x4){0u, 0u, 0u, 0u}; bb = AP_PAF(w_); }
    unsigned selmask = 0u;
    if (MODE == M_MOBA) { if (u.qb > 0) {
        f32x16 g = f32x16{}; const float* km = u.kmean + (size_t)r32 * 64 + hi * 8;
#pragma unroll
        for (int d0 = 0; d0 < 4; ++d0) { const f32x4 a0 = *(const f32x4*)(km + 16 * d0), a1 = *(const f32x4*)(km + 16 * d0 + 4); bf16x8 kh, kl;
#pragma unroll
            for (int j = 0; j < 4; ++j) { unsigned h0 = f2bf(a0[j]), h1 = f2bf(a1[j]); kh[j] = (short)h0; kh[j + 4] = (short)h1; kl[j] = (short)f2bf(a0[j] - bf2f((bf16)h0)); kl[j + 4] = (short)f2bf(a1[j] - bf2f((bf16)h1)); }
            g = ATT_MFMA(kh, qr[d0], g); g = ATT_MFMA(kl, qr[d0], g); }
#pragma unroll
        for (int r = 0; r < 16; ++r) if (crow(r, hi) >= u.qb) g[r] = -INFINITY;
#pragma unroll 1
        for (int it = 0; it < 3; ++it) { float bv = -INFINITY; int bj = 99;
#pragma unroll
            for (int r = 0; r < 16; ++r) if (g[r] > bv) { bv = g[r]; bj = crow(r, hi); }
            const float pv = __shfl_xor(bv, 32); const int pj = __shfl_xor(bj, 32);
            if (pv > bv || (pv == bv && pj < bj)) { bv = pv; bj = pj; }
            if (bv > -INFINITY) selmask |= 1u << (bj & 31);
#pragma unroll
            for (int r = 0; r < 16; ++r) if (crow(r, hi) == bj) g[r] = -INFINITY; }
    } }
    const lds_cptr shc = (lds_cptr)shm;
    const lds_cptr kp0 = shc + LDS_K + hi * 1024 + r32 * 16;
    const lds_cptr vp0 = shc + LDS_V + ((lane >> 4) & 1) * 32 + (lane & 3) * 8 + (4 * hi + ((lane & 15) >> 2)) * 64;
#define AP_CINIT4(X, b, p1, I) do { const int ti_ = u.t_hi - (I); \
        if (MODE == M_FOX) { const int jb2_ = ti_ - 4 * u.qb; const int es_ = jb2_ >= 0 ? 256 + 64 * jb2_ : 192; const f32x4 e_ = *(const LAS f32x4*)(wsf + es_ + ((p1) ? 32 : 0) + 2 * (b) + 4 * hi); \
            X[(b)] = e_[0] - Eq; X[(b) + 1] = e_[1] - Eq; X[(b) + 2] = e_[2] - Eq; X[(b) + 3] = e_[3] - Eq; } \
        else { float base_ = u.sl2 * (float)(64 * ti_ + 4 * hi - qpos + ((p1) ? 32 : 0)); if (ti_ < 4 * u.qb) { if (!((selmask >> (ti_ >> 2)) & 1u)) base_ = -INFINITY; } \
            X[(b)] = __builtin_fmaf(u.sl2, (float)(2 * (b)), base_); X[(b) + 1] = __builtin_fmaf(u.sl2, (float)(2 * (b) + 1), base_); X[(b) + 2] = __builtin_fmaf(u.sl2, (float)(2 * (b) + 2), base_); X[(b) + 3] = __builtin_fmaf(u.sl2, (float)(2 * (b) + 3), base_); } } while (0)
#define AP_CMASK(C0, C1, I) do { const int jbm_ = u.t_hi - (I) - 4 * u.qb; if (jbm_ >= 0) { const int kb_ = 64 * jbm_ + 4 * hi; \
        _Pragma("unroll") for (int r = 0; r < 16; ++r) { const int kv_ = kb_ + (r & 3) + 8 * (r >> 2); if (kv_ > qrel) C0[r] = -INFINITY; if (kv_ + 32 > qrel) C1[r] = -INFINITY; } } } while (0)
    f32x16 pA0, pA1, pB0, pB1, o0 = f32x16{}, o1 = f32x16{}; float l = 0.f;
    bf16x8 kf[8]; u32x4 pw0, pw1, pw2, pw3;
    int so_prev = 0, so_cur = 0, so_n1 = SLOTB, so_n2 = 2 * SLOTB;
#define AP_ROT() do { so_prev = so_cur; so_cur = so_n1; so_n1 = so_n2; so_n2 = so_prev; } while (0)
    bool last = false;
    asm volatile("s_waitcnt vmcnt(0) lgkmcnt(0)\n\ts_barrier" ::: "memory");
    { float e0_, e1_; AP_EREAD(0, e0_, e1_); AP_EB(e0_, ab0); AP_EB(e1_, ab1); }
    pA0 = ATT_MFMA(AP_PAF(ab0), bb, f32x16{}); pA1 = ATT_MFMA(AP_PAF(ab1), bb, f32x16{});
#pragma unroll
    for (int d0 = 0; d0 < 4; ++d0) { kf[2 * d0] = *(const LAS bf16x8*)(kp0 + d0 * 2048); kf[2 * d0 + 1] = *(const LAS bf16x8*)(kp0 + d0 * 2048 + 512); }
    pA0 = ATT_MFMA(kf[0], qr[0], pA0); pA1 = ATT_MFMA(kf[1], qr[0], pA1); pA0 = ATT_MFMA(kf[2], qr[1], pA0); pA1 = ATT_MFMA(kf[3], qr[1], pA1);
    pA0 = ATT_MFMA(kf[4], qr[2], pA0); pA1 = ATT_MFMA(kf[5], qr[2], pA1); pA0 = ATT_MFMA(kf[6], qr[3], pA0); pA1 = ATT_MFMA(kf[7], qr[3], pA1);
    AP_CMASK(pA0, pA1, 0);
#pragma unroll
    for (int r = 0; r < 16; ++r) { pA0[r] = fexp2(pA0[r]); pA1[r] = fexp2(pA1[r]); }
    asm volatile("s_waitcnt vmcnt(0) lgkmcnt(0)\n\ts_barrier" ::: "memory");
    AP_DMA_K(3, 0); AP_DMA_V(1, SLOTB); AP_DMA_F(3, 0);
#pragma unroll
    for (int d0 = 0; d0 < 4; ++d0) { kf[2 * d0] = *(const LAS bf16x8*)(kp0 + SLOTB + d0 * 2048); kf[2 * d0 + 1] = *(const LAS bf16x8*)(kp0 + SLOTB + d0 * 2048 + 512); }
    { float e0_, e1_; AP_EREAD(1, e0_, e1_); AP_EB(e0_, ab0); AP_EB(e1_, ab1); }
    if (MODE == M_FOX) ATT_WAIT_BAR(3); else ATT_WAIT_BAR(2);
    AP_ROT();
#define AP_GA(C, g, a0, a1, a2, a3, W0, W1, PW, SC) do { C = ATT_MFMA(kf[g], qr[(g) >> 1], C); kf[g] = *(const LAS bf16x8*)(kn_ + ((g) >> 1) * 2048 + ((g) & 1) * 512); \
        sacc += a0; sacc += a1; sacc += a2; sacc += a3; W0; W1; SC; AP_PIN(PW); AP_PIN(sacc); AP_SBAR(); } while (0)
#define AP_SCD(ctrl, rmask) do { if (MODE == M_FOX) { const int t_ = __builtin_amdgcn_update_dpp(0, sx_, ctrl, rmask, 0xf, false); sx_ = __builtin_bit_cast(int, __builtin_bit_cast(float, sx_) + __builtin_bit_cast(float, t_)); AP_PIN(sx_); } } while (0)
#define AP_GB(O, PW, VA, VB, NA, NB, noff, X, xb, BS) do { if ((noff) >= 0) { NA = vtr(vp_ + (noff)); NB = vtr(vp_ + (noff) + 512); } \
        O = ATT_MFMA(AP_PAF(PW), AP_VF(VA, VB), O); X[xb] = fexp2(X[xb]); X[(xb) + 1] = fexp2(X[(xb) + 1]); X[(xb) + 2] = fexp2(X[(xb) + 2]); X[(xb) + 3] = fexp2(X[(xb) + 3]); \
        BS; AP_PIN(X); AP_SBAR(); } while (0)
#define AP_VOFF(i) (((i) >> 2) * 4096 + ((i) & 3) * 1024)
#define AP_STEP(C0, C1, P0, P1, I) do { const int i_ = (I); const lds_cptr kn_ = kp0 + so_n1; AP_SBAR(); \
        int sx_ = 0; if (MODE == M_FOX) sx_ = __builtin_bit_cast(int, wsf[(so_n1 >> 5) / 4 + (63 - lane)]);                   \
        C0 = ATT_MFMA(AP_PAF(ab0), bb, f32x16{}); AP_SBAR(); C1 = ATT_MFMA(AP_PAF(ab1), bb, f32x16{}); AP_SBAR();              \
        float sacc = P0[0] + P0[1]; \
        AP_GA(C0, 0, P0[2], P0[3], P0[4], P0[5], pw0[0] = AP_PKW(P0, 0), pw0[1] = AP_PKW(P0, 2), pw0, (void)0); \
        AP_GA(C1, 1, P0[6], P0[7], P0[8], P0[9], pw0[2] = AP_PKW(P0, 4), pw0[3] = AP_PKW(P0, 6), pw0, AP_SCD(0x111, 0xf)); \
        AP_GA(C0, 2, P0[10], P0[11], P0[12], P0[13], pw1[0] = AP_PKW(P0, 8), pw1[1] = AP_PKW(P0, 10), pw1, AP_SCD(0x112, 0xf)); \
        AP_GA(C1, 3, P0[14], P0[15], P1[0], P1[1], pw1[2] = AP_PKW(P0, 12), pw1[3] = AP_PKW(P0, 14), pw1, AP_SCD(0x114, 0xf)); \
        AP_GA(C0, 4, P1[2], P1[3], P1[4], P1[5], pw2[0] = AP_PKW(P1, 0), pw2[1] = AP_PKW(P1, 2), pw2, AP_SCD(0x118, 0xf)); \
        AP_GA(C1, 5, P1[6], P1[7], P1[8], P1[9], pw2[2] = AP_PKW(P1, 4), pw2[3] = AP_PKW(P1, 6), pw2, AP_SCD(0x142, 0xa)); \
        AP_GA(C0, 6, P1[10], P1[11], P1[12], P1[13], pw3[0] = AP_PKW(P1, 8), pw3[1] = AP_PKW(P1, 10), pw3, AP_SCD(0x143, 0xc)); \
        AP_GA(C1, 7, P1[14], P1[15], 0.f, 0.f, pw3[2] = AP_PKW(P1, 12), pw3[3] = AP_PKW(P1, 14), pw3, (void)0); \
        l += sacc; \
        last = (i_ + 1 >= NT); \
        if (MODE == M_FOX) { if (!last) { if (u.t_hi - (i_ + 1) < 4 * u.qb) {                                   \
            const float w_ = __builtin_bit_cast(float, sx_) + carry; \
            const unsigned etopb_ = (unsigned)__builtin_amdgcn_readfirstlane(__builtin_bit_cast(int, w_));                      \
            if (etopb_ > limb) last = true;                                                                                   \
            else { wsf[192 + (63 - lane)] = w_; carry = __builtin_bit_cast(float, __builtin_amdgcn_readlane(__builtin_bit_cast(int, w_), 63)); } } } } \
        const lds_cptr vp_ = vp0 + so_prev; s16x4 va0_, vb0_, va1_, vb1_; va0_ = vtr(vp_ + AP_VOFF(0)); vb0_ = vtr(vp_ + AP_VOFF(0) + 512); \
        float e0_, e1_; AP_EREAD(i_ + 1, e0_, e1_);                                                                        \
        AP_SBAR(); \
        AP_DMA_K(i_ + 3, so_cur); AP_DMA_V(i_ + 1, so_n1); AP_DMA_F(i_ + 3, so_cur); \
        AP_CMASK(C0, C1, i_); \
        AP_SBAR(); \
        AP_GB(o0, pw0, va0_, vb0_, va1_, vb1_, AP_VOFF(4), C0, 0, (void)0); \
        AP_GB(o1, pw0, va1_, vb1_, va0_, vb0_, AP_VOFF(1), C0, 4, (void)0); \
        AP_GB(o0, pw1, va0_, vb0_, va1_, vb1_, AP_VOFF(5), C0, 8, AP_EB(e0_, ab0); AP_PIN(ab0)); \
        AP_GB(o1, pw1, va1_, vb1_, va0_, vb0_, AP_VOFF(2), C0, 12, (void)0); \
        AP_GB(o0, pw2, va0_, vb0_, va1_, vb1_, AP_VOFF(6), C1, 0, AP_EB(e1_, ab1); AP_PIN(ab1)); \
        AP_GB(o1, pw2, va1_, vb1_, va0_, vb0_, AP_VOFF(3), C1, 4, (void)0); \
        AP_GB(o0, pw3, va0_, vb0_, va1_, vb1_, AP_VOFF(7), C1, 8, (void)0); \
        AP_GB(o1, pw3, va1_, vb1_, va0_, vb0_, -1, C1, 12, (void)0); \
        if (MODE == M_FOX) ATT_WAIT_BAR(3); else ATT_WAIT_BAR(2); \
        AP_ROT(); } while (0)
#define AP_DRAIN(P0, P1) do { float sacc = 0.f; _Pragma("unroll") for (int r = 0; r < 16; ++r) sacc += P0[r] + P1[r]; l += sacc; \
        pw0 = (u32x4){AP_PKW(P0, 0), AP_PKW(P0, 2), AP_PKW(P0, 4), AP_PKW(P0, 6)}; pw1 = (u32x4){AP_PKW(P0, 8), AP_PKW(P0, 10), AP_PKW(P0, 12), AP_PKW(P0, 14)}; \
        pw2 = (u32x4){AP_PKW(P1, 0), AP_PKW(P1, 2), AP_PKW(P1, 4), AP_PKW(P1, 6)}; pw3 = (u32x4){AP_PKW(P1, 8), AP_PKW(P1, 10), AP_PKW(P1, 12), AP_PKW(P1, 14)}; \
        const lds_cptr vp_ = vp0 + so_prev; \
        _Pragma("unroll") for (int ks = 0; ks < 4; ++ks) { const s16x4 a = vtr(vp_ + ks * 1024), b = vtr(vp_ + ks * 1024 + 512), c = vtr(vp_ + 4096 + ks * 1024), d = vtr(vp_ + 4096 + ks * 1024 + 512); \
            const u32x4 pw_ = ks == 0 ? pw0 : ks == 1 ? pw1 : ks == 2 ? pw2 : pw3; o0 = ATT_MFMA(AP_PAF(pw_), AP_VF(a, b), o0); o1 = ATT_MFMA(AP_PAF(pw_), AP_VF(c, d), o1); } } while (0)
    {
        int i = 1; bool inA = true;
#pragma unroll 1
        for (;;) {
            AP_STEP(pB0, pB1, pA0, pA1, i); inA = false; if (last) break;
            AP_STEP(pA0, pA1, pB0, pB1, i + 1); inA = true; if (last) break;
            i += 2;
        }
        if (inA) AP_DRAIN(pA0, pA1); else AP_DRAIN(pB0, pB1);
    }
    asm volatile("s_waitcnt vmcnt(0) lgkmcnt(0)" ::: "memory");
    attn_epilogue<MODE>(u, shm, o0, o1, l);
#undef AP_TILE
#undef AP_DMA_K
#undef AP_DMA_V
#undef AP_DMA_F
#undef AP_CINIT4
#undef AP_SPLIT3
#undef AP_EB
#undef AP_EREAD
#undef AP_CMASK
#undef AP_ROT
#undef AP_GA
#undef AP_SCD
#undef AP_GB
#undef AP_VOFF
#undef AP_STEP
#undef AP_DRAIN
}
}
namespace att {
constexpr int G_K = 0, G_V = 32768, G_WS = 65536, G_OST = G_WS + 8 * WSB, G_END = G_OST + 8 * 4096;
constexpr int G_QW = G_END, G_PARTS = G_END + 64, G_PRE = G_PARTS + 384 * 4, G_SEL = G_PRE + 385 * 4;
constexpr int MLIST_CAP = 8192;

struct MobaBufs { unsigned* mcnt; unsigned short* mlist; bf16* slab_o; float* slab_l; };

__device__ __forceinline__ void moba_gate_item(const bf16* P, const float* kmean_all, const MobaBufs& mb, int b, int hb, int i) {
    const int tid = threadIdx.x, lane = tid & 63, r32 = lane & 31, hi = lane >> 5; const int wid = __builtin_amdgcn_readfirstlane(tid >> 6);
    const size_t row0 = (size_t)b * SEQ + i * 256;
    bf16x8 qr[4];
    { const bf16* Qw = P + (row0 + wid * 32 + r32) * LDP + L0_BQ + hb * 64 + hi * 8;
#pragma unroll
      for (int d0 = 0; d0 < 4; ++d0) qr[d0] = *(const bf16x8*)(Qw + d0 * 16); }
    f32x16 g = f32x16{}; const float* km = kmean_all + ((size_t)b * 6 + hb) * 32 * 64 + (size_t)r32 * 64 + hi * 8;
#pragma unroll
    for (int d0 = 0; d0 < 4; ++d0) { const f32x4 a0 = *(const f32x4*)(km + 16 * d0), a1 = *(const f32x4*)(km + 16 * d0 + 4); bf16x8 kh, kl;
#pragma unroll
        for (int j = 0; j < 4; ++j) { unsigned h0 = f2bf(a0[j]), h1 = f2bf(a1[j]); kh[j] = (short)h0; kh[j + 4] = (short)h1; kl[j] = (short)f2bf(a0[j] - bf2f((bf16)h0)); kl[j + 4] = (short)f2bf(a1[j] - bf2f((bf16)h1)); }
        g = ATT_MFMA(kh, qr[d0], g); g = ATT_MFMA(kl, qr[d0], g); }
#pragma unroll
    for (int r = 0; r < 16; ++r) if (crow(r, hi) >= i) g[r] = -INFINITY;
    unsigned selmask = 0u;
#pragma unroll 1
    for (int it = 0; it < 3; ++it) { float bv = -INFINITY; int bj = 99;
#pragma unroll
        for (int r = 0; r < 16; ++r) if (g[r] > bv) { bv = g[r]; bj = crow(r, hi); }
        const float pv = __shfl_xor(bv, 32); const int pj = __shfl_xor(bj, 32);
        if (pv > bv || (pv == bv && pj < bj)) { bv = pv; bj = pj; }
        if (bv > -INFINITY) selmask |= 1u << (bj & 31);
#pragma unroll
        for (int r = 0; r < 16; ++r) if (crow(r, hi) == bj) g[r] = -INFINITY; }
    const bool rep = (hi == 0);
    unsigned mycnt = 0u;
#pragma unroll 1
    for (int j = 0; j < i; ++j) { const unsigned long long m = __ballot(rep && ((selmask >> j) & 1u)); if (lane == j) mycnt = (unsigned)__popcll(m); }
    unsigned base = 0u; unsigned* cnt = mb.mcnt + ((size_t)b * 6 + hb) * 32;
    if (lane < i && mycnt) base = __hip_atomic_fetch_add(cnt + lane, mycnt, __ATOMIC_RELAXED, __HIP_MEMORY_SCOPE_AGENT);
    unsigned short* lst = mb.mlist + (((size_t)b * 6 + hb) * 32) * MLIST_CAP;
    const unsigned long long lt = (1ull << lane) - 1ull;
#pragma unroll 1
    for (int j = 0; j < i; ++j) { const bool sj = rep && ((selmask >> j) & 1u); const unsigned long long m = __ballot(sj);
        const unsigned bj = (unsigned)__builtin_amdgcn_readlane((int)base, j);
        if (sj) { const unsigned pos = bj + (unsigned)__popcll(m & lt), slot = (unsigned)__popc(selmask & ((1u << j) - 1u));
            lst[(size_t)j * MLIST_CAP + pos] = (unsigned short)((i * 256 + wid * 32 + r32) | (slot << 13)); } }
}

#ifndef KV_SUB
#define KV_SUB 2
#endif
struct SubChunk { int row, slot, S; bool valid, act; };
__device__ __forceinline__ void moba_subchunk(const SubChunk& sc, const bf16x8 (&qr)[4], int b, int hb, int j, float sl2, const MobaBufs& mb, LAS unsigned char* shm) {
    const int tid = threadIdx.x, lane = tid & 63, r32 = lane & 31, hi = lane >> 5; const int wid = __builtin_amdgcn_readfirstlane(tid >> 6);
    LAS float* wsf = (LAS float*)(shm + G_WS + wid * WSB);
    LAS float* ost = (LAS float*)(shm + G_OST + wid * 4096);
    const lds_cptr shc = (lds_cptr)shm;
    const int orow = lane >> 1, oh = lane & 1;
    const int S = sc.S; const bool own = (S < 8); const int k = 32 * S + r32; const int row = sc.row; const bool valid = sc.valid;
    f32x16 o0 = f32x16{}, o1 = f32x16{}; float l = 0.f;
#pragma unroll 1
    for (int tt = 3; tt >= 0; --tt) {
        if (own) { if (64 * tt > 32 * S + 31) continue; }
        const lds_cptr kp = shc + G_K + tt * 8192 + hi * 1024 + r32 * 16;
        bf16x8 kf[8];
#pragma unroll
        for (int d0 = 0; d0 < 4; ++d0) { kf[2 * d0] = *(const LAS bf16x8*)(kp + d0 * 2048); kf[2 * d0 + 1] = *(const LAS bf16x8*)(kp + d0 * 2048 + 512); }
        float base = sl2 * (float)(64 * (4 * j + tt) + 4 * hi - row); if (!valid) base = -INFINITY;
        f32x16 p0, p1;
#pragma unroll
        for (int r = 0; r < 16; ++r) { p0[r] = __builtin_fmaf(sl2, (float)((r & 3) + 8 * (r >> 2)), base); p1[r] = p0[r] + 32.f * sl2; }
        p0 = ATT_MFMA(kf[0], qr[0], p0); p1 = ATT_MFMA(kf[1], qr[0], p1); p0 = ATT_MFMA(kf[2], qr[1], p0); p1 = ATT_MFMA(kf[3], qr[1], p1);
        p0 = ATT_MFMA(kf[4], qr[2], p0); p1 = ATT_MFMA(kf[5], qr[2], p1); p0 = ATT_MFMA(kf[6], qr[3], p0); p1 = ATT_MFMA(kf[7], qr[3], p1);
        if (own) { const int kb = 64 * tt + 4 * hi;
#pragma unroll
            for (int r = 0; r < 16; ++r) { const int kv = kb + (r & 3) + 8 * (r >> 2); if (kv > k) p0[r] = -INFINITY; if (kv + 32 > k) p1[r] = -INFINITY; } }
#pragma unroll
        for (int r = 0; r < 16; ++r) { p0[r] = fexp2(p0[r]); p1[r] = fexp2(p1[r]); }
        float sm = 0.f;
#pragma unroll
        for (int r = 0; r < 16; ++r) sm += p0[r] + p1[r];
        l += sm;
        u32x4 pw[4];
#pragma unroll
        for (int q = 0; q < 4; ++q) { pw[0][q] = cvtpk(p0[2 * q], p0[2 * q + 1]); pw[1][q] = cvtpk(p0[8 + 2 * q], p0[9 + 2 * q]); pw[2][q] = cvtpk(p1[2 * q], p1[2 * q + 1]); pw[3][q] = cvtpk(p1[8 + 2 * q], p1[9 + 2 * q]); }
        const lds_cptr vp = shc + G_V + tt * 8192 + ((lane >> 4) & 1) * 32 + (lane & 3) * 8 + (4 * hi + ((lane & 15) >> 2)) * 64;
#pragma unroll
        for (int ks = 0; ks < 4; ++ks) { const s16x4 va = vtr(vp + ks * 1024), vb = vtr(vp + ks * 1024 + 512), vc = vtr(vp + 4096 + ks * 1024), vd = vtr(vp + 4096 + ks * 1024 + 512);
            const bf16x8 v0 = (bf16x8){va[0], va[1], va[2], va[3], vb[0], vb[1], vb[2], vb[3]}, v1 = (bf16x8){vc[0], vc[1], vc[2], vc[3], vd[0], vd[1], vd[2], vd[3]};
            o0 = ATT_MFMA(__builtin_bit_cast(bf16x8, pw[ks]), v0, o0); o1 = ATT_MFMA(__builtin_bit_cast(bf16x8, pw[ks]), v1, o1); }
    }
    l += __shfl_xor(l, 32);
    const size_t brow = (size_t)b * SEQ + row;
    if (hi == 0) { wsf[r32] = l > 0.f ? 1.f / l : 0.f; if (valid) mb.slab_l[((size_t)sc.slot * T + brow) * 6 + hb] = l; }
    asm volatile("s_waitcnt lgkmcnt(0)" ::: "memory");
    float rl[16];
#pragma unroll
    for (int r = 0; r < 16; ++r) rl[r] = wsf[crow(r, hi)];
    const int row_o = __shfl(row, orow), slot_o = __shfl(sc.slot, orow); const bool valid_o = __shfl((int)valid, orow) != 0;
    bf16* dst = mb.slab_o + (((size_t)slot_o * T + (size_t)b * SEQ + row_o) * 6 + hb) * 64 + 16 * oh;
#pragma unroll
    for (int d0 = 0; d0 < 2; ++d0) {
#pragma unroll
        for (int r = 0; r < 16; ++r) ost[crow(r, hi) * 32 + r32] = (d0 == 0 ? o0[r] : o1[r]) * rl[r];
        asm volatile("s_waitcnt lgkmcnt(0)" ::: "memory");
        f32x4 ov[4];
#pragma unroll
        for (int q = 0; q < 4; ++q) ov[q] = *(const LAS f32x4*)(ost + orow * 32 + 16 * oh + 4 * q);
        u32x4 y0, y1; y0[0] = cvtpk(ov[0][0], ov[0][1]); y0[1] = cvtpk(ov[0][2], ov[0][3]); y0[2] = cvtpk(ov[1][0], ov[1][1]); y0[3] = cvtpk(ov[1][2], ov[1][3]);
        y1[0] = cvtpk(ov[2][0], ov[2][1]); y1[1] = cvtpk(ov[2][2], ov[2][3]); y1[2] = cvtpk(ov[3][0], ov[3][1]); y1[3] = cvtpk(ov[3][2], ov[3][3]);
        if (valid_o) { *(u32x4*)(dst + 32 * d0) = y0; *(u32x4*)(dst + 32 * d0 + 8) = y1; }
        asm volatile("s_waitcnt lgkmcnt(0)" ::: "memory");
    }
}
__device__ __forceinline__ void moba_kv_unit(const bf16* P, const MobaBufs& mb, int b, int hb, int j, int part, unsigned* qctr, LAS unsigned char* shm) {
    const int tid = threadIdx.x, lane = tid & 63, r32 = lane & 31, hi = lane >> 5; const int wid = __builtin_amdgcn_readfirstlane(tid >> 6);
    const unsigned lds0 = (unsigned)(size_t)shm;
    const bf16* Pb = P + (size_t)b * SEQ * LDP;
    { const bf16* ksrc = Pb + L0_BK + hb * 64 + (size_t)(256 * j + lane) * LDP + wid * 8;
      const bf16* vsrc = Pb + L0_BV + hb * 64 + (size_t)(256 * j + 16 * (wid & 3) + (lane >> 2)) * LDP + (wid >> 2) * 32 + (lane & 3) * 8;
#pragma unroll
      for (int tt = 0; tt < 4; ++tt) { glds16(ksrc + (size_t)tt * 64 * LDP, ATT_RFL(lds0 + G_K + tt * 8192 + wid * 1024)); glds16(vsrc + (size_t)tt * 64 * LDP, ATT_RFL(lds0 + G_V + tt * 8192 + wid * 1024)); } }
    const int list = (b * 6 + hb) * 32 + j;
    const int cnt = (int)mb.mcnt[list]; const int rows_total = 256 + cnt;
    const unsigned short* lst = mb.mlist + (size_t)list * MLIST_CAP;
    const float sl2 = alibi_slope2(6 + hb);
    unsigned nxt = 0u; if (tid == 0) nxt = __hip_atomic_fetch_add(qctr, 1u, __ATOMIC_RELAXED, __HIP_MEMORY_SCOPE_AGENT);
    SubChunk cur, nx; bf16x8 qc[4], qn[4];
#define KV_DESC(D, s_) do { const int S_ = 8 * KV_SUB * part + wid + 8 * (s_); D.S = S_; D.act = ((s_) < KV_SUB) && (32 * S_ < rows_total); const int k_ = 32 * S_ + r32; \
        if (S_ < 8) { D.row = 256 * j + k_; D.slot = 3; D.valid = true; } \
        else { const int idx_ = k_ - 256; const bool v_ = D.act && idx_ < cnt; const unsigned e_ = v_ ? (unsigned)lst[idx_] : 0u; D.row = (int)(e_ & 8191u); D.slot = (int)(e_ >> 13); D.valid = v_; } } while (0)
    KV_DESC(cur, 0);
    { const bf16* Q0 = Pb + (size_t)cur.row * LDP + L0_BQ + hb * 64 + hi * 8;
#pragma unroll
      for (int d0 = 0; d0 < 4; ++d0) qc[d0] = *(const bf16x8*)(Q0 + d0 * 16); }
    asm volatile("" : "+v"(qc[0]), "+v"(qc[1]), "+v"(qc[2]), "+v"(qc[3]));
    asm volatile("s_waitcnt vmcnt(0) lgkmcnt(0)\n\ts_barrier" ::: "memory");
#pragma unroll 1
    for (int s = 0; s < KV_SUB; ++s) {
        if (!cur.act) break;
        KV_DESC(nx, s + 1);
        { const bf16* Q1 = Pb + (size_t)nx.row * LDP + L0_BQ + hb * 64 + hi * 8;
#pragma unroll
          for (int d0 = 0; d0 < 4; ++d0) qn[d0] = *(const bf16x8*)(Q1 + d0 * 16); }
        moba_subchunk(cur, qc, b, hb, j, sl2, mb, shm);
        cur = nx;
#pragma unroll
        for (int d0 = 0; d0 < 4; ++d0) qc[d0] = qn[d0];
    }
#undef KV_DESC
    if (tid == 0) *(LAS unsigned*)(shm + G_QW) = nxt;
    asm volatile("s_waitcnt vmcnt(0) lgkmcnt(0)\n\ts_barrier" ::: "memory");
}

__device__ __forceinline__ void moba_kv_phase(const Args& a, const MobaBufs& mb, LAS unsigned char* lds, unsigned* qctr) {
    const bf16* P = (const bf16*)(a.ws + WS_P);
    const int tid = threadIdx.x;
    LAS unsigned* qw = (LAS unsigned*)(lds + G_QW); LAS int* parts = (LAS int*)(lds + G_PARTS); LAS int* pre = (LAS int*)(lds + G_PRE); LAS int* sel = (LAS int*)(lds + G_SEL);
    if (tid == 0) {
        unsigned sp = 0u; while (__hip_atomic_load(mb.mcnt + 512, __ATOMIC_RELAXED, __HIP_MEMORY_SCOPE_AGENT) < 372u) { __builtin_amdgcn_s_sleep(2); if (++sp > (1u << 22)) break; }
        __builtin_amdgcn_fence(__ATOMIC_ACQUIRE, "agent"); asm volatile("s_waitcnt vmcnt(0)" ::: "memory"); }
    __syncthreads();
    if (tid < 384) parts[tid] = (256 + (int)__hip_atomic_load(mb.mcnt + tid, __ATOMIC_RELAXED, __HIP_MEMORY_SCOPE_AGENT) + 256 * KV_SUB - 1) / (256 * KV_SUB);
    if (tid == 0) *qw = __hip_atomic_fetch_add(qctr, 1u, __ATOMIC_RELAXED, __HIP_MEMORY_SCOPE_AGENT);
    __syncthreads();
    {
        const int lane_ = tid & 63, w_ = tid >> 6; int v = (tid < 384) ? parts[tid] - 1 : 0, inc = v;
#pragma unroll
        for (int o = 1; o < 64; o <<= 1) { const int t_ = __shfl_up(inc, o); if (lane_ >= o) inc += t_; }
        if (lane_ == 63 && w_ < 6) sel[4 + w_] = inc;
        __syncthreads();
        int off = 0;
#pragma unroll
        for (int k = 0; k < 6; ++k) if (k < w_) off += sel[4 + k];
        if (tid < 384) pre[tid] = off + inc - v;
        if (tid == 383) pre[384] = off + inc; }
    __syncthreads();
    const int nfull = pre[384], total = nfull + 384;
    for (;;) {
        const int idx = __builtin_amdgcn_readfirstlane((int)*qw);
        if (idx >= total) break;
        if (tid < 384) { if (idx < nfull) { if (pre[tid] <= idx && idx < pre[tid + 1]) { sel[0] = tid; sel[1] = idx - pre[tid]; } }
                         else if (tid == idx - nfull) { sel[0] = tid; sel[1] = parts[tid] - 1; } }
        __syncthreads();
        const int list = __builtin_amdgcn_readfirstlane(sel[0]), part = __builtin_amdgcn_readfirstlane(sel[1]);
        const int bh = list >> 5, j = list & 31;
        moba_kv_unit(P, mb, bh / 6, bh % 6, j, part, qctr, lds);
    }
}

__device__ __forceinline__ void moba_combine(const Args& a, const MobaBufs& mb, int vcu, int G) {
    const bf16* P = (const bf16*)(a.ws + WS_P); bf16* Y = (bf16*)(a.ws + WS_Y);
    const int NIT = T * 6 * 8;
    for (int it = vcu * 512 + threadIdx.x; it < NIT; it += G * 512) {
        const int dg = it & 7, rh = it >> 3, hb = rh % 6, brow = rh / 6, blk = (brow & (SEQ - 1)) >> 8, nv = blk < 3 ? blk : 3;
        float O[8], L = 0.f;
#pragma unroll
        for (int e = 0; e < 8; ++e) O[e] = 0.f;
#pragma unroll
        for (int s = 0; s < 4; ++s) { if (s == 3 || s < nv) { const size_t si = ((size_t)s * T + brow) * 6 + hb; const float l = mb.slab_l[si]; const u32x4 w = *(const u32x4*)(mb.slab_o + si * 64 + 8 * dg);
#pragma unroll
            for (int e = 0; e < 4; ++e) { O[2 * e] += l * __uint_as_float(w[e] << 16); O[2 * e + 1] += l * __uint_as_float(w[e] & 0xffff0000u); } L += l; } }
        const float il = 1.f / L;
        const u32x4 z = *(const u32x4*)(P + (size_t)brow * LDP + L0_Z + (6 + hb) * 64 + 8 * dg); u32x4 y;
#pragma unroll
        for (int e = 0; e < 4; ++e) y[e] = cvtpk(O[2 * e] * il * __uint_as_float(z[e] << 16), O[2 * e + 1] * il * __uint_as_float(z[e] & 0xffff0000u));
        *(u32x4*)(Y + (size_t)brow * DM + (6 + hb) * 64 + 8 * dg) = y;
    }
}
}
#ifndef ATT_PIPE
#define ATT_PIPE 1
#endif
#ifndef MOBA_GATHER
#define MOBA_GATHER 1
#endif
namespace att {
constexpr int R_K = 0, R_V = 49152, R_WS = 98304, R_OST = R_WS + 8 * 256, R_END = R_OST + 8 * 4096;
__device__ __forceinline__ void swa_res_unit(const bf16* P, bf16* Y, const float* sinks, int b, int kvh, int qb, unsigned* qctr, LAS unsigned* qw, LAS unsigned char* shm) {
    const int tid = threadIdx.x, lane = tid & 63, r32 = lane & 31, hi = lane >> 5; const int wid = __builtin_amdgcn_readfirstlane(tid >> 6);
    const unsigned lds0 = (unsigned)(size_t)shm;
    const bf16* Pb = P + (size_t)b * SEQ * LDP;
    const int t0 = 4 * qb - 2 < 0 ? 0 : 4 * qb - 2, ntl = 4 * qb + 4 - t0;
    { const bf16* ksrc = Pb + L0_AK + kvh * 64 + (size_t)(64 * t0 + lane) * LDP + wid * 8;
      const bf16* vsrc = Pb + L0_AV + kvh * 64 + (size_t)(64 * t0 + 16 * (wid & 3) + (lane >> 2)) * LDP + (wid >> 2) * 32 + (lane & 3) * 8;
#pragma unroll 1
      for (int tt = 0; tt < ntl; ++tt) { glds16(ksrc + (size_t)tt * 64 * LDP, ATT_RFL(lds0 + R_K + tt * 8192 + wid * 1024)); glds16(vsrc + (size_t)tt * 64 * LDP, ATT_RFL(lds0 + R_V + tt * 8192 + wid * 1024)); } }
    unsigned nxt = 0u; if (tid == 0) nxt = __hip_atomic_fetch_add(qctr, 1u, __ATOMIC_RELAXED, __HIP_MEMORY_SCOPE_AGENT);
    const int qmin = 256 * qb + 32 * wid, qpos = qmin + r32; const size_t brow = (size_t)b * SEQ + qpos;
    asm volatile("s_waitcnt vmcnt(0) lgkmcnt(0)\n\ts_barrier" ::: "memory");
    LAS float* wsf = (LAS float*)(shm + R_WS + wid * 256); LAS float* ost = (LAS float*)(shm + R_OST + wid * 4096);
    const lds_cptr shc = (lds_cptr)shm;
    const int orow = lane >> 1, oh = lane & 1;
    const int t_hi = (qmin + 31) >> 6, t_lo = (qmin - 127) < 0 ? 0 : (qmin - 127) >> 6;
#pragma unroll 1
    for (int g = 0; g < 3; ++g) { const int h = 3 * kvh + g; float sl2v = alibi_slope2(h); asm volatile("" : "+v"(sl2v)); const float sl8v = sl2v * 4.f * 2.f, sl16v = sl8v * 2.f, sl24v = sl8v + sl16v, sl32v = sl16v * 2.f;
        bf16x8 qr[4];
        { const bf16* Qw = P + brow * LDP + L0_AQ + h * 64 + hi * 8;
#pragma unroll
          for (int d0 = 0; d0 < 4; ++d0) qr[d0] = *(const bf16x8*)(Qw + d0 * 16); }
        const size_t srow = (size_t)b * SEQ + qmin + orow;
        u32x4 zz[2][2];
#pragma unroll
        for (int d0 = 0; d0 < 2; ++d0) { const bf16* zp = P + srow * LDP + L0_Z + h * 64 + 32 * d0 + 16 * oh; zz[d0][0] = *(const u32x4*)zp; zz[d0][1] = *(const u32x4*)(zp + 8); }
        f32x16 o0 = f32x16{}, o1 = f32x16{}; float l = 0.f;
#pragma unroll 1
        for (int t = t_hi; t >= t_lo; --t) {
            const lds_cptr kp = shc + R_K + (t - t0) * 8192 + hi * 1024 + r32 * 16;
            bf16x8 kf[8];
#pragma unroll
            for (int d0 = 0; d0 < 4; ++d0) { kf[2 * d0] = *(const LAS bf16x8*)(kp + d0 * 2048); kf[2 * d0 + 1] = *(const LAS bf16x8*)(kp + d0 * 2048 + 512); }
            const float base = sl2v * (float)(64 * t + 4 * hi - qpos);
            f32x16 p0, p1;
#pragma unroll
            for (int g4 = 0; g4 < 4; ++g4) { const float a0 = g4 == 0 ? base : g4 == 1 ? base + sl8v : g4 == 2 ? base + sl16v : base + sl24v;
                p0[4 * g4] = a0; p0[4 * g4 + 1] = a0 + sl2v; p0[4 * g4 + 2] = p0[4 * g4 + 1] + sl2v; p0[4 * g4 + 3] = p0[4 * g4 + 2] + sl2v; }
#pragma unroll
            for (int r = 0; r < 16; ++r) p1[r] = p0[r] + sl32v;
            p0 = ATT_MFMA(kf[0], qr[0], p0); p1 = ATT_MFMA(kf[1], qr[0], p1); p0 = ATT_MFMA(kf[2], qr[1], p0); p1 = ATT_MFMA(kf[3], qr[1], p1);
            p0 = ATT_MFMA(kf[4], qr[2], p0); p1 = ATT_MFMA(kf[5], qr[2], p1); p0 = ATT_MFMA(kf[6], qr[3], p0); p1 = ATT_MFMA(kf[7], qr[3], p1);
            { int d = qpos - (64 * t + 4 * hi); asm volatile("" : "+v"(d));
              if (64 * t + 63 > qmin) {
#pragma unroll
                  for (int r = 0; r < 16; ++r) { const int c = (r & 3) + 8 * (r >> 2); if (c > d) p0[r] = -INFINITY; if (c + 32 > d) p1[r] = -INFINITY; } }
              if (64 * t < qmin + 31 - 127) {
#pragma unroll
                  for (int r = 0; r < 16; ++r) { const int c = (r & 3) + 8 * (r >> 2); if (d - c >= 128) p0[r] = -INFINITY; if (d - c - 32 >= 128) p1[r] = -INFINITY; } } }
#pragma unroll
            for (int r = 0; r < 16; ++r) { p0[r] = fexp2(p0[r]); p1[r] = fexp2(p1[r]); }
            float sm = 0.f;
#pragma unroll
            for (int r = 0; r < 16; ++r) sm += p0[r] + p1[r];
            l += sm;
            u32x4 pw[4];
#pragma unroll
            for (int q = 0; q < 4; ++q) { pw[0][q] = cvtpk(p0[2 * q], p0[2 * q + 1]); pw[1][q] = cvtpk(p0[8 + 2 * q], p0[9 + 2 * q]); pw[2][q] = cvtpk(p1[2 * q], p1[2 * q + 1]); pw[3][q] = cvtpk(p1[8 + 2 * q], p1[9 + 2 * q]); }
            const lds_cptr vp = shc + R_V + (t - t0) * 8192 + ((lane >> 4) & 1) * 32 + (lane & 3) * 8 + (4 * hi + ((lane & 15) >> 2)) * 64;
#pragma unroll
            for (int ks = 0; ks < 4; ++ks) { const s16x4 va = vtr(vp + ks * 1024), vb = vtr(vp + ks * 1024 + 512), vc = vtr(vp + 4096 + ks * 1024), vd = vtr(vp + 4096 + ks * 1024 + 512);
                const bf16x8 v0 = (bf16x8){va[0], va[1], va[2], va[3], vb[0], vb[1], vb[2], vb[3]}, v1 = (bf16x8){vc[0], vc[1], vc[2], vc[3], vd[0], vd[1], vd[2], vd[3]};
                o0 = ATT_MFMA(__builtin_bit_cast(bf16x8, pw[ks]), v0, o0); o1 = ATT_MFMA(__builtin_bit_cast(bf16x8, pw[ks]), v1, o1); }
        }
        l += __shfl_xor(l, 32); l += fexp2(LOG2E * sinks[h]);
        if (hi == 0) wsf[r32] = 1.f / l;
        asm volatile("s_waitcnt lgkmcnt(0)" ::: "memory");
        float rl[16];
#pragma unroll
        for (int r = 0; r < 16; ++r) rl[r] = wsf[crow(r, hi)];
#pragma unroll
        for (int d0 = 0; d0 < 2; ++d0) {
#pragma unroll
            for (int r = 0; r < 16; ++r) ost[crow(r, hi) * 32 + r32] = (d0 == 0 ? o0[r] : o1[r]) * rl[r];
            asm volatile("s_waitcnt lgkmcnt(0)" ::: "memory");
            f32x4 ov[4];
#pragma unroll
            for (int j = 0; j < 4; ++j) ov[j] = *(const LAS f32x4*)(ost + orow * 32 + 16 * oh + 4 * j);
            const u32x4 z0 = zz[d0][0], z1 = zz[d0][1]; u32x4 y0, y1;
#pragma unroll
            for (int j = 0; j < 4; ++j) { const unsigned za = j < 2 ? z0[2 * j] : z1[2 * (j - 2)], zb = j < 2 ? z0[2 * j + 1] : z1[2 * (j - 2) + 1];
                const unsigned w0 = cvtpk(ov[j][0] * __uint_as_float(za << 16), ov[j][1] * __uint_as_float(za & 0xffff0000u)), w1 = cvtpk(ov[j][2] * __uint_as_float(zb << 16), ov[j][3] * __uint_as_float(zb & 0xffff0000u));
                if (j < 2) { y0[2 * j] = w0; y0[2 * j + 1] = w1; } else { y1[2 * (j - 2)] = w0; y1[2 * (j - 2) + 1] = w1; } }
            bf16* yp = Y + srow * DM + h * 64 + 32 * d0 + 16 * oh;
            *(u32x4*)yp = y0; *(u32x4*)(yp + 8) = y1;
            asm volatile("s_waitcnt lgkmcnt(0)" ::: "memory");
        }
    }
    if (tid == 0) *qw = nxt;
    asm volatile("s_waitcnt vmcnt(0) lgkmcnt(0)\n\ts_barrier" ::: "memory");
}

constexpr int NUNITS = 1024;
__device__ __forceinline__ void attn_phase(int layer, const Args& a, LAS unsigned char* lds, unsigned* qctr, const MobaBufs& mb) {
    unsigned char* ws = a.ws; const bf16* P = (const bf16*)(ws + WS_P); bf16* Y = (bf16*)(ws + WS_Y);
    LAS unsigned* qw = (LAS unsigned*)(lds + R_END);
    const int tid = threadIdx.x, lane = tid & 63;
    float thr2 = 0.f; bool zok = false;
    if (layer == 1) { const float* g = a.in[11]; float mq = fabsf(g[lane]), mk = fabsf(g[64 + lane]);
#pragma unroll
        for (int o = 1; o < 64; o <<= 1) { mq = fmaxf(mq, __shfl_xor(mq, o)); mk = fmaxf(mk, __shfl_xor(mk, o)); }
        thr2 = LOG2E * (104.f + 2.f * 8.f * mq * mk); thr2 = __builtin_bit_cast(float, __builtin_amdgcn_readfirstlane(__builtin_bit_cast(int, thr2))); }
    if (tid == 0) *qw = __hip_atomic_fetch_add(qctr, 1u, __ATOMIC_RELAXED, __HIP_MEMORY_SCOPE_AGENT);
    __syncthreads();
    for (;;) {
        int idx = __builtin_amdgcn_readfirstlane((int)*qw);
        if (MOBA_GATHER && layer == 0) {
            if (idx >= 372 + 128 + 256) break;
            if (idx < 372) { moba_gate_item(P, (const float*)(ws + WS_KMEAN), mb, (idx % 12) / 6, (idx % 12) % 6, 1 + idx / 12);
                asm volatile("s_waitcnt vmcnt(0)" ::: "memory");
                __syncthreads();
                if (tid == 0) { __builtin_amdgcn_fence(__ATOMIC_RELEASE, "agent"); asm volatile("s_waitcnt vmcnt(0)" ::: "memory");
                    __hip_atomic_fetch_add(mb.mcnt + 512, 1u, __ATOMIC_RELAXED, __HIP_MEMORY_SCOPE_AGENT);
                    *qw = __hip_atomic_fetch_add(qctr, 1u, __ATOMIC_RELAXED, __HIP_MEMORY_SCOPE_AGENT); }
                __syncthreads(); continue; }
            if (idx < 500) { const int k = idx - 372; swa_res_unit(P, Y, a.in[5], (k & 3) >> 1, k & 1, 31 - (k >> 2), qctr, qw, lds); continue; }
            idx += 768 - 500;
        }
        if (idx >= NUNITS) break;
        if (layer == 1 && idx >= 512 && !zok) {
            if (tid == 0) { unsigned sp = 0u; while (__hip_atomic_load(mb.mcnt + 1024, __ATOMIC_RELAXED, __HIP_MEMORY_SCOPE_AGENT) < 128u) { __builtin_amdgcn_s_sleep(2); if (++sp > (1u << 22)) break; }
                __builtin_amdgcn_fence(__ATOMIC_ACQUIRE, "agent"); asm volatile("s_waitcnt vmcnt(0)" ::: "memory"); }
            __syncthreads(); zok = true; }
        UnitP u; u.qctr = qctr; u.qw = qw; u.sl2 = 0.f; u.sinkp = 0.f; u.thr2 = thr2; u.lf = nullptr; u.kmean = nullptr; u.pitch = LDP;
        int mode;
        if (idx >= 768) { const int k = idx - 768, qb = k >> 3, bh = k & 7, b = bh >> 2, hm = bh & 3; mode = M_MEM;
            const size_t row0 = (size_t)b * SEQ + qb * 256; const int mq = layer == 0 ? L0_MQ : L1_MQ, zc = (layer == 0 ? L0_Z : L1_Z) + (12 + hm) * 64;
            const bf16* MK = (const bf16*)(ws + WS_MKV + (size_t)(2 * layer) * MKV_ONE) + (size_t)b * MEML * 256 + hm * 64; const bf16* MV = (const bf16*)(ws + WS_MKV + (size_t)(2 * layer + 1) * MKV_ONE) + (size_t)b * MEML * 256 + hm * 64;
            u.Q = P + row0 * LDP + mq + hm * 64; u.K = MK; u.V = MV; u.pitch = 256; u.Z = P + row0 * LDP + zc; u.Y = Y + row0 * DM + (12 + hm) * 64; u.qb = qb; u.t_hi = 3; u.t_lo = 0;
        } else if (layer == 1) { int qb, b, h;
            if (idx < 512) { qb = 31 - idx / 16; b = (idx % 16) / 8; h = idx % 8; } else { const int k = idx - 512; qb = 31 - k / 8; b = (k % 8) / 4; h = 8 + k % 4; }
            mode = M_FOX;
            const size_t row0 = (size_t)b * SEQ + qb * 256; const bf16* Pb = P + (size_t)b * SEQ * LDP;
            u.Q = P + row0 * LDP + L1_CQ + h * 64; u.K = Pb + L1_CK + h * 64; u.V = Pb + L1_CV + h * 64; u.Z = P + row0 * LDP + L1_Z + h * 64; u.Y = Y + row0 * DM + h * 64;
            u.qb = qb; u.t_hi = 4 * qb + 3; u.t_lo = 0; u.lf = (const float*)(ws + WS_LOGF) + ((size_t)b * 12 + h) * SEQ;
        } else if (idx < 384) { const int qb = 31 - idx / 12, bh = idx % 12, b = bh / 6, hb = bh % 6; mode = M_MOBA;
            const size_t row0 = (size_t)b * SEQ + qb * 256; const bf16* Pb = P + (size_t)b * SEQ * LDP;
            u.Q = P + row0 * LDP + L0_BQ + hb * 64; u.K = Pb + L0_BK + hb * 64; u.V = Pb + L0_BV + hb * 64; u.Z = P + row0 * LDP + L0_Z + (6 + hb) * 64; u.Y = Y + row0 * DM + (6 + hb) * 64;
            u.qb = qb; u.t_hi = 4 * qb + 3; u.t_lo = 0; u.sl2 = alibi_slope2(6 + hb); u.kmean = (const float*)(ws + WS_KMEAN) + ((size_t)b * 6 + hb) * 32 * 64;
        } else { const int k = idx - 384, qb = k / 12, bh = k % 12, b = bh / 6, h = bh % 6, kvh = h / 3; mode = M_SWA;
            const size_t row0 = (size_t)b * SEQ + qb * 256; const bf16* Pb = P + (size_t)b * SEQ * LDP;
            u.Q = P + row0 * LDP + L0_AQ + h * 64; u.K = Pb + L0_AK + kvh * 64; u.V = Pb + L0_AV + kvh * 64; u.Z = P + row0 * LDP + L0_Z + h * 64; u.Y = Y + row0 * DM + h * 64;
            u.qb = qb; u.t_hi = 4 * qb + 3; u.t_lo = 4 * qb - 2 < 0 ? 0 : 4 * qb - 2; u.sl2 = alibi_slope2(h); u.sinkp = fexp2(LOG2E * a.in[5][h]);
        }
        if (mode == M_MEM) attn_unit<M_MEM>(u, lds); else if (mode == M_FOX) { if (ATT_PIPE) attn_unit_pipe<M_FOX>(u, lds); else attn_unit<M_FOX>(u, lds); } else if (mode == M_MOBA) attn_unit<M_MOBA>(u, lds); else attn_unit<M_SWA>(u, lds);
    }
}
}
typedef GAS unsigned gu32;
#define RLX_AGENT __ATOMIC_RELAXED, __HIP_MEMORY_SCOPE_AGENT
#define XB_TMO      128
#define XB_XCNT(j)  (256  + 64 * (j))
#define XB_XSUB(j)  (1280 + 64 * (j))
#define XB_XGEN(j)  (2304 + 64 * (j))
#define XB_TOP      3328
#define XB_TOPGEN   3392
#define XCD_BAR_WORDS 3456
#define XB_SPIN_CAP (1u << 18)

__device__ __forceinline__ unsigned xb_ld(unsigned* p)              { return __hip_atomic_load(p, __ATOMIC_RELAXED, __HIP_MEMORY_SCOPE_AGENT); }
__device__ __forceinline__ unsigned xb_add(unsigned* p, unsigned v) { return __hip_atomic_fetch_add(p, v, __ATOMIC_RELAXED, __HIP_MEMORY_SCOPE_AGENT); }
__device__ __forceinline__ unsigned xb_xcc_id() { return (unsigned)__builtin_amdgcn_s_getreg((3 << 11) | 20) & 0xFu; }
#define XB_SPIN(cond, bar) do { unsigned _sp = 0; while (cond) { __builtin_amdgcn_s_sleep(1); \
    if ((++_sp & 255u) == 0u) { if (xb_ld(&(bar)[XB_TMO])) break; if (_sp > XB_SPIN_CAP) { atomicAdd(&(bar)[XB_TMO], 1u); break; } } } } while (0)

struct XcdBarrier {
    unsigned* bar; unsigned x;
    volatile LAS unsigned* st;
};

__device__ __forceinline__ XcdBarrier xcd_barrier_post(unsigned* bar, volatile LAS unsigned* st) {
    XcdBarrier b; b.bar = bar; b.x = xb_xcc_id(); b.st = st;
    if (threadIdx.x == 0) (void)xb_add(&bar[XB_XCNT(b.x)], 1u);
    return b;
}
__device__ __forceinline__ void xcd_barrier_complete(unsigned* bar, unsigned x, unsigned& nloc, unsigned& nx) {
    const unsigned G = gridDim.x * gridDim.y * gridDim.z;
    unsigned sum, cnt, mine, sp = 0u;
    for (;;) {
        sum = 0u; cnt = 0u; mine = 0u;
#pragma unroll
        for (unsigned j = 0; j < 16; ++j) { const unsigned c = xb_ld(&bar[XB_XCNT(j)]); sum += c; cnt += (c > 0u) ? 1u : 0u; mine = (j == x) ? c : mine; }
        if (sum == G) break;
        __builtin_amdgcn_s_sleep(1);
        if ((++sp & 255u) == 0u) { if (xb_ld(&bar[XB_TMO])) break; if (sp > XB_SPIN_CAP) { atomicAdd(&bar[XB_TMO], 1u); break; } }
    }
    nloc = mine > 0u ? mine : 1u; nx = cnt > 0u ? cnt : 1u;
}

__device__ __forceinline__ void xcd_barrier(const XcdBarrier& b) {
    asm volatile("s_waitcnt vmcnt(0)" ::: "memory");
    __syncthreads();
    if (threadIdx.x == 0) {
        unsigned* bar = b.bar;
        __builtin_amdgcn_s_waitcnt(0);
        unsigned nloc = b.st[0], nx = b.st[1];
        if (nloc == 0u) { xcd_barrier_complete(bar, b.x, nloc, nx); b.st[0] = nloc; b.st[1] = nx; }
        const unsigned old = xb_add(&bar[XB_XSUB(b.x)], 1u);
        const unsigned gen = old / nloc;
        if (old + 1u == (gen + 1u) * nloc) {
            __builtin_amdgcn_fence(__ATOMIC_RELEASE, "agent");
            asm volatile("s_waitcnt vmcnt(0)" ::: "memory");
            const unsigned og = xb_add(&bar[XB_TOP], 1u);
            const unsigned tg = og / nx;
            if (og + 1u == (tg + 1u) * nx) xb_add(&bar[XB_TOPGEN], 1u);
            else XB_SPIN(xb_ld(&bar[XB_TOPGEN]) == tg, bar);
            __builtin_amdgcn_fence(__ATOMIC_ACQUIRE, "agent");
            xb_add(&bar[XB_XGEN(b.x)], 1u);
            asm volatile("s_waitcnt vmcnt(0)" ::: "memory");
        } else {
            XB_SPIN(xb_ld(&bar[XB_XGEN(b.x)]) == gen, bar);
            __builtin_amdgcn_fence(__ATOMIC_ACQUIRE, "agent");
            asm volatile("s_waitcnt vmcnt(0)" ::: "memory");
        }
    }
    __syncthreads();
}
constexpr int CW_ZDONE = 9216;
namespace pg8 {
struct OneUnit { int pm, pn;
    __device__ __forceinline__ bool next(int i, Unit& u) const { if (i) return false; u.pm = pm; u.pn = pn; return true; }
    __device__ __forceinline__ void a_ready(const Unit&) const {}
    __device__ __forceinline__ void done(const Unit&) const {} };
}
__device__ __forceinline__ void cf_item(const Args& a, int item, LAS unsigned char* lds) {
    const int tid = threadIdx.x, lane = tid & 63, fr = lane & 15, fq = lane >> 4, wid = tid >> 6;
    const bf16* XB = (const bf16*)(a.ws + WS_XB); const bf16* W = (const bf16*)(a.ws + WS_WIN1) + (size_t)3584 * DM; const float* SS = (const float*)(a.ws + WS_SS1); float* logf2 = (float*)(a.ws + WS_LOGF);
    const int row0 = item * 64, k0 = wid * 128 + 8 * fq;
    const bf16* wp = W + (size_t)fr * DM + k0; const bf16* xp = XB + (size_t)(row0 + fr) * DM + k0;
    bf16x8 wf[4], xf[4][4];
#pragma unroll
    for (int ks = 0; ks < 4; ++ks) { wf[ks] = *(const bf16x8*)(wp + 32 * ks);
#pragma unroll
        for (int g = 0; g < 4; ++g) xf[g][ks] = *(const bf16x8*)(xp + (size_t)(16 * g) * DM + 32 * ks); }
    f32x4 acc[4];
#pragma unroll
    for (int g = 0; g < 4; ++g) { acc[g] = (f32x4){0.f, 0.f, 0.f, 0.f};
#pragma unroll
        for (int ks = 0; ks < 4; ++ks) acc[g] = __builtin_amdgcn_mfma_f32_16x16x32_bf16(wf[ks], xf[g][ks], acc[g], 0, 0, 0); }
    LAS float* part = (LAS float*)lds;
#pragma unroll
    for (int g = 0; g < 4; ++g) *(LAS f32x4*)(part + (wid * 64 + 16 * g + fr) * 16 + 4 * fq) = acc[g];
    __syncthreads();
    { const int r = tid >> 3, n0 = (tid & 7) * 2;
      float v0 = 0.f, v1 = 0.f;
#pragma unroll
      for (int w = 0; w < 8; ++w) { v0 += part[(w * 64 + r) * 16 + n0]; v1 += part[(w * 64 + r) * 16 + n0 + 1]; }
      const int row = row0 + r; float ss = 0.f;
#pragma unroll
      for (int q = 0; q < 4; ++q) { const f32x4 sp = *(const f32x4*)(SS + (size_t)row * 16 + 4 * q); ss += (sp[0] + sp[1]) + (sp[2] + sp[3]); }
      const float rstd = rsqrtf(ss * (1.f / DM) + EPS); const int b = row / SEQ, t = row % SEQ;
      if (n0 < 12) { logf2[((size_t)b * 12 + n0) * SEQ + t] = logsig2(v0 * rstd + a.in[12][n0]); logf2[((size_t)b * 12 + n0 + 1) * SEQ + t] = logsig2(v1 * rstd + a.in[12][n0 + 1]); } }
    __syncthreads();
}

#ifndef PROBE_REP
#define PROBE_REP -1
#endif
#ifndef MK_ONE_LAUNCH
#define MK_ONE_LAUNCH 1
#endif
constexpr int NPHASE = 9;
constexpr int LDS_BYTES = 147456;
constexpr int LDSCTL_OFF = 135168;
constexpr int CW_BAR = 4096;
constexpr int CW_Q0 = 64, CW_Q1 = 128, CW_Q0B = 192;
constexpr int CW_MCNT = 8192;
constexpr size_t WS_SLAB = 200 * MiB;
constexpr size_t WS_END2 = 250 * MiB;
constexpr size_t DO_MLIST = 0, DO_SLABL = 8 * MiB;
__global__ void __launch_bounds__(512, 2) mk_fwd(Args a) {
    extern __shared__ __attribute__((aligned(16))) unsigned char lds_raw[];
    LAS unsigned char* lds = (LAS unsigned char*)lds_raw;
    const int G = gridDim.x, bx = blockIdx.x; const int vcu = (G % 8 == 0) ? (bx % 8) * (G / 8) + bx / 8 : bx;
    unsigned char* ws = a.ws; unsigned* ctl = (unsigned*)(ws + WS_CTL);
    bf16* XB = (bf16*)(ws + WS_XB); bf16* P = (bf16*)(ws + WS_P); bf16* Y = (bf16*)(ws + WS_Y);
    float* kmean = (float*)(ws + WS_KMEAN); float* logf2 = (float*)(ws + WS_LOGF); float* SS0 = (float*)(ws + WS_SS0); float* SS1 = (float*)(ws + WS_SS1);
    const att::MobaBufs mb{ctl + CW_MCNT, (unsigned short*)((unsigned char*)a.out + DO_MLIST), (bf16*)(ws + WS_SLAB), (float*)((unsigned char*)a.out + DO_SLABL)};
    volatile LAS unsigned* MISC = (volatile LAS unsigned*)(lds + LDSCTL_OFF);
    if (threadIdx.x < 64) MISC[threadIdx.x] = 0u;
    __syncthreads();
    XcdBarrier bar; bar.bar = ctl + CW_BAR; bar.x = 0; bar.st = nullptr;
    if (MK_ONE_LAUNCH) bar = xcd_barrier_post(ctl + CW_BAR, MISC + 8);
#define IN(k) (a.ph_lo <= (k) && (k) < a.ph_hi)
#define SEAM(k) do { if (MK_ONE_LAUNCH && IN(k) && IN((k) + 1)) xcd_barrier(bar); } while (0)
#define PH_PRO() do { if (IN(0)) phase_prologue(a, lds, vcu, G); SEAM(0); } while (0)
#define PH_IN0() do { if (IN(1)) { pg8::Gemm g{XB, (const bf16*)(ws + WS_WIN0), T, N0, DM}; pg8::StaticOrder S; S.init(T, N0, G, bx); \
        pg8::EpiProj E{0, P, SS0, a.in[4], nullptr, kmean, logf2}; pg8::gemm_phase<pg8::EpiProj, pg8::StaticOrder, true, true>(lds, g, S, E); } SEAM(1); } while (0)
#define PH_A0A(q) do { if (IN(2)) att::attn_phase(0, a, lds, ctl + (q), mb); } while (0)
#define PH_A0B(q) do { if (MOBA_GATHER) { if (IN(3)) att::moba_kv_phase(a, mb, lds, ctl + (q)); SEAM(3); } } while (0)
#define PH_A0C() do { if (MOBA_GATHER) { if (IN(4)) att::moba_combine(a, mb, vcu, G); SEAM(4); } } while (0)
#define PH_OUT0() do { if (IN(5)) { pg8::Gemm g{Y, (const bf16*)(ws + WS_WOUT0), T, DM, DM}; pg8::StaticOrder S; S.init(T, DM, G, bx); \
        pg8::EpiOut0 E{a.in[0], XB, SS1}; pg8::gemm_phase<pg8::EpiOut0, pg8::StaticOrder, true, true>(lds, g, S, E); } SEAM(5); } while (0)
#define PH_IN1() do { if (IN(6)) { pg8::Gemm g{XB, (const bf16*)(ws + WS_WIN1), T, 3072, DM}; pg8::StaticOrder S; S.init(T, 3072, G, bx); \
        pg8::EpiProj E{1, P, SS1, a.in[11], a.in[12], kmean, logf2}; pg8::gemm_phase<pg8::EpiProj, pg8::StaticOrder, true, true>(lds, g, S, E); \
        for (int it = vcu; it < T / 64; it += G) cf_item(a, it, lds); } SEAM(6); } while (0)
#define PH_A1(q) do { if (IN(7)) { for (int zi = vcu; zi < 128; zi += G) {         \
            pg8::Gemm g{XB, (const bf16*)(ws + WS_WIN1), T, N1, DM}; pg8::OneUnit S{zi >> 1, 12 + (zi & 1)}; \
            pg8::EpiProj E{1, P, SS1, a.in[11], a.in[12], kmean, logf2}; pg8::gemm_phase<pg8::EpiProj, pg8::OneUnit, true, true>(lds, g, S, E); \
            asm volatile("s_waitcnt vmcnt(0)" ::: "memory"); __syncthreads(); \
            if (threadIdx.x == 0) { __builtin_amdgcn_fence(__ATOMIC_RELEASE, "agent"); asm volatile("s_waitcnt vmcnt(0)" ::: "memory"); __hip_atomic_fetch_add(ctl + CW_ZDONE, 1u, __ATOMIC_RELAXED, __HIP_MEMORY_SCOPE_AGENT); } } \
        att::attn_phase(1, a, lds, ctl + (q), mb); } SEAM(7); } while (0)
#define PH_OUT1() do { if (IN(8)) { pg8::Gemm g{Y, (const bf16*)(ws + WS_WOUT1), T, DM, DM}; pg8::StaticOrder S; S.init(T, DM, G, bx); \
        pg8::EpiOut1 E{XB, a.out}; pg8::gemm_phase<pg8::EpiOut1, pg8::StaticOrder, true, true>(lds, g, S, E); } } while (0)
    PH_PRO();
#if PROBE_REP == 0
    PH_PRO();
#endif
    PH_IN0();
#if PROBE_REP == 1
    PH_IN0();
#endif
    PH_A0A(CW_Q0);
    PH_A0B(CW_Q0B);
#if PROBE_REP == 3
    PH_A0B(CW_Q0B + 256);
#endif
    PH_A0C();
#if PROBE_REP == 4
    PH_A0C();
#endif
#if PROBE_REP == 5
    PH_OUT0();
#endif
    PH_OUT0();
    PH_IN1();
#if PROBE_REP == 6
    PH_IN1();
#endif
    PH_A1(CW_Q1);
#if PROBE_REP == 7
    PH_A1(CW_Q1 + 256);
#endif
    PH_OUT1();
#undef IN
#undef SEAM
}

extern "C" void kernel_launch(void* const* d_in, const int* in_sizes, int n_in, void* d_out, int out_size, void* d_ws, size_t ws_size, hipStream_t stream) {
    static int grid = 0;
    if (grid == 0) {
        if (n_in != 16 || out_size != T * DM || ws_size < WS_END2) { fprintf(stderr, "kernel_launch: unexpected shapes (n_in %d out %d ws %zu)\n", n_in, out_size, ws_size); grid = -1; return; }
        int dev = 0, cus = 0, per_cu = 0;
        (void)hipGetDevice(&dev); (void)hipDeviceGetAttribute(&cus, hipDeviceAttributeMultiprocessorCount, dev);
        (void)hipFuncSetAttribute((const void*)mk_fwd, hipFuncAttributeMaxDynamicSharedMemorySize, LDS_BYTES);
        (void)hipOccupancyMaxActiveBlocksPerMultiprocessor(&per_cu, (const void*)mk_fwd, 512, LDS_BYTES);
        (void)hipGetLastError();
        grid = cus * (per_cu >= 1 ? 1 : 0); if (grid <= 0) { fprintf(stderr, "kernel_launch: occupancy query says 0 workgroups per CU\n"); grid = -1; return; }
    }
    if (grid < 0) return;
    unsigned char* ws = (unsigned char*)d_ws;
    (void)hipMemsetAsync(ws + WS_CTL, 0, CTL_ZERO_BYTES, stream);
    Args a{}; for (int i = 0; i < 16; ++i) a.in[i] = (const float*)d_in[i];
    a.out = (float*)d_out; a.ws = ws;
#define RUN(lo, hi) do { a.ph_lo = (lo); a.ph_hi = (hi); hipLaunchKernelGGL(mk_fwd, dim3(grid), dim3(512), LDS_BYTES, stream, a); } while (0)
    if (MK_ONE_LAUNCH) RUN(0, NPHASE);
    else { for (int k = 0; k < NPHASE; ++k) RUN(k, k + 1); }
#undef RUN
}
```
